# Optimizing an MI355X kernel written in HIP

```python
import jax
import jax.numpy as jnp
from jax import lax
import numpy as np

D_MODEL = 1024
BATCH = 16
SEQ = 2048
DEPTH = 4

N_MIXERS = 4
N_REPEAT = DEPTH // N_MIXERS
RMS_EPS = 1e-6
ROPE_THETA = 10000.0

DSA_HEADS = 16
DSA_KV_HEADS = 4
DSA_HEAD_DIM = 64
DSA_IDX_HEADS = 8
DSA_IDX_DIM = 128
DSA_TOPK = 256
DSA_QBLOCK = 128
DSA_Q = DSA_HEADS * DSA_HEAD_DIM
DSA_KV = DSA_KV_HEADS * DSA_HEAD_DIM
DSA_SPLITS = (DSA_Q, DSA_Q + DSA_KV, DSA_Q + 2 * DSA_KV, 2 * DSA_Q + 2 * DSA_KV,
              2 * DSA_Q + 2 * DSA_KV + DSA_IDX_HEADS * DSA_IDX_DIM,
              2 * DSA_Q + 2 * DSA_KV + DSA_IDX_HEADS * DSA_IDX_DIM + DSA_IDX_HEADS)
DSA_IN = DSA_SPLITS[-1] + DSA_IDX_DIM
DSA_IDX_SCALE = (DSA_IDX_HEADS * DSA_IDX_DIM) ** -0.5

LRU_WIDTH = D_MODEL
LRU_BLOCKS = 16
LRU_BLOCK_DIM = LRU_WIDTH // LRU_BLOCKS
LRU_CONV = 4
LRU_C = 8.0

RWKV_HEAD_DIM = 64
RWKV_HEADS = D_MODEL // RWKV_HEAD_DIM
RWKV_DECAY_LORA = 64
RWKV_AAA_LORA = 64
RWKV_GN_EPS = 64e-5

GLA_HEADS = 4
GLA_KEY_DIM = D_MODEL // 2
GLA_VAL_DIM = D_MODEL
GLA_DK = GLA_KEY_DIM // GLA_HEADS
GLA_DV = GLA_VAL_DIM // GLA_HEADS
GLA_GATE_RANK = 16
GLA_GATE_NORM = 16.0
GLA_CHUNK = 64
GLA_SPLITS = (GLA_KEY_DIM, 2 * GLA_KEY_DIM, 2 * GLA_KEY_DIM + GLA_VAL_DIM,
              2 * GLA_KEY_DIM + 2 * GLA_VAL_DIM)
GLA_IN = GLA_SPLITS[-1] + GLA_GATE_RANK

kernel_name = 'hybrid_dsa_rglru_rwkv7_gla_trunk'


def rms_norm(x, gain, eps=RMS_EPS):
    xf = x.astype(jnp.float32)
    y = xf * lax.rsqrt(jnp.mean(xf * xf, axis=-1, keepdims=True) + eps)
    return (y * gain.astype(jnp.float32)).astype(x.dtype)


def rope(x):
    seq, d = x.shape[1], x.shape[-1]
    half = d // 2
    inv_freq = ROPE_THETA ** (-jnp.arange(half, dtype=jnp.float32) / half)
    ang = jnp.arange(seq, dtype=jnp.float32)[:, None] * inv_freq[None, :]
    cos = jnp.cos(ang)[None, :, None, :]
    sin = jnp.sin(ang)[None, :, None, :]
    xf = x.astype(jnp.float32)
    x1, x2 = xf[..., :half], xf[..., half:]
    return jnp.concatenate([x1 * cos - x2 * sin, x2 * cos + x1 * sin], axis=-1).astype(x.dtype)


def dsa_mixer(h, w_in, q_gain, k_gain, w_out):
    f32 = jnp.float32
    bsz, seq, _ = h.shape
    q, k, v, g, qi, wi, ki = jnp.split(h @ w_in, DSA_SPLITS, axis=-1)
    q = rope(rms_norm(q.reshape(bsz, seq, DSA_HEADS, DSA_HEAD_DIM), q_gain))
    k = rope(rms_norm(k.reshape(bsz, seq, DSA_KV_HEADS, DSA_HEAD_DIM), k_gain))
    v = v.reshape(bsz, seq, DSA_KV_HEADS, DSA_HEAD_DIM)
    qi = rope(qi.reshape(bsz, seq, DSA_IDX_HEADS, DSA_IDX_DIM)).astype(f32)
    ki = rope(ki.reshape(bsz, seq, 1, DSA_IDX_DIM))[:, :, 0].astype(f32)
    wi = wi.astype(f32) * DSA_IDX_SCALE
    n_sel = min(DSA_TOPK, seq // 4)
    n_blk = seq // DSA_QBLOCK
    rep = DSA_HEADS // DSA_KV_HEADS
    scale = DSA_HEAD_DIM ** -0.5
    starts = jnp.arange(n_blk, dtype=jnp.int32) * DSA_QBLOCK
    key_pos = jnp.arange(seq, dtype=jnp.int32)

    def one_sequence(args):
        q_s, k_s, v_s, qi_s, wi_s, ki_s = args

        def one_block(blk):
            q_b, qi_b, wi_b, t0 = blk
            q_pos = t0 + jnp.arange(DSA_QBLOCK, dtype=jnp.int32)
            idx_logits = jnp.einsum('qhd,sd->qhs', qi_b, ki_s)
            score = jnp.einsum('qh,qhs->qs', wi_b, jax.nn.relu(idx_logits))
            score = jnp.where(key_pos[None, :] <= q_pos[:, None], score, -jnp.inf)
            _, sel = lax.top_k(score, n_sel)
            valid = sel <= q_pos[:, None]
            k_sel = k_s[sel]
            v_sel = v_s[sel]
            q_g = q_b.reshape(DSA_QBLOCK, DSA_KV_HEADS, rep, DSA_HEAD_DIM)
            s = jnp.einsum('qgrd,qkgd->qgrk', q_g, k_sel).astype(f32) * scale
            s = jnp.where(valid[:, None, None, :], s, -jnp.inf)
            p = jax.nn.softmax(s, axis=-1).astype(v_sel.dtype)
            o = jnp.einsum('qgrk,qkgd->qgrd', p, v_sel)
            return o.reshape(DSA_QBLOCK, DSA_Q)

        blocks = (q_s.reshape(n_blk, DSA_QBLOCK, DSA_HEADS, DSA_HEAD_DIM),
                  qi_s.reshape(n_blk, DSA_QBLOCK, DSA_IDX_HEADS, DSA_IDX_DIM),
                  wi_s.reshape(n_blk, DSA_QBLOCK, DSA_IDX_HEADS), starts)
        return lax.map(one_block, blocks).reshape(seq, DSA_Q)

    o = lax.map(one_sequence, (q, k, v, qi, wi, ki))
    return (o * jax.nn.silu(g)) @ w_out


def causal_depthwise_conv(u, w, b):
    width = w.shape[0]
    out = lax.conv_general_dilated(u, w[:, None, :].astype(u.dtype), window_strides=(1,),
                                   padding=[(width - 1, 0)],
                                   dimension_numbers=('NWC', 'WIO', 'NWC'),
                                   feature_group_count=u.shape[-1])
    return out + b


def rglru_mixer(h, w_in, conv_w, conv_b, gate_a_w, gate_a_b, gate_x_w, gate_x_b, lam, w_out):
    f32 = jnp.float32
    bsz, seq, _ = h.shape
    u, g = jnp.split(h @ w_in, 2, axis=-1)
    u = causal_depthwise_conv(u, conv_w, conv_b)
    u_blk = u.reshape(bsz, seq, LRU_BLOCKS, LRU_BLOCK_DIM)
    gr = jnp.einsum('bsnc,ncd->bsnd', u_blk, gate_a_w).reshape(bsz, seq, LRU_WIDTH) + gate_a_b
    gi = jnp.einsum('bsnc,ncd->bsnd', u_blk, gate_x_w).reshape(bsz, seq, LRU_WIDTH) + gate_x_b
    r = jax.nn.sigmoid(gr.astype(f32))
    i = jax.nn.sigmoid(gi.astype(f32))
    log_a = -LRU_C * r * jax.nn.softplus(-lam.astype(f32))
    a = jnp.exp(log_a)
    b = jnp.sqrt(-jnp.expm1(2.0 * log_a)) * (i * u.astype(f32))

    def combine(left, right):
        a_l, b_l = left
        a_r, b_r = right
        return a_l * a_r, a_r * b_l + b_r

    _, hs = lax.associative_scan(combine, (a, b), axis=1)
    return (hs.astype(h.dtype) * jax.nn.silu(g)) @ w_out


def rwkv7_mixer(h, mu, w_in, w0, w1, w2, a0, a1, a2, k_k, k_a, r_k, ln_w, ln_b, w_out):
    f32 = jnp.float32
    bsz, seq, dm = h.shape
    hshape = (RWKV_HEADS, RWKV_HEAD_DIM)
    h_prev = jnp.pad(h, ((0, 0), (1, 0), (0, 0)))[:, :-1]
    xs = h[None] + (h_prev - h)[None] * mu[:, None, None, :]
    r, k, v, g = jnp.einsum('nbsd,nde->nbse', xs[:4], w_in)
    w_log = -jax.nn.softplus(-(w0 + jnp.tanh(xs[4] @ w1) @ w2).astype(f32)) - 0.5
    decay = jnp.exp(-jnp.exp(w_log))
    a = jax.nn.sigmoid((a0 + (xs[5] @ a1) @ a2).astype(f32))

    def heads(t):
        return t.astype(f32).reshape(bsz, seq, *hshape)

    r, k, v, decay, a = heads(r), heads(k), heads(v), heads(decay), heads(a)
    kk = k * k_k.reshape(hshape)
    kk = kk / jnp.maximum(jnp.sqrt(jnp.sum(kk * kk, axis=-1, keepdims=True)), 1e-12)
    k = k * (1.0 + (a - 1.0) * k_a.reshape(hshape))

    def step(state, inp):
        r_t, w_t, k_t, v_t, a_t, b_t = inp
        sa = jnp.einsum('bhij,bhj->bhi', state, a_t)
        state = (state * w_t[:, :, None, :] + sa[..., None] * b_t[:, :, None, :]
                 + v_t[..., None] * k_t[:, :, None, :])
        return state, jnp.einsum('bhij,bhj->bhi', state, r_t)

    s0 = jnp.zeros((bsz, RWKV_HEADS, RWKV_HEAD_DIM, RWKV_HEAD_DIM), f32)
    seq_major = tuple(jnp.moveaxis(t, 1, 0) for t in (r, decay, k, v, -kk, kk * a))
    _, y = lax.scan(step, s0, seq_major)
    y = jnp.moveaxis(y, 0, 1)
    mean = jnp.mean(y, axis=-1, keepdims=True)
    var = jnp.mean(jnp.square(y - mean), axis=-1, keepdims=True)
    y = (y - mean) * lax.rsqrt(var + RWKV_GN_EPS) * ln_w.reshape(hshape) + ln_b.reshape(hshape)
    y = y + jnp.sum(r * k * r_k, axis=-1, keepdims=True) * v
    y = y.reshape(bsz, seq, dm).astype(h.dtype) * jax.nn.silu(g)
    return y @ w_out


def gla_mixer(h, w_in, alpha_w2, alpha_b, norm_gain, w_out):
    f32 = jnp.float32
    bsz, seq, _ = h.shape
    q, k, v, g, a_low = jnp.split(h @ w_in, GLA_SPLITS, axis=-1)
    log_alpha = jax.nn.log_sigmoid((a_low @ alpha_w2 + alpha_b).astype(f32)) / GLA_GATE_NORM
    n_chunk = seq // GLA_CHUNK

    def chunks(t, d):
        return t.astype(f32).reshape(bsz, n_chunk, GLA_CHUNK, GLA_HEADS, d)

    q = chunks(q, GLA_DK) * GLA_DK ** -0.5
    k = chunks(k, GLA_DK)
    v = chunks(v, GLA_DV)
    cum = lax.cumsum(chunks(log_alpha, GLA_DK), axis=2)
    last = cum[:, :, -1]
    q_dec = q * jnp.exp(cum)
    k_inv = k * jnp.exp(-cum)
    k_end = k * jnp.exp(last[:, :, None] - cum)
    causal = jnp.tril(jnp.ones((GLA_CHUNK, GLA_CHUNK), dtype=bool))
    att = jnp.where(causal, jnp.einsum('bnihd,bnjhd->bnhij', q_dec, k_inv), 0.0)
    o_intra = jnp.einsum('bnhij,bnjhe->bnihe', att, v)
    chunk_kv = jnp.einsum('bnjhd,bnjhe->bnhde', k_end, v)

    def carry_state(state, inp):
        kv_c, last_c = inp
        return state * jnp.exp(last_c)[..., None] + kv_c, state

    s0 = jnp.zeros((bsz, GLA_HEADS, GLA_DK, GLA_DV), f32)
    _, s_prev = lax.scan(carry_state, s0, (jnp.moveaxis(chunk_kv, 1, 0), jnp.moveaxis(last, 1, 0)))
    o_inter = jnp.einsum('bnihd,nbhde->bnihe', q_dec, s_prev)
    o = (o_intra + o_inter).reshape(bsz, seq, GLA_HEADS, GLA_DV)
    o = rms_norm(o, norm_gain).reshape(bsz, seq, GLA_VAL_DIM).astype(h.dtype)
    return (o * jax.nn.silu(g)) @ w_out


def setup_inputs(seed: int = 0) -> dict:
    key = jax.random.key(seed)
    keys = iter(jax.random.split(key, 64))
    f32 = jnp.float32
    D, R = D_MODEL, N_REPEAT

    def nrm(shape, scale):
        return jax.random.normal(next(keys), shape, f32) * scale

    def unif(shape, lo, hi):
        return jax.random.uniform(next(keys), shape, f32, lo, hi)

    lru_u = unif((R, LRU_WIDTH), 0.9, 0.999)
    lru_base = lru_u ** (1.0 / LRU_C)
    return {
        'x': nrm((BATCH, SEQ, D), 1.0),
        'c': nrm((BATCH, D), 1.0),
        'ln_gain': 1.0 + nrm((DEPTH, D), 0.02),
        'mod_w': nrm((DEPTH, D, 3 * D), 0.5 * D ** -0.5),
        'mod_b': nrm((DEPTH, 3 * D), 0.02),
        'dsa_w_in': nrm((R, D, DSA_IN), D ** -0.5),
        'dsa_q_gain': 1.0 + nrm((R, DSA_HEAD_DIM), 0.02),
        'dsa_k_gain': 1.0 + nrm((R, DSA_HEAD_DIM), 0.02),
        'dsa_w_out': nrm((R, DSA_Q, D), DSA_Q ** -0.5),
        'lru_w_in': nrm((R, D, 2 * LRU_WIDTH), D ** -0.5),
        'lru_conv_w': nrm((R, LRU_CONV, LRU_WIDTH), LRU_CONV ** -0.5),
        'lru_conv_b': nrm((R, LRU_WIDTH), 0.02),
        'lru_gate_a_w': nrm((R, LRU_BLOCKS, LRU_BLOCK_DIM, LRU_BLOCK_DIM), LRU_BLOCK_DIM ** -0.5),
        'lru_gate_a_b': nrm((R, LRU_WIDTH), 0.02),
        'lru_gate_x_w': nrm((R, LRU_BLOCKS, LRU_BLOCK_DIM, LRU_BLOCK_DIM), LRU_BLOCK_DIM ** -0.5),
        'lru_gate_x_b': nrm((R, LRU_WIDTH), 0.02),
        'lru_lambda': jnp.log(lru_base) - jnp.log1p(-lru_base),
        'lru_w_out': nrm((R, LRU_WIDTH, D), LRU_WIDTH ** -0.5),
        'rwkv_mu': unif((R, 6, D), 0.0, 1.0),
        'rwkv_w_in': nrm((R, 4, D, D), D ** -0.5),
        'rwkv_w0': unif((R, D), -6.0, -1.0),
        'rwkv_w1': nrm((R, D, RWKV_DECAY_LORA), D ** -0.5),
        'rwkv_w2': nrm((R, RWKV_DECAY_LORA, D), 0.1 * RWKV_DECAY_LORA ** -0.5),
        'rwkv_a0': nrm((R, D), 0.1),
        'rwkv_a1': nrm((R, D, RWKV_AAA_LORA), D ** -0.5),
        'rwkv_a2': nrm((R, RWKV_AAA_LORA, D), 0.1 * RWKV_AAA_LORA ** -0.5),
        'rwkv_k_k': 0.85 + nrm((R, D), 0.02),
        'rwkv_k_a': 1.0 + nrm((R, D), 0.02),
        'rwkv_r_k': nrm((R, RWKV_HEADS, RWKV_HEAD_DIM), 0.1),
        'rwkv_ln_w': 1.0 + nrm((R, D), 0.02),
        'rwkv_ln_b': nrm((R, D), 0.02),
        'rwkv_w_out': nrm((R, D, D), D ** -0.5),
        'gla_w_in': nrm((R, D, GLA_IN), D ** -0.5),
        'gla_alpha_w2': nrm((R, GLA_GATE_RANK, GLA_KEY_DIM), GLA_GATE_RANK ** -0.5),
        'gla_alpha_b': nrm((R, GLA_KEY_DIM), 0.1),
        'gla_norm_gain': 1.0 + nrm((R, GLA_DV), 0.02),
        'gla_w_out': nrm((R, GLA_VAL_DIM, D), GLA_VAL_DIM ** -0.5),
    }


def reference(x, c, ln_gain, mod_w, mod_b,
              dsa_w_in, dsa_q_gain, dsa_k_gain, dsa_w_out,
              lru_w_in, lru_conv_w, lru_conv_b, lru_gate_a_w, lru_gate_a_b,
              lru_gate_x_w, lru_gate_x_b, lru_lambda, lru_w_out,
              rwkv_mu, rwkv_w_in, rwkv_w0, rwkv_w1, rwkv_w2, rwkv_a0, rwkv_a1, rwkv_a2,
              rwkv_k_k, rwkv_k_a, rwkv_r_k, rwkv_ln_w, rwkv_ln_b, rwkv_w_out,
              gla_w_in, gla_alpha_w2, gla_alpha_b, gla_norm_gain, gla_w_out):
    c_act = jax.nn.silu(c)
    for layer in range(DEPTH):
        mixer, r = layer % N_MIXERS, layer // N_MIXERS
        mod = c_act @ mod_w[layer] + mod_b[layer]
        shift, scale, gate = jnp.split(mod, 3, axis=-1)
        h = rms_norm(x, ln_gain[layer]) * (1.0 + scale[:, None, :]) + shift[:, None, :]
        if mixer == 0:
            y = dsa_mixer(h, dsa_w_in[r], dsa_q_gain[r], dsa_k_gain[r], dsa_w_out[r])
        elif mixer == 1:
            y = rglru_mixer(h, lru_w_in[r], lru_conv_w[r], lru_conv_b[r], lru_gate_a_w[r],
                            lru_gate_a_b[r], lru_gate_x_w[r], lru_gate_x_b[r], lru_lambda[r],
                            lru_w_out[r])
        elif mixer == 2:
            y = rwkv7_mixer(h, rwkv_mu[r], rwkv_w_in[r], rwkv_w0[r], rwkv_w1[r], rwkv_w2[r],
                            rwkv_a0[r], rwkv_a1[r], rwkv_a2[r], rwkv_k_k[r], rwkv_k_a[r],
                            rwkv_r_k[r], rwkv_ln_w[r], rwkv_ln_b[r], rwkv_w_out[r])
        else:
            y = gla_mixer(h, gla_w_in[r], gla_alpha_w2[r], gla_alpha_b[r], gla_norm_gain[r],
                          gla_w_out[r])
        x = x + gate[:, None, :] * y
    return x
```

```cpp
#include <hip/hip_runtime.h>
#include <hip/hip_cooperative_groups.h>
#include <cstdio>
#include <cmath>
namespace cg = cooperative_groups;

#ifndef DUP
#define DUP 0
#endif
#ifndef LAYER_MASK
#define LAYER_MASK 15
#endif

typedef unsigned short u16;
using bf16x8 = __attribute__((ext_vector_type(8))) short;
using f32x4 = __attribute__((ext_vector_type(4))) float;

#define NTHR 512
constexpr int T_ = 32768;
constexpr size_t MiB = 1ull << 20;
constexpr int LDS_BYTES = 128 * 1024 + 64;
constexpr size_t WS_XBAR = 896 * 1024;

constexpr size_t WS_MOD = 0;
constexpr size_t WS_ROPE128 = 1 * MiB;
constexpr size_t WS_ROPE64 = 2 * MiB;
constexpr size_t WS_WT = 4 * MiB;
constexpr size_t WS_H = 52 * MiB;
constexpr size_t WS_H2 = 116 * MiB;
constexpr size_t WS_P = 180 * MiB;

constexpr size_t W_DSA_MAIN = 0;
constexpr size_t W_DSA_IDX_HI = W_DSA_MAIN + 2560ull * 1024;
constexpr size_t W_DSA_IDX_LO = W_DSA_IDX_HI + 1280ull * 1024;
constexpr size_t W_DSA_OUT = W_DSA_IDX_LO + 1280ull * 1024;
constexpr size_t W_LRU_IN = W_DSA_OUT + 1024ull * 1024;
constexpr size_t W_LRU_GATE = W_LRU_IN + 2048ull * 1024;
constexpr size_t W_LRU_OUT = W_LRU_GATE + 16ull * 128 * 64;
constexpr size_t W_RWKV_IN = W_LRU_OUT + 1024ull * 1024;
constexpr size_t W_RWKV_L1 = W_RWKV_IN + 4096ull * 2048;
constexpr size_t W_RWKV_W2 = W_RWKV_L1 + 128ull * 2048;
constexpr size_t W_RWKV_A2 = W_RWKV_W2 + 1024ull * 64;
constexpr size_t W_RWKV_OUT = W_RWKV_A2 + 1024ull * 64;
constexpr size_t W_GLA_IN = W_RWKV_OUT + 1024ull * 1024;
constexpr size_t W_GLA_OUT = W_GLA_IN + 3328ull * 1024;
constexpr size_t W_END = W_GLA_OUT + 1024ull * 1024;
static_assert(W_END * 2 <= 48 * MiB, "weights region");

constexpr size_t DSA_QKVG = WS_P;
constexpr size_t DSA_QIHI = WS_P + 160 * MiB;
constexpr size_t DSA_QILO = WS_P + 224 * MiB;
constexpr size_t DSA_KIHI = WS_P + 288 * MiB;
constexpr size_t DSA_KILO = WS_P + 296 * MiB;
constexpr size_t DSA_WI = WS_P + 304 * MiB;
constexpr size_t DSA_VT = WS_P + 306 * MiB;
constexpr size_t DSA_SCR = WS_H;
constexpr size_t LRU_UG = WS_H2;
constexpr size_t LRU_A = WS_H2 + 128 * MiB;
constexpr size_t LRU_B = WS_H2 + 256 * MiB;
constexpr size_t RW_RKVG = WS_P;
constexpr size_t RW_L1 = WS_P + 256 * MiB;
constexpr size_t RW_EW = WS_H;
constexpr size_t RW_A = WS_P + 264 * MiB;
constexpr size_t GL_P = WS_H2;
constexpr size_t GL_O = WS_H2 + 194 * MiB;
constexpr size_t GL_QD = WS_H2 + 258 * MiB;
constexpr size_t GL_KET = WS_H2 + 290 * MiB;
constexpr size_t GL_ATT_OUT = 0;
constexpr size_t GL_LAST_OUT = 16 * MiB;
constexpr size_t XR1 = 448 * MiB;
constexpr size_t XR3 = 438 * MiB;
constexpr size_t GL_VT = WS_H;

struct Params {
  const float* in[37];
  float* out;
  unsigned char* ws;
  float invf128[64];
  float invf64[32];
};

typedef const Params __attribute__((address_space(4))) * CParamsPtr;
struct PAcc { CParamsPtr pp; };

__device__ __forceinline__ int tid_() { int t = __builtin_amdgcn_workitem_id_x(); asm volatile("" : "+v"(t)); return t; }
__device__ __forceinline__ u16 f2bf(float f) {
  unsigned u = __float_as_uint(f);
  u += 0x7fffu + ((u >> 16) & 1u);
  return (u16)(u >> 16);
}
__device__ __forceinline__ float bf2f(u16 h) { return __uint_as_float(((unsigned)h) << 16); }
__device__ __forceinline__ float bflo(unsigned w) { return __uint_as_float(w << 16); }
__device__ __forceinline__ float bfhi(unsigned w) { return __uint_as_float(w & 0xffff0000u); }
__device__ __forceinline__ unsigned pack2(float a, float b) { return (unsigned)f2bf(a) | ((unsigned)f2bf(b) << 16); }
__device__ __forceinline__ float sigmoid_(float x) { return 1.f / (1.f + __expf(-x)); }
__device__ __forceinline__ float silu_(float x) { return x / (1.f + __expf(-x)); }
__device__ __forceinline__ float softplus_(float x) { return x > 20.f ? x : log1pf(__expf(x)); }
template <int CTRL> __device__ __forceinline__ float dpp(float x) {
  return __builtin_bit_cast(float, __builtin_amdgcn_mov_dpp(__builtin_bit_cast(int, x), CTRL, 0xf, 0xf, true));
}
__device__ __forceinline__ float red8(float x) {
  x += dpp<0xB1>(x); x += dpp<0x4E>(x); x += dpp<0x141>(x); return x;
}
typedef _Float16 f16x8_t __attribute__((ext_vector_type(8)));
typedef _Float16 f16x2_t __attribute__((ext_vector_type(2)));
__device__ __forceinline__ f32x4 mfma16h(bf16x8 a, bf16x8 b, f32x4 c) {
  return __builtin_amdgcn_mfma_f32_16x16x32_f16(__builtin_bit_cast(f16x8_t, a), __builtin_bit_cast(f16x8_t, b), c, 0, 0, 0);
}
__device__ __forceinline__ unsigned packh2(float a, float b) {
  f16x2_t v; v.x = (_Float16)a; v.y = (_Float16)b; return __builtin_bit_cast(unsigned, v);
}
__device__ __forceinline__ float hlo(unsigned w) { return (float)__builtin_bit_cast(f16x2_t, w).x; }
__device__ __forceinline__ float hhi(unsigned w) { return (float)__builtin_bit_cast(f16x2_t, w).y; }
__device__ __forceinline__ u16 f2h(float a) { return __builtin_bit_cast(u16, (_Float16)a); }
__device__ __forceinline__ float red32(float x) {
  x += dpp<0xB1>(x); x += dpp<0x4E>(x); x += dpp<0x141>(x); x += dpp<0x140>(x);
  const auto s_ = __builtin_amdgcn_permlane16_swap(__float_as_uint(x), __float_as_uint(x), false, false);
  return __uint_as_float(s_[0]) + __uint_as_float(s_[1]);
}
__device__ __forceinline__ f32x4 mfma16(bf16x8 a, bf16x8 b, f32x4 c) {
  return __builtin_amdgcn_mfma_f32_16x16x32_bf16(a, b, c, 0, 0, 0);
}
__device__ __forceinline__ void sincos_d(double x, float& c, float& s) {
  double k = rint(x * 0.63661977236758134308);
  double r = fma(-k, 1.57079632679489655800, x);
  r = fma(-k, 6.12323399573676603587e-17, r);
  int q = ((int)k) & 3;
  double r2 = r * r;
  double sp = r * (1.0 + r2 * (-1.0 / 6 + r2 * (1.0 / 120 + r2 * (-1.0 / 5040 + r2 * (1.0 / 362880 + r2 * (-1.0 / 39916800 + r2 * (1.0 / 6227020800.0)))))));
  double cp = 1.0 + r2 * (-0.5 + r2 * (1.0 / 24 + r2 * (-1.0 / 720 + r2 * (1.0 / 40320 + r2 * (-1.0 / 3628800 + r2 * (1.0 / 479001600.0 + r2 * (-1.0 / 87178291200.0)))))));
  double ss = (q == 0) ? sp : (q == 1) ? cp : (q == 2) ? -sp : -cp;
  double cc = (q == 0) ? cp : (q == 1) ? -sp : (q == 2) ? -cp : sp;
  c = (float)cc; s = (float)ss;
}

__device__ __forceinline__ int idx_perm(int p) {
  int wc = p >> 6, jn = (p >> 4) & 3, fr = p & 15;
  return wc * 32 + (jn & 1) * 16 + fr + 64 * (jn >> 1);
}
__device__ __forceinline__ void tconv_job(const float* __restrict__ src, int ld_src, int K, int nrows, int colmode, int col_off, int nvalid,
                          u16* __restrict__ dst, u16* __restrict__ dst_lo, int ldd, int dst_col0,
                          const float* __restrict__ mu, int smode, float* tl, int fmt = 0) {
  const int tid = tid_();
  const int tk = K >> 6, tn = nrows >> 6;
  for (int tile = blockIdx.x; tile < tk * tn; tile += gridDim.x) {
    const int k0 = (tile % tk) << 6, j0 = (tile / tk) << 6;
    {
      const int jn = tid & 63;
      const int j = j0 + jn;
      int col;
      if (colmode == 0) col = (j < nvalid) ? col_off + j : -1;
      else if (colmode == 2) {
        if (j < 1280) { const int P = j & 255; col = (j & ~255) + ((P >> 5) & 3) * 64 + 32 * (P >> 7) + (P & 31); }
        else col = j;
      } else {
        const int P = j & 255, bj = P >> 7, wcc = (P >> 5) & 3, r5 = P & 31;
        if (j < 1024) col = 2560 + ((j >> 8) * 2 + (wcc >> 1)) * 128 + 32 * (wcc & 1) + r5 + 64 * bj;
        else if (wcc < 2) col = 3592 + 32 * (wcc & 1) + r5 + 64 * bj;
        else if (wcc == 2 && bj == 0 && r5 < 8) col = 3584 + r5;
        else col = -1;
      }
#pragma unroll
      for (int i = 0; i < 8; ++i) {
        const int kr = i * 8 + (tid >> 6);
        float v = 0.f;
        if (col >= 0) v = src[(size_t)(k0 + kr) * ld_src + col];
        if (smode == 1) v *= (1.f - mu[k0 + kr]);
        else if (smode == 2) v *= mu[k0 + kr];
        tl[kr * 65 + jn] = v;
      }
    }
    __syncthreads();
    {
      const int kr = tid & 63;
#pragma unroll
      for (int i = 0; i < 8; ++i) {
        const int jn = i * 8 + (tid >> 6);
        float v = tl[kr * 65 + jn];
        u16 hi = fmt ? f2h(v) : f2bf(v);
        size_t o = (size_t)(j0 + jn) * ldd + dst_col0 + k0 + kr;
        dst[o] = hi;
        if (dst_lo) dst_lo[o] = f2bf(v - bf2f(hi));
      }
    }
    __syncthreads();
  }
}

__device__ __forceinline__ void prep_phase(const PAcc& p, char* lds) {
  const int tid = tid_();
  u16* WT = (u16*)(p.pp->ws + WS_WT);
  float* fl = (float*)lds;
  if (blockIdx.x < 192) {
    float* cact = fl;
    float* red = fl + 16384;
    const float* c = p.pp->in[1];
    for (int i = tid; i < 16384; i += NTHR) { int b = i >> 10, k = i & 1023; cact[k * 16 + b] = silu_(c[i]); }
    __syncthreads();
    for (int item = blockIdx.x; item < 192; item += gridDim.x) {
      const int l = item / 48, n0 = (item % 48) * 64;
      const int col = tid & 63, kq = tid >> 6;
      float acc[16];
#pragma unroll
      for (int b = 0; b < 16; ++b) acc[b] = 0.f;
      const float* w = p.pp->in[3] + (size_t)l * 1024 * 3072 + n0 + col;
#pragma unroll 16
      for (int k = kq * 128; k < kq * 128 + 128; ++k) {
        float wv = w[(size_t)k * 3072];
        const float4* cp = (const float4*)(cact + k * 16);
        float4 c0 = cp[0], c1 = cp[1], c2 = cp[2], c3 = cp[3];
        acc[0] += c0.x * wv; acc[1] += c0.y * wv; acc[2] += c0.z * wv; acc[3] += c0.w * wv;
        acc[4] += c1.x * wv; acc[5] += c1.y * wv; acc[6] += c1.z * wv; acc[7] += c1.w * wv;
        acc[8] += c2.x * wv; acc[9] += c2.y * wv; acc[10] += c2.z * wv; acc[11] += c2.w * wv;
        acc[12] += c3.x * wv; acc[13] += c3.y * wv; acc[14] += c3.z * wv; acc[15] += c3.w * wv;
      }
#pragma unroll
      for (int b = 0; b < 16; ++b) red[(kq * 16 + b) * 64 + col] = acc[b];
      __syncthreads();
      for (int o = tid; o < 1024; o += NTHR) {
        int b = o >> 6, cc = o & 63;
        float s = 0.f;
#pragma unroll
        for (int q = 0; q < 8; ++q) s += red[(q * 16 + b) * 64 + cc];
        ((float*)(p.pp->ws + WS_MOD))[((size_t)l * 16 + b) * 3072 + n0 + cc] = s + p.pp->in[4][l * 3072 + n0 + cc];
      }
      __syncthreads();
    }
  }
  __syncthreads();
  {
    const float f128 = p.pp->invf128[tid & 63], f64 = p.pp->invf64[tid & 31];
    float2* r128 = (float2*)(p.pp->ws + WS_ROPE128);
    float2* r64 = (float2*)(p.pp->ws + WS_ROPE64);
    for (int idx = blockIdx.x * NTHR + tid; idx < 2048 * 64; idx += gridDim.x * NTHR) {
      int pos = idx >> 6;
      float ang = (float)pos * f128;
      float c_, s_; sincos_d((double)ang, c_, s_);
      r128[idx] = make_float2(c_, s_);
    }
    for (int idx = blockIdx.x * NTHR + tid; idx < 2048 * 32; idx += gridDim.x * NTHR) {
      int pos = idx >> 5;
      float ang = (float)pos * f64;
      float c_, s_; sincos_d((double)ang, c_, s_);
      r64[idx] = make_float2(c_, s_);
    }
  }
  float* tl = fl;
  tconv_job(p.pp->in[5], 3720, 1024, 2560, 2, 0, 2560, WT + W_DSA_MAIN, nullptr, 1024, 0, nullptr, 0, tl, 1);
  tconv_job(p.pp->in[5], 3720, 1024, 1280, 3, 0, 0, WT + W_DSA_IDX_HI, nullptr, 1024, 0, nullptr, 0, tl, 1);
  tconv_job(p.pp->in[8], 1024, 1024, 1024, 0, 0, 1024, WT + W_DSA_OUT, nullptr, 1024, 0, nullptr, 0, tl);
  tconv_job(p.pp->in[9], 2048, 1024, 2048, 0, 0, 2048, WT + W_LRU_IN, nullptr, 1024, 0, nullptr, 0, tl);
  tconv_job(p.pp->in[17], 1024, 1024, 1024, 0, 0, 1024, WT + W_LRU_OUT, nullptr, 1024, 0, nullptr, 0, tl);
  for (int n = 0; n < 4; ++n) {
    tconv_job(p.pp->in[19] + (size_t)n * 1024 * 1024, 1024, 1024, 1024, 0, 0, 1024, WT + W_RWKV_IN + (size_t)n * 1024 * 2048, nullptr, 2048, 0, p.pp->in[18] + n * 1024, 1, tl);
    tconv_job(p.pp->in[19] + (size_t)n * 1024 * 1024, 1024, 1024, 1024, 0, 0, 1024, WT + W_RWKV_IN + (size_t)n * 1024 * 2048, nullptr, 2048, 1024, p.pp->in[18] + n * 1024, 2, tl);
  }
  tconv_job(p.pp->in[21], 64, 1024, 64, 0, 0, 64, WT + W_RWKV_L1, nullptr, 2048, 0, p.pp->in[18] + 4 * 1024, 1, tl);
  tconv_job(p.pp->in[21], 64, 1024, 64, 0, 0, 64, WT + W_RWKV_L1, nullptr, 2048, 1024, p.pp->in[18] + 4 * 1024, 2, tl);
  tconv_job(p.pp->in[24], 64, 1024, 64, 0, 0, 64, WT + W_RWKV_L1 + 64 * 2048, nullptr, 2048, 0, p.pp->in[18] + 5 * 1024, 1, tl);
  tconv_job(p.pp->in[24], 64, 1024, 64, 0, 0, 64, WT + W_RWKV_L1 + 64 * 2048, nullptr, 2048, 1024, p.pp->in[18] + 5 * 1024, 2, tl);
  tconv_job(p.pp->in[22], 1024, 64, 1024, 0, 0, 1024, WT + W_RWKV_W2, nullptr, 64, 0, nullptr, 0, tl);
  tconv_job(p.pp->in[25], 1024, 64, 1024, 0, 0, 1024, WT + W_RWKV_A2, nullptr, 64, 0, nullptr, 0, tl);
  tconv_job(p.pp->in[31], 1024, 1024, 1024, 0, 0, 1024, WT + W_RWKV_OUT, nullptr, 1024, 0, nullptr, 0, tl);
  tconv_job(p.pp->in[32], 3088, 1024, 3328, 0, 0, 3088, WT + W_GLA_IN, nullptr, 1024, 0, nullptr, 0, tl);
  tconv_job(p.pp->in[36], 1024, 1024, 1024, 0, 0, 1024, WT + W_GLA_OUT, nullptr, 1024, 0, nullptr, 0, tl);
  for (int idx = blockIdx.x * NTHR + tid; idx < 16 * 128 * 64; idx += gridDim.x * NTHR) {
    int n = idx >> 13, pp = (idx >> 6) & 127, k = idx & 63;
    int wc = pp >> 6, jn = (pp >> 4) & 3, fr = pp & 15;
    int type = jn & 1, d = wc * 32 + (jn >> 1) * 16 + fr;
    const float* src = type ? p.pp->in[14] : p.pp->in[12];
    WT[W_LRU_GATE + idx] = f2bf(src[n * 4096 + k * 64 + d]);
  }
}

template <bool SHIFT, bool F16 = false, bool IN16 = false>
__device__ __forceinline__ void norm_phase(const PAcc& p, const void* __restrict__ xin, int layer, u16* __restrict__ Hhi, u16* __restrict__ Hlo) {
  const int lane = tid_() & 63;
  const int gw = blockIdx.x * (NTHR / 64) + (tid_() >> 6);
  const int nw = gridDim.x * (NTHR / 64);
  const float* gain = p.pp->in[2] + layer * 1024;
  const float* mod = (const float*)(p.pp->ws + WS_MOD) + (size_t)layer * 16 * 3072;
  for (int row = gw; row < T_; row += nw) {
    float4 v[4];
    float ss = 0.f;
    if (IN16) {
      const uint2* xr = (const uint2*)((const u16*)xin + (size_t)row * 1024);
#pragma unroll
      for (int i = 0; i < 4; ++i) { const uint2 t = xr[i * 64 + lane]; v[i] = make_float4(bflo(t.x), bfhi(t.x), bflo(t.y), bfhi(t.y)); }
    } else {
      const float4* xr = (const float4*)((const float*)xin + (size_t)row * 1024);
#pragma unroll
      for (int i = 0; i < 4; ++i) v[i] = xr[i * 64 + lane];
    }
#pragma unroll
    for (int i = 0; i < 4; ++i) ss += v[i].x * v[i].x + v[i].y * v[i].y + v[i].z * v[i].z + v[i].w * v[i].w;
#pragma unroll
    for (int m = 32; m >= 1; m >>= 1) ss += __shfl_xor(ss, m);
    const float rstd = rsqrtf(ss * (1.f / 1024.f) + 1e-6f);
    const float* mb = mod + (size_t)(row >> 11) * 3072;
#pragma unroll
    for (int i = 0; i < 4; ++i) {
      const int c = i * 256 + lane * 4;
      float4 g = *(const float4*)(gain + c);
      float4 sh = *(const float4*)(mb + c);
      float4 sc = *(const float4*)(mb + 1024 + c);
      float y0 = v[i].x * rstd * g.x * (1.f + sc.x) + sh.x;
      float y1 = v[i].y * rstd * g.y * (1.f + sc.y) + sh.y;
      float y2 = v[i].z * rstd * g.z * (1.f + sc.z) + sh.z;
      float y3 = v[i].w * rstd * g.w * (1.f + sc.w) + sh.w;
      uint2 o;
      if (F16) { o.x = packh2(y0, y1); o.y = packh2(y2, y3); }
      else { o.x = pack2(y0, y1); o.y = pack2(y2, y3); }
      if (SHIFT) {
        *(uint2*)(Hhi + (size_t)row * 2048 + c) = o;
        if (((row + 1) & 2047) != 0) *(uint2*)(Hhi + (size_t)(row + 1) * 2048 + 1024 + c) = o;
        if ((row & 2047) == 0) *(uint2*)(Hhi + (size_t)row * 2048 + 1024 + c) = make_uint2(0u, 0u);
      } else {
        *(uint2*)(Hhi + (size_t)row * 1024 + c) = o;
      }
      if (!SHIFT && Hlo) {
        uint2 l;
        l.x = packh2(y0 - hlo(o.x), y1 - hhi(o.x));
        l.y = packh2(y2 - hlo(o.y), y3 - hhi(o.y));
        *(uint2*)(Hlo + (size_t)row * 1024 + c) = l;
      }
    }
  }
}

enum { EPI_PLAIN = 0, EPI_DSA_MAIN, EPI_DSA_IDX, EPI_RESID, EPI_RWKV_L1, EPI_RWKV_W, EPI_RWKV_A };
struct EpiP {
  u16* o16; u16* o16b; u16* o16c; u16* o16d; float* of; const float* f0; const float* f1; const float* f2; const float* f3;
  int ldc; int nvalid;
};
constexpr int LROW = 40;

template <int EPI>
__device__ __forceinline__ void gemm_epilogue(const EpiP& e, const PAcc& p, f32x4 (&acc)[4][4], int rowbase, int colbase, int nt, int wc, int fr, int fq) {
  if (EPI == EPI_PLAIN) {
#pragma unroll
    for (int i = 0; i < 4; ++i)
#pragma unroll
      for (int j = 0; j < 4; ++j) {
        const int col = colbase + j * 16 + fr;
        if (col < e.nvalid) {
#pragma unroll
          for (int r = 0; r < 4; ++r) e.o16[(size_t)(rowbase + i * 16 + fq * 4 + r) * e.ldc + col] = f2bf(acc[i][j][r]);
        }
      }
  } else if (EPI == EPI_DSA_MAIN) {
    if (nt < 10) {
      const float* gain = (nt < 8) ? e.f0 : e.f1;
      const float g0 = gain[fr], g1 = gain[16 + fr], g2 = gain[32 + fr], g3 = gain[48 + fr];
      const float2* rope = (const float2*)(p.pp->ws + WS_ROPE64);
#pragma unroll
      for (int i = 0; i < 4; ++i)
#pragma unroll
        for (int r = 0; r < 4; ++r) {
          float v0 = acc[i][0][r], v1 = acc[i][1][r], v2 = acc[i][2][r], v3 = acc[i][3][r];
          float ss = v0 * v0 + v1 * v1 + v2 * v2 + v3 * v3;
          ss += __shfl_xor(ss, 1); ss += __shfl_xor(ss, 2); ss += __shfl_xor(ss, 4); ss += __shfl_xor(ss, 8);
          const float rstd = rsqrtf(ss * (1.f / 64.f) + 1e-6f);
          v0 *= rstd * g0; v1 *= rstd * g1; v2 *= rstd * g2; v3 *= rstd * g3;
          const int row = rowbase + i * 16 + fq * 4 + r;
          const int pos = row & 2047;
          const float2 ca = rope[pos * 32 + fr], cb = rope[pos * 32 + 16 + fr];
          const float o0 = v0 * ca.x - v2 * ca.y, o2 = v2 * ca.x + v0 * ca.y;
          const float o1 = v1 * cb.x - v3 * cb.y, o3 = v3 * cb.x + v1 * cb.y;
          u16* d = e.o16 + (size_t)row * 2560 + colbase + fr;
          d[0] = f2bf(o0); d[16] = f2bf(o1); d[32] = f2bf(o2); d[48] = f2bf(o3);
        }
    } else {
#pragma unroll
      for (int i = 0; i < 4; ++i)
#pragma unroll
        for (int j = 0; j < 4; ++j)
#pragma unroll
          for (int r = 0; r < 4; ++r) e.o16[(size_t)(rowbase + i * 16 + fq * 4 + r) * 2560 + colbase + j * 16 + fr] = f2bf(acc[i][j][r]);
    }
  } else if (EPI == EPI_DSA_IDX) {
    if (nt < 9) {
      const float2* rope = (const float2*)(p.pp->ws + WS_ROPE128);
#pragma unroll
      for (int i = 0; i < 4; ++i)
#pragma unroll
        for (int r = 0; r < 4; ++r) {
          const int row = rowbase + i * 16 + fq * 4 + r;
          const int pos = row & 2047;
#pragma unroll
          for (int jj = 0; jj < 2; ++jj) {
            const int ii = wc * 32 + jj * 16 + fr;
            const float2 cs = rope[pos * 64 + ii];
            const float x1 = acc[i][jj][r], x2 = acc[i][jj + 2][r];
            const float o1 = x1 * cs.x - x2 * cs.y, o2 = x2 * cs.x + x1 * cs.y;
            const u16 h1 = f2bf(o1), h2 = f2bf(o2);
            const u16 l1 = f2bf(o1 - bf2f(h1)), l2 = f2bf(o2 - bf2f(h2));
            if (nt < 8) {
              size_t o = (size_t)row * 1024 + nt * 128 + ii;
              e.o16[o] = h1; e.o16[o + 64] = h2; e.o16b[o] = l1; e.o16b[o + 64] = l2;
            } else {
              size_t o = (size_t)row * 128 + ii;
              e.o16c[o] = h1; e.o16c[o + 64] = h2; e.o16d[o] = l1; e.o16d[o + 64] = l2;
            }
          }
        }
    } else {
      if (wc == 0 && fr < 8) {
#pragma unroll
        for (int i = 0; i < 4; ++i)
#pragma unroll
          for (int r = 0; r < 4; ++r) e.of[(size_t)(rowbase + i * 16 + fq * 4 + r) * 8 + fr] = acc[i][0][r] * 0.03125f;
      }
    }
  } else if (EPI == EPI_RESID) {
#pragma unroll
    for (int i = 0; i < 4; ++i)
#pragma unroll
      for (int j = 0; j < 4; ++j) {
        const int col = colbase + j * 16 + fr;
#pragma unroll
        for (int r = 0; r < 4; ++r) {
          const int row = rowbase + i * 16 + fq * 4 + r;
          const float gate = e.f1[(size_t)(row >> 11) * 3072 + 2048 + col];
          const size_t o = (size_t)row * 1024 + col;
          e.of[o] = e.f0[o] + gate * acc[i][j][r];
        }
      }
  } else if (EPI == EPI_RWKV_L1) {
#pragma unroll
    for (int i = 0; i < 4; ++i)
#pragma unroll
      for (int j = 0; j < 4; ++j) {
        const int col = colbase + j * 16 + fr;
#pragma unroll
        for (int r = 0; r < 4; ++r) {
          float v = acc[i][j][r];
          if (col < 64) v = tanhf(v);
          e.o16[(size_t)(rowbase + i * 16 + fq * 4 + r) * 128 + col] = f2bf(v);
        }
      }
  } else if (EPI == EPI_RWKV_W) {
#pragma unroll
    for (int i = 0; i < 4; ++i)
#pragma unroll
      for (int j = 0; j < 4; ++j) {
        const int col = colbase + j * 16 + fr;
        const float w0 = e.f0[col];
#pragma unroll
        for (int r = 0; r < 4; ++r) {
          const float w = w0 + acc[i][j][r];
          e.of[(size_t)(rowbase + i * 16 + fq * 4 + r) * 1024 + col] = __expf(-softplus_(-w) - 0.5f);
        }
      }
  } else if (EPI == EPI_RWKV_A) {
#pragma unroll
    for (int i = 0; i < 4; ++i)
#pragma unroll
      for (int j = 0; j < 4; ++j) {
        const int col = colbase + j * 16 + fr;
        const float a0 = e.f0[col];
#pragma unroll
        for (int r = 0; r < 4; ++r)
          e.o16[(size_t)(rowbase + i * 16 + fq * 4 + r) * 1024 + col] = f2bf(sigmoid_(a0 + acc[i][j][r]));
      }
  }
}

template <int EPI>
__device__ __forceinline__ void gemm_phase(const PAcc& p, const u16* A0, const u16* A1, const u16* A2, const u16* B0, const u16* B1, const u16* B2,
                           int lda, int ldb, int kseg, int nseg, int shiftmask, int ntn, const EpiP& e, char* ldsc) {
  const int tid = tid_(), lane = tid & 63, wave = tid >> 6;
  const int wr = wave >> 1, wc = wave & 1, fr = lane & 15, fq = lane >> 4;
  u16* As = (u16*)ldsc;
  u16* Bs = As + 2 * 256 * LROW;
  const int kps = kseg >> 5;
  const int nk = nseg * kps;
  const int ntiles = 128 * ntn;
  const int lrow = tid >> 2, lkc = (tid & 3) * 8;
  for (int tile = blockIdx.x; tile < ntiles; tile += gridDim.x) {
    const int mt = tile / ntn, nt = tile - mt * ntn;
    const int m0 = mt * 256, n0 = nt * 128;
    f32x4 acc[4][4];
#pragma unroll
    for (int i = 0; i < 4; ++i)
#pragma unroll
      for (int j = 0; j < 4; ++j) acc[i][j] = (f32x4){0.f, 0.f, 0.f, 0.f};
    uint4 ra0, ra1, rb;
#define GLOAD(ks_)                                                                           \
  {                                                                                          \
    const int s_ = (ks_) / kps;                                                              \
    const int kk_ = ((ks_) - s_ * kps) << 5;                                                 \
    const u16* Ap_ = s_ == 0 ? A0 : (s_ == 1 ? A1 : A2);                                     \
    const u16* Bp_ = s_ == 0 ? B0 : (s_ == 1 ? B1 : B2);                                     \
    const int sh_ = (shiftmask >> s_) & 1;                                                   \
    const int g0_ = m0 + lrow, g1_ = m0 + 128 + lrow;                                        \
    ra0 = (sh_ && (g0_ & 2047) == 0) ? make_uint4(0, 0, 0, 0) : *(const uint4*)(Ap_ + (size_t)(g0_ - sh_) * lda + kk_ + lkc); \
    ra1 = (sh_ && (g1_ & 2047) == 0) ? make_uint4(0, 0, 0, 0) : *(const uint4*)(Ap_ + (size_t)(g1_ - sh_) * lda + kk_ + lkc); \
    rb = *(const uint4*)(Bp_ + (size_t)(n0 + lrow) * ldb + kk_ + lkc);                       \
  }
#define LSTORE(buf_)                                                                         \
  {                                                                                          \
    *(uint4*)(As + ((buf_) * 256 + lrow) * LROW + lkc) = ra0;                                \
    *(uint4*)(As + ((buf_) * 256 + 128 + lrow) * LROW + lkc) = ra1;                          \
    *(uint4*)(Bs + ((buf_) * 128 + lrow) * LROW + lkc) = rb;                                 \
  }
    GLOAD(0);
    LSTORE(0);
    __syncthreads();
    for (int ks = 0; ks < nk; ++ks) {
      const int buf = ks & 1;
      if (ks + 1 < nk) GLOAD(ks + 1);
      bf16x8 af[4], bfr[4];
#pragma unroll
      for (int i = 0; i < 4; ++i) af[i] = *(const bf16x8*)(As + (buf * 256 + wr * 64 + i * 16 + fr) * LROW + fq * 8);
#pragma unroll
      for (int j = 0; j < 4; ++j) bfr[j] = *(const bf16x8*)(Bs + (buf * 128 + wc * 64 + j * 16 + fr) * LROW + fq * 8);
#pragma unroll
      for (int i = 0; i < 4; ++i)
#pragma unroll
        for (int j = 0; j < 4; ++j) acc[i][j] = mfma16(af[i], bfr[j], acc[i][j]);
      if (ks + 1 < nk) LSTORE(buf ^ 1);
      __syncthreads();
    }
#undef GLOAD
#undef LSTORE
    gemm_epilogue<EPI>(e, p, acc, m0 + wr * 64, n0 + wc * 64, nt, wc, fr, fq);
  }
}


namespace pg8 {
#define PG8_LAS __attribute__((address_space(3)))
typedef unsigned u32x4 __attribute__((ext_vector_type(4)));
constexpr int BM = 256, BK = 64, HALF = 128, HTB = HALF * BK * 2, NXCD = 8, WGM = 8;
__device__ __forceinline__ int lds_byte(int r, int c) { const int st = (r >> 4) * 2 + (c >> 5), rr = r & 15, cc = c & 31, ob = rr * 64 + cc * 2; return st * 1024 + (ob ^ (((ob >> 9) & 1) << 5)); }
__device__ __forceinline__ void stage_rc(int b, int& R, int& C) { const int st = b / 1024, sb = b % 1024, swz = sb ^ (((sb >> 9) & 1) << 5); R = (st >> 1) * 16 + swz / 64; C = (st & 1) * 32 + (swz % 64) / 2; }
__device__ __forceinline__ int perm32(int rho) { const int n = rho >> 4, i = rho & 15; return 8 * (i >> 2) + 4 * n + (i & 3); }
struct Unit { int pm, pn; };
struct GemmD { const u16 *A0, *A1, *A2, *B0, *B1, *B2; int lda, ldb, lgnts, nseg, M, N; };
struct StaticOrder {
  int nM, nN, nwg, G, c;
  __device__ void init(int M, int N, int G_, int c_) { nM = M / BM; nN = N / BM; nwg = nM * nN; G = G_; c = c_; }
  __device__ bool next(int i, Unit& u) const {
    const long L = (long)i * G + c; if (L >= nwg) return false;
    int wgid = (int)L; { const int q = nwg / NXCD, r = nwg % NXCD, xcd = wgid % NXCD, off = wgid / NXCD; wgid = (xcd < r ? xcd * (q + 1) : r * (q + 1) + (xcd - r) * q) + off; }
    const int nig = WGM * nN, gid = wgid / nig, fm = gid * WGM, gsz = (nM - fm) < WGM ? (nM - fm) : WGM;
    u.pm = fm + ((wgid % nig) % gsz); u.pn = (wgid % nig) / gsz; return true;
  }
};
__device__ __forceinline__ unsigned cvt_pk_bf16(float lo, float hi) { unsigned r; asm volatile("v_cvt_pk_bf16_f32 %0, %1, %2" : "=v"(r) : "v"(lo), "v"(hi)); return r; }

struct EpiPlain {
  static constexpr bool PERM = true;
  u16* O; int ldc; int nvalid;
  __device__ __forceinline__ void operator()(const f32x4 (&acc)[2][2][4][2], const Unit& u, int wr, int wc, int fr, int fq) const {
    asm volatile("" : "+v"(fr), "+v"(fq));
    const int row0 = u.pm * BM + wr * 64 + fr, col0 = u.pn * BM + wc * 32 + 8 * fq;
#pragma unroll
    for (int ai = 0; ai < 2; ++ai)
#pragma unroll
      for (int m = 0; m < 4; ++m) {
        u16* rowp = O + (size_t)(row0 + ai * HALF + m * 16) * ldc;
#pragma unroll
        for (int bj = 0; bj < 2; ++bj) {
          const int col = col0 + bj * HALF;
          if (col < nvalid) {
            const f32x4 v0 = acc[ai][bj][m][0], v1 = acc[ai][bj][m][1];
            u32x4 w; w.x = cvt_pk_bf16(v0[0], v0[1]); w.y = cvt_pk_bf16(v0[2], v0[3]); w.z = cvt_pk_bf16(v1[0], v1[1]); w.w = cvt_pk_bf16(v1[2], v1[3]);
            *(u32x4*)(rowp + col) = w;
          }
        }
      }
  }
};
template <bool IN16, bool OUT16>
struct EpiResid {
  static constexpr bool PERM = true;
  void* out; const void* xin; const float* mod;
  __device__ __forceinline__ void operator()(const f32x4 (&acc)[2][2][4][2], const Unit& u, int wr, int wc, int fr, int fq) const {
    asm volatile("" : "+v"(fr), "+v"(fq));
    const int row0 = u.pm * BM + wr * 64 + fr, col0 = u.pn * BM + wc * 32 + 8 * fq;
#pragma unroll
    for (int ai = 0; ai < 2; ++ai)
#pragma unroll
      for (int m = 0; m < 4; ++m) {
        const int row = row0 + ai * HALF + m * 16;
        const float* gp = mod + (size_t)(row >> 11) * 3072 + 2048;
#pragma unroll
        for (int bj = 0; bj < 2; ++bj) {
          const int col = col0 + bj * HALF;
          const size_t o = (size_t)row * 1024 + col;
          const f32x4 g0 = *(const f32x4*)(gp + col), g1 = *(const f32x4*)(gp + col + 4);
          f32x4 x0, x1;
          if (IN16) {
            const u32x4 xv = *(const u32x4*)((const u16*)xin + o);
            x0 = (f32x4){bflo(xv.x), bfhi(xv.x), bflo(xv.y), bfhi(xv.y)};
            x1 = (f32x4){bflo(xv.z), bfhi(xv.z), bflo(xv.w), bfhi(xv.w)};
          } else {
            x0 = *(const f32x4*)((const float*)xin + o); x1 = *(const f32x4*)((const float*)xin + o + 4);
          }
          const f32x4 y0 = x0 + g0 * acc[ai][bj][m][0], y1 = x1 + g1 * acc[ai][bj][m][1];
          if (OUT16) {
            u32x4 w; w.x = cvt_pk_bf16(y0[0], y0[1]); w.y = cvt_pk_bf16(y0[2], y0[3]); w.z = cvt_pk_bf16(y1[0], y1[1]); w.w = cvt_pk_bf16(y1[2], y1[3]);
            *(u32x4*)((u16*)out + o) = w;
          } else {
            *(f32x4*)((float*)out + o) = y0; *(f32x4*)((float*)out + o + 4) = y1;
          }
        }
      }
  }
};
struct EpiDsaMain {
  static constexpr bool PERM = true;
  u16* O; const float* qg; const float* kg; const float2* rope; u16* VT;
  __device__ __forceinline__ void operator()(const f32x4 (&acc)[2][2][4][2], const Unit& u, int wr, int wc, int fr, int fq) const {
    asm volatile("" : "+v"(fr), "+v"(fq));
    const int row0 = u.pm * BM + wr * 64 + fr;
    if (u.pn <= 4) {
      const float* gain = (u.pn < 4) ? qg : kg;
      const int cb = u.pn * 256 + wc * 64 + 8 * fq;
#pragma unroll
      for (int ai = 0; ai < 2; ++ai)
#pragma unroll
        for (int m = 0; m < 4; ++m) {
          const int row = row0 + ai * HALF + m * 16;
          float ss = 0.f;
#pragma unroll
          for (int n = 0; n < 2; ++n)
#pragma unroll
            for (int j = 0; j < 4; ++j) { const float x = acc[ai][0][m][n][j], y = acc[ai][1][m][n][j]; ss += x * x + y * y; }
          ss += __shfl_xor(ss, 16); ss += __shfl_xor(ss, 32);
          const float rstd = rsqrtf(ss * (1.f / 64.f) + 1e-6f);
          const float2* rp = rope + (row & 2047) * 32 + 8 * fq;
          u16* d = O + (size_t)row * 2560 + cb;
#pragma unroll
          for (int n = 0; n < 2; ++n) {
            float ol[4], oh[4];
#pragma unroll
            for (int j = 0; j < 4; ++j) {
              const int e = 4 * n + j;
              const float2 cs = rp[e];
              const float xn = acc[ai][0][m][n][j] * rstd * gain[8 * fq + e], yn = acc[ai][1][m][n][j] * rstd * gain[32 + 8 * fq + e];
              ol[j] = xn * cs.x - yn * cs.y; oh[j] = yn * cs.x + xn * cs.y;
            }
            uint2 w; w.x = cvt_pk_bf16(ol[0], ol[1]); w.y = cvt_pk_bf16(ol[2], ol[3]);
            *(uint2*)(d + 4 * n) = w;
            w.x = cvt_pk_bf16(oh[0], oh[1]); w.y = cvt_pk_bf16(oh[2], oh[3]);
            *(uint2*)(d + 32 + 4 * n) = w;
          }
        }
    } else if (u.pn == 5) {
#pragma unroll
      for (int ai = 0; ai < 2; ++ai)
#pragma unroll
        for (int m = 0; m < 4; ++m) {
          const int row = row0 + ai * HALF + m * 16;
          u16* vb = VT + (size_t)(row >> 11) * 256 * 2048 + (row & 2047);
#pragma unroll
          for (int bj = 0; bj < 2; ++bj)
#pragma unroll
            for (int n = 0; n < 2; ++n)
#pragma unroll
              for (int j = 0; j < 4; ++j) vb[(size_t)(128 * bj + 32 * wc + 8 * fq + 4 * n + j) * 2048] = f2bf(acc[ai][bj][m][n][j]);
        }
    } else {
      const int col0 = u.pn * BM + wc * 32 + 8 * fq;
#pragma unroll
      for (int ai = 0; ai < 2; ++ai)
#pragma unroll
        for (int m = 0; m < 4; ++m) {
          u16* rowp = O + (size_t)(row0 + ai * HALF + m * 16) * 2560 + col0;
#pragma unroll
          for (int bj = 0; bj < 2; ++bj) {
            const f32x4 v0 = acc[ai][bj][m][0], v1 = acc[ai][bj][m][1];
            u32x4 w; w.x = cvt_pk_bf16(v0[0], v0[1]); w.y = cvt_pk_bf16(v0[2], v0[3]); w.z = cvt_pk_bf16(v1[0], v1[1]); w.w = cvt_pk_bf16(v1[2], v1[3]);
            *(u32x4*)(rowp + bj * HALF) = w;
          }
        }
    }
  }
};
struct EpiDsaIdx {
  static constexpr bool PERM = true;
  u16 *qh, *ql, *kh, *kl; float* wi; const float2* rope;
  __device__ __forceinline__ void operator()(const f32x4 (&acc)[2][2][4][2], const Unit& u, int wr, int wc, int fr, int fq) const {
    asm volatile("" : "+v"(fr), "+v"(fq));
    const int row0 = u.pm * BM + wr * 64 + fr;
    if (u.pn < 4 || wc < 2) {
      const int dl = 32 * (wc & 1) + 8 * fq;
      u16* dh; size_t ld; int cb;
      if (u.pn < 4) { dh = qh; ld = 1024; cb = (u.pn * 2 + (wc >> 1)) * 128 + dl; }
      else { dh = kh; ld = 128; cb = dl; }
#pragma unroll
      for (int ai = 0; ai < 2; ++ai)
#pragma unroll
        for (int m = 0; m < 4; ++m) {
          const int row = row0 + ai * HALF + m * 16;
          const float2* rp = rope + (row & 2047) * 64 + dl;
          const size_t o = (size_t)row * ld + cb;
#pragma unroll
          for (int n = 0; n < 2; ++n) {
            float o1[4], o2[4];
#pragma unroll
            for (int j = 0; j < 4; ++j) {
              const float2 cs = rp[4 * n + j];
              const float x = acc[ai][0][m][n][j], y = acc[ai][1][m][n][j];
              o1[j] = x * cs.x - y * cs.y; o2[j] = y * cs.x + x * cs.y;
            }
            uint2 h1, h2;
            h1.x = packh2(o1[0], o1[1]); h1.y = packh2(o1[2], o1[3]);
            h2.x = packh2(o2[0], o2[1]); h2.y = packh2(o2[2], o2[3]);
            *(uint2*)(dh + o + 4 * n) = h1; *(uint2*)(dh + o + 64 + 4 * n) = h2;
          }
        }
    } else if (wc == 2 && fq == 0) {
#pragma unroll
      for (int ai = 0; ai < 2; ++ai)
#pragma unroll
        for (int m = 0; m < 4; ++m) {
          const int row = row0 + ai * HALF + m * 16;
          *(f32x4*)(wi + (size_t)row * 8) = acc[ai][0][m][0] * 0.03125f;
          *(f32x4*)(wi + (size_t)row * 8 + 4) = acc[ai][0][m][1] * 0.03125f;
        }
    }
  }
};

template <class Epi, bool F16>
__device__ __forceinline__ void gemm_phase(PG8_LAS unsigned char* lds, const GemmD g, const StaticOrder& S, const Epi& E) {
  const int tid = tid_(), wid = __builtin_amdgcn_readfirstlane(tid >> 6), lane = tid & 63, wr = wid >> 2, wc = wid & 3, fr = lane & 15, fq = lane >> 4;
  const int lg = g.lgnts, nts = 1 << lg, nt = nts * g.nseg;
  unsigned voffA[2], voffB[2];
#pragma unroll
  for (int i = 0; i < 2; ++i) { int R, C; stage_rc(tid * 16 + i * 8192, R, C); const int Rb = Epi::PERM ? ((R & ~31) + perm32(R & 31)) : R;
    voffA[i] = (unsigned)(R * g.lda + C) * 2u; voffB[i] = (unsigned)(Rb * g.ldb + C) * 2u; }
  const size_t kstep = (size_t)(BK * 2);
  const size_t hstepA = (size_t)HALF * g.lda * 2, hstepB = (size_t)HALF * g.ldb * 2;
  const size_t tstepA = 2 * hstepA, tstepB = 2 * hstepB;
  const unsigned ldsw = (unsigned)wid * 1024u;
  const int aoff = lds_byte(wr * 64 + fr, fq * 8), boff = lds_byte(wc * 32 + fr, fq * 8);
#define PG8_APTR(pm_, t_) ((const char*)((((t_) >> lg) == 0) ? g.A0 : ((((t_) >> lg) == 1) ? g.A1 : g.A2)) + (size_t)(pm_) * tstepA + (size_t)((t_) & (nts - 1)) * kstep)
#define PG8_BPTR(pn_, t_) ((const char*)((((t_) >> lg) == 0) ? g.B0 : ((((t_) >> lg) == 1) ? g.B1 : g.B2)) + (size_t)(pn_) * tstepB + (size_t)((t_) & (nts - 1)) * kstep)
#define PG8_SA(b, h) (((b) * 2 + (h)) * HTB)
#define PG8_SB(b, h) ((4 + (b) * 2 + (h)) * HTB)
#define PG8_STAGE(bufoff, gbase, voff) do { _Pragma("unroll") for (int _i = 0; _i < 2; ++_i) \
    __builtin_amdgcn_global_load_lds((const unsigned*)((const char*)(gbase) + (voff)[_i]), (PG8_LAS unsigned*)(lds + (bufoff) + ldsw + _i * 8192), 16, 0, 0); } while (0)
#define PG8_LDA(dst, b, h) do { _Pragma("unroll") for (int m = 0; m < 4; ++m) _Pragma("unroll") for (int k = 0; k < 2; ++k) dst[m][k] = *(const PG8_LAS bf16x8*)(lds + PG8_SA(b, h) + aoff + m * 2048 + k * 1024); } while (0)
#define PG8_LDB(dst, b, h) do { _Pragma("unroll") for (int n = 0; n < 2; ++n) _Pragma("unroll") for (int k = 0; k < 2; ++k) dst[n][k] = *(const PG8_LAS bf16x8*)(lds + PG8_SB(b, h) + boff + n * 2048 + k * 1024); } while (0)
#define PG8_MMA(ai, bj, At, Bt) do { __builtin_amdgcn_s_setprio(1); _Pragma("unroll") for (int m = 0; m < 4; ++m) _Pragma("unroll") for (int n = 0; n < 2; ++n) _Pragma("unroll") for (int k = 0; k < 2; ++k) \
    acc[ai][bj][m][n] = F16 ? mfma16h(Bt[n][k], At[m][k], acc[ai][bj][m][n]) : __builtin_amdgcn_mfma_f32_16x16x32_bf16(Bt[n][k], At[m][k], acc[ai][bj][m][n], 0, 0, 0); __builtin_amdgcn_s_setprio(0); } while (0)
#define PG8_WAIT_V(n) asm volatile("s_waitcnt vmcnt(" #n ")" ::: "memory")
#define PG8_WAIT_L(n) asm volatile("s_waitcnt lgkmcnt(" #n ")" ::: "memory")
#define PG8_BAR __builtin_amdgcn_s_barrier()
#define PG8_SCHED __builtin_amdgcn_sched_barrier(0)
  Unit cur, nxt; int ui = 0;
  if (!S.next(0, cur)) return;
  f32x4 acc[2][2][4][2];
#pragma unroll
  for (int a = 0; a < 2; ++a)
#pragma unroll
    for (int b = 0; b < 2; ++b)
#pragma unroll
      for (int m = 0; m < 4; ++m)
#pragma unroll
        for (int n = 0; n < 2; ++n) acc[a][b][m][n] = (f32x4){0.f, 0.f, 0.f, 0.f};
  bf16x8 At[4][2], B0[2][2], B1[2][2];
  {
    const char* cA = PG8_APTR(cur.pm, 0); const char* cB = PG8_BPTR(cur.pn, 0);
    PG8_STAGE(PG8_SB(0, 0), cB, voffB); PG8_STAGE(PG8_SA(0, 0), cA, voffA); PG8_STAGE(PG8_SB(0, 1), cB + hstepB, voffB); PG8_STAGE(PG8_SA(0, 1), cA + hstepA, voffA);
    if (wr == 1) PG8_BAR;
    PG8_WAIT_V(4); PG8_BAR;
    PG8_STAGE(PG8_SB(1, 0), cB + kstep, voffB); PG8_STAGE(PG8_SA(1, 0), cA + kstep, voffA); PG8_STAGE(PG8_SB(1, 1), cB + hstepB + kstep, voffB);
    PG8_WAIT_V(6); PG8_BAR;
  }
  for (;;) {
    const bool has_next = S.next(ui + 1, nxt);
    const int npm = has_next ? nxt.pm : cur.pm, npn = has_next ? nxt.pn : cur.pn;
    for (int t = 0; t < nt; t += 2) {
      const bool last = (t == nt - 2);
      const char* a1 = PG8_APTR(cur.pm, t + 1);
      const char* a2 = last ? PG8_APTR(npm, 0) : PG8_APTR(cur.pm, t + 2);
      const char* b2 = last ? PG8_BPTR(npn, 0) : PG8_BPTR(cur.pn, t + 2);
      const char* a3 = a2 + kstep; const char* b3 = b2 + kstep;
      PG8_LDB(B0, 0, 0); PG8_SCHED; PG8_LDA(At, 0, 0); PG8_STAGE(PG8_SA(1, 1), a1 + hstepA, voffA);
      PG8_WAIT_L(8); PG8_BAR; PG8_WAIT_L(0); PG8_MMA(0, 0, At, B0); PG8_BAR; PG8_SCHED;
      PG8_LDB(B1, 0, 1); PG8_STAGE(PG8_SB(0, 0), b2, voffB);
      PG8_BAR; PG8_WAIT_L(0); PG8_MMA(0, 1, At, B1); PG8_BAR;
      PG8_LDA(At, 0, 1); PG8_STAGE(PG8_SA(0, 0), a2, voffA);
      PG8_BAR; PG8_WAIT_L(0); PG8_MMA(1, 0, At, B0); PG8_BAR; PG8_SCHED;
      PG8_STAGE(PG8_SB(0, 1), b2 + hstepB, voffB);
      PG8_WAIT_V(6); PG8_BAR; PG8_MMA(1, 1, At, B1); PG8_BAR;
      PG8_LDB(B0, 1, 0); PG8_SCHED; PG8_LDA(At, 1, 0); PG8_STAGE(PG8_SA(0, 1), a2 + hstepA, voffA);
      PG8_WAIT_L(8); PG8_BAR; PG8_WAIT_L(0); PG8_MMA(0, 0, At, B0); PG8_BAR; PG8_SCHED;
      PG8_LDB(B1, 1, 1); PG8_STAGE(PG8_SB(1, 0), b3, voffB);
      PG8_BAR; PG8_WAIT_L(0); PG8_MMA(0, 1, At, B1); PG8_BAR;
      PG8_LDA(At, 1, 1); PG8_STAGE(PG8_SA(1, 0), a3, voffA);
      PG8_BAR; PG8_WAIT_L(0); PG8_MMA(1, 0, At, B0); PG8_BAR; PG8_SCHED;
      PG8_STAGE(PG8_SB(1, 1), b3 + hstepB, voffB);
      PG8_WAIT_V(6); PG8_BAR; PG8_MMA(1, 1, At, B1); PG8_BAR;
    }
    E(acc, cur, wr, wc, fr, fq);
    if (!has_next) break;
#pragma unroll
    for (int a = 0; a < 2; ++a)
#pragma unroll
      for (int b = 0; b < 2; ++b)
#pragma unroll
        for (int m = 0; m < 4; ++m)
#pragma unroll
          for (int n = 0; n < 2; ++n) acc[a][b][m][n] = (f32x4){0.f, 0.f, 0.f, 0.f};
    cur = nxt; ++ui;
  }
  PG8_WAIT_V(0);
  if (wr == 0) PG8_BAR;
  PG8_BAR;
#undef PG8_APTR
#undef PG8_BPTR
#undef PG8_SA
#undef PG8_SB
#undef PG8_STAGE
#undef PG8_LDA
#undef PG8_LDB
#undef PG8_MMA
#undef PG8_WAIT_V
#undef PG8_WAIT_L
#undef PG8_BAR
#undef PG8_SCHED
}
template <class Epi, bool F16 = false>
__device__ __forceinline__ void run(char* lds, const u16* A0, const u16* A1, const u16* A2, const u16* B0, const u16* B1, const u16* B2,
                                    int lda, int ldb, int lgnts, int nseg, int N, const Epi& E) {
  GemmD g; g.A0 = A0; g.A1 = A1; g.A2 = A2; g.B0 = B0; g.B1 = B1; g.B2 = B2; g.lda = lda; g.ldb = ldb; g.lgnts = lgnts; g.nseg = nseg; g.M = T_; g.N = N;
  StaticOrder S; S.init(T_, N, (int)gridDim.x, (int)blockIdx.x);
  gemm_phase<Epi, F16>((PG8_LAS unsigned char*)lds, g, S, E);
}
}


template <int NE>
__device__ __forceinline__ void topk_row(const float* __restrict__ srow, int qpos, int lane, unsigned* __restrict__ mrow) {
  unsigned uk[NE];
#pragma unroll
  for (int e = 0; e < NE; ++e) {
    const int key = e * 64 + lane;
    const float v = srow[key];
    unsigned uu = __float_as_uint(v);
    uu = (uu & 0x80000000u) ? ~uu : (uu | 0x80000000u);
    uk[e] = (key <= qpos) ? uu : 0u;
  }
  unsigned prefix = 0u;
  for (int bit = 31; bit >= 0; --bit) {
    const unsigned cand = prefix | (1u << bit);
    int cnt = 0;
#pragma unroll
    for (int e = 0; e < NE; ++e) cnt += __popcll(__ballot(uk[e] >= cand));
    if (cnt >= 256) { prefix = cand; if (cnt == 256) break; }
  }
  int cgt = 0;
#pragma unroll
  for (int e = 0; e < NE; ++e) cgt += __popcll(__ballot(uk[e] > prefix));
  const int need = 256 - cgt;
  int eqused = 0;
  const unsigned long long lt = (1ull << lane) - 1ull;
#pragma unroll
  for (int e = 0; e < NE; ++e) {
    const bool gt = uk[e] > prefix, eq = uk[e] == prefix;
    const unsigned long long meq = __ballot(eq);
    const bool take = gt || (eq && (eqused + __popcll(meq & lt)) < need);
    const unsigned long long ms = __ballot(take);
    if (lane == 0) { mrow[2 * e] = (unsigned)ms; mrow[2 * e + 1] = (unsigned)(ms >> 32); }
    eqused += __popcll(meq);
  }
}

__device__ __forceinline__ void dsa_unit_phase(const PAcc& p, char* lds, bool st) {
  u16* qihi = (u16*)lds;
  unsigned* MASK = (unsigned*)lds;
  const u16* VT = (const u16*)(p.pp->ws + DSA_VT);
  float* wis = (float*)(lds + 73728);
  u16* QKVG = (u16*)(p.pp->ws + DSA_QKVG);
  const u16* QIH = (const u16*)(p.pp->ws + DSA_QIHI);
  const u16* KIH = (const u16*)(p.pp->ws + DSA_KIHI);
  const float* WI = (const float*)(p.pp->ws + DSA_WI);
  float* scr = (float*)(p.pp->ws + DSA_SCR) + (size_t)blockIdx.x * 16 * 2048;

  const bool xmap = (gridDim.x == 256);
  for (int u = blockIdx.x; u < 2048; u += gridDim.x) {
    const int tid = tid_(), lane = tid & 63, wave = tid >> 6, fr = lane & 15, fq = lane >> 4;
    int qt, b;
    if (xmap) { const int v = (blockIdx.x >> 3) + 32 * (u >> 8); b = 2 * (blockIdx.x & 7) + (v & 1); qt = 127 - (v >> 1); }
    else { qt = 127 - (u >> 4); b = u & 15; }
    const int q0 = qt * 16;
    const size_t tok0 = (size_t)b * 2048 + q0;
    const bool full = (q0 < 256);
    if (!full) {
#pragma unroll
      for (int i = 0; i < 4; ++i) {
        const int c = tid + i * NTHR;
        const int row = c >> 7, ch = c & 127;
        *(uint4*)(qihi + row * 1032 + ch * 8) = *(const uint4*)(QIH + (tok0 + row) * 1024 + ch * 8);
      }
      if (tid < 128) wis[tid] = WI[tok0 * 8 + tid];
      __syncthreads();
      const int nkeys = q0 + 16;
      const int nch = (nkeys + 31) >> 5;
      for (int rep_ = 0; rep_ < ((DUP == 6) ? 2 : 1); ++rep_)
      for (int c = wave; c < nch; c += 8) {
        const int kbase = c * 32;
        bf16x8 khi[2][4];
#pragma unroll
        for (int mt = 0; mt < 2; ++mt)
#pragma unroll
          for (int ks = 0; ks < 4; ++ks) {
            const size_t o = ((size_t)b * 2048 + kbase + mt * 16 + fr) * 128 + ks * 32 + fq * 8;
            khi[mt][ks] = *(const bf16x8*)(KIH + o);
          }
        f32x4 sc[2];
        sc[0] = (f32x4){0.f, 0.f, 0.f, 0.f}; sc[1] = sc[0];
#pragma unroll 1
        for (int h = 0; h < 8; ++h) {
          const float wv = wis[fr * 8 + h];
          f32x4 lg[2];
          lg[0] = (f32x4){0.f, 0.f, 0.f, 0.f}; lg[1] = lg[0];
#pragma unroll
          for (int ks = 0; ks < 4; ++ks) {
            const bf16x8 bh = *(const bf16x8*)(qihi + fr * 1032 + h * 128 + ks * 32 + fq * 8);
#pragma unroll
            for (int mt = 0; mt < 2; ++mt) {
              lg[mt] = mfma16h(khi[mt][ks], bh, lg[mt]);
            }
          }
#pragma unroll
          for (int mt = 0; mt < 2; ++mt)
#pragma unroll
            for (int r = 0; r < 4; ++r) sc[mt][r] += wv * fmaxf(lg[mt][r], 0.f);
        }
#pragma unroll
        for (int mt = 0; mt < 2; ++mt) *(f32x4*)(scr + fr * 2048 + kbase + mt * 16 + fq * 4) = sc[mt];
      }
    }
    __syncthreads();
    u16* QF = (u16*)(lds + 81920);
#pragma unroll
    for (int i = 0; i < 4; ++i) {
      const int c = tid + i * NTHR;
      const int row = c >> 7, ch = c & 127;
      *(uint4*)(QF + row * 1032 + ch * 8) = *(const uint4*)(QKVG + (tok0 + row) * 2560 + ch * 8);
    }
#pragma unroll 1
    for (int qi2 = 0; qi2 < ((DUP == 7) ? 4 : 2); ++qi2) {
      const int qq = wave * 2 + (qi2 & 1);
      const int qpos = q0 + qq;
      if (!full) {
        const int ng = ((q0 + 15) >> 8) + 1;
        const float* sr = scr + qq * 2048; unsigned* mr = MASK + qq * 64;
        switch (ng) {
          case 2: topk_row<8>(sr, qpos, lane, mr); break;
          case 3: topk_row<12>(sr, qpos, lane, mr); break;
          case 4: topk_row<16>(sr, qpos, lane, mr); break;
          case 5: topk_row<20>(sr, qpos, lane, mr); break;
          case 6: topk_row<24>(sr, qpos, lane, mr); break;
          case 7: topk_row<28>(sr, qpos, lane, mr); break;
          default: topk_row<32>(sr, qpos, lane, mr); break;
        }
      } else {
#pragma unroll
        for (int e = 0; e < 32; ++e) {
          const unsigned long long ms = __ballot((e * 64 + lane) <= qpos);
          if (lane == 0) { MASK[qq * 64 + 2 * e] = (unsigned)ms; MASK[qq * 64 + 2 * e + 1] = (unsigned)(ms >> 32); }
        }
      }
    }
    __syncthreads();
    {
      int fr_a = fr, fq_a = fq, lane_a = lane;
      asm volatile("" : "+v"(fr_a), "+v"(fq_a), "+v"(lane_a));
#define fr fr_a
#define fq fq_a
#define lane lane_a
      const int g = wave >> 1, half = wave & 1;
      float mq = fabsf(p.pp->in[6][lane]), mk = fabsf(p.pp->in[7][lane]);
#pragma unroll
      for (int mm = 32; mm >= 1; mm >>= 1) { mq = fmaxf(mq, __shfl_xor(mq, mm)); mk = fmaxf(mk, __shfl_xor(mk, mm)); }
      const float shift = 8.f * mq * mk; const float nshift2 = -shift * 1.44269504089f;
      const u16* qfp = QF + fr * 1032 + g * 256 + fq * 8;
      f32x4 o[4][4];
#pragma unroll
      for (int rr = 0; rr < 4; ++rr)
#pragma unroll
        for (int mt = 0; mt < 4; ++mt) o[rr][mt] = (f32x4){0.f, 0.f, 0.f, 0.f};
      float lsum[4] = {0.f, 0.f, 0.f, 0.f};
      const u16* Kb = QKVG + (size_t)b * 2048 * 2560 + 1024 + g * 64 + fq * 8 + (size_t)(8 * (fr >> 2) + (fr & 3)) * 2560;
      const u16* Vb = VT + (size_t)(b * 256 + g * 64 + fr) * 2048 + 8 * fq;
      const int nb = (q0 + 16 + 31) >> 5;
      bf16x8 kf[2][2], vf[4];
      {
        const int k0 = (half < nb ? half : 0) * 32;
#pragma unroll
        for (int s2 = 0; s2 < 2; ++s2)
#pragma unroll
          for (int ks = 0; ks < 2; ++ks) kf[s2][ks] = *(const bf16x8*)(Kb + (size_t)(k0 + 4 * s2) * 2560 + ks * 32);
#pragma unroll
        for (int mt = 0; mt < 4; ++mt) vf[mt] = *(const bf16x8*)(Vb + (size_t)mt * 16 * 2048 + k0);
      }
#pragma unroll 1
      for (int blk = half; blk < nb; blk += 2) {
        bf16x8 kn[2][2], vn[4];
        const int nx = (blk + 2 < nb) ? (blk + 2) * 32 : blk * 32;
#pragma unroll
        for (int s2 = 0; s2 < 2; ++s2)
#pragma unroll
          for (int ks = 0; ks < 2; ++ks) kn[s2][ks] = *(const bf16x8*)(Kb + (size_t)(nx + 4 * s2) * 2560 + ks * 32);
#pragma unroll
        for (int mt = 0; mt < 4; ++mt) vn[mt] = *(const bf16x8*)(Vb + (size_t)mt * 16 * 2048 + nx);
        const unsigned mw = MASK[fr * 64 + blk] >> (8 * fq);
        f32x4 mf[2];
#pragma unroll
        for (int s2 = 0; s2 < 2; ++s2)
#pragma unroll
          for (int r = 0; r < 4; ++r) mf[s2][r] = (float)((mw >> (4 * s2 + r)) & 1u);
#pragma unroll
        for (int rr = 0; rr < 4; ++rr) {
          float pv[8];
          f32x4 pq[2];
#pragma unroll
          for (int s2 = 0; s2 < 2; ++s2) {
            f32x4 stv = (f32x4){0.f, 0.f, 0.f, 0.f};
            stv = mfma16(kf[s2][0], *(const bf16x8*)(qfp + rr * 64), stv);
            stv = mfma16(kf[s2][1], *(const bf16x8*)(qfp + rr * 64 + 32), stv);
            stv = stv * (0.125f * 1.44269504089f) + nshift2;
#pragma unroll
            for (int r = 0; r < 4; ++r) stv[r] = __builtin_amdgcn_exp2f(stv[r]);
            pq[s2] = stv * mf[s2];
          }
          {
            const f32x4 sm_ = pq[0] + pq[1];
            lsum[rr] += (sm_[0] + sm_[1]) + (sm_[2] + sm_[3]);
          }
#pragma unroll
          for (int r = 0; r < 4; ++r) { pv[r] = pq[0][r]; pv[4 + r] = pq[1][r]; }
          union { bf16x8 v; unsigned w[4]; } pk;
          pk.w[0] = pg8::cvt_pk_bf16(pv[0], pv[1]); pk.w[1] = pg8::cvt_pk_bf16(pv[2], pv[3]);
          pk.w[2] = pg8::cvt_pk_bf16(pv[4], pv[5]); pk.w[3] = pg8::cvt_pk_bf16(pv[6], pv[7]);
#pragma unroll
          for (int mt = 0; mt < 4; ++mt) o[rr][mt] = mfma16(vf[mt], pk.v, o[rr][mt]);
        }
#pragma unroll
        for (int s2 = 0; s2 < 2; ++s2)
#pragma unroll
          for (int ks = 0; ks < 2; ++ks) kf[s2][ks] = kn[s2][ks];
#pragma unroll
        for (int mt = 0; mt < 4; ++mt) vf[mt] = vn[mt];
      }
      float* CB = (float*)(lds + 8192) + (size_t)g * 68 * 64 + lane;
      if (half == 1) {
#pragma unroll
        for (int rr = 0; rr < 4; ++rr) {
#pragma unroll
          for (int mt = 0; mt < 4; ++mt)
#pragma unroll
            for (int r = 0; r < 4; ++r) CB[((rr * 4 + mt) * 4 + r) * 64] = o[rr][mt][r];
          CB[(64 + rr) * 64] = lsum[rr];
        }
      }
      __syncthreads();
      if (half == 0) {
#pragma unroll
        for (int rr = 0; rr < 4; ++rr) {
          float l = lsum[rr] + CB[(64 + rr) * 64];
          l += __shfl_xor(l, 16); l += __shfl_xor(l, 32);
          const float inv = 1.f / l;
          const int h = g * 4 + rr;
#pragma unroll
          for (int mt = 0; mt < 4; ++mt) {
            u16* op = QKVG + (tok0 + fr) * 2560 + h * 64 + mt * 16 + fq * 4;
            const uint2 gg = *(const uint2*)(op + 1536);
            const float v0 = o[rr][mt][0] + CB[((rr * 4 + mt) * 4 + 0) * 64], v1 = o[rr][mt][1] + CB[((rr * 4 + mt) * 4 + 1) * 64];
            const float v2 = o[rr][mt][2] + CB[((rr * 4 + mt) * 4 + 2) * 64], v3 = o[rr][mt][3] + CB[((rr * 4 + mt) * 4 + 3) * 64];
            uint2 w;
            w.x = pg8::cvt_pk_bf16(v0 * inv * silu_(bflo(gg.x)), v1 * inv * silu_(bfhi(gg.x)));
            w.y = pg8::cvt_pk_bf16(v2 * inv * silu_(bflo(gg.y)), v3 * inv * silu_(bfhi(gg.y)));
            if (st) *(uint2*)op = w;
          }
        }
      }
#undef fr
#undef fq
#undef lane
    }
    __syncthreads();
  }
}

__device__ __forceinline__ void lru_gate_phase(const PAcc& p, char* lds) {
  const int tid = tid_(), lane = tid & 63, wave = tid >> 6;
  const int wr = wave >> 1, wc = wave & 1, fr = lane & 15, fq = lane >> 4;
  float* UC = (float*)lds;
  u16* Al = (u16*)(lds + 256 * 65 * 4);
  u16* Bl = Al + 256 * 72;
  const u16* UG = (const u16*)(p.pp->ws + LRU_UG);
  const u16* WG = (const u16*)(p.pp->ws + WS_WT) + W_LRU_GATE;
  float* LA = (float*)(p.pp->ws + LRU_A);
  float* LB = (float*)(p.pp->ws + LRU_B);
  for (int unit = blockIdx.x; unit < 2048; unit += gridDim.x) {
    const int n = unit & 15, mt = unit >> 4;
    const int m0 = mt * 256;
    {
      const int c = tid & 63, rg = tid >> 6;
      const int ch = n * 64 + c;
      const float w0 = p.pp->in[10][ch], w1 = p.pp->in[10][1024 + ch], w2 = p.pp->in[10][2048 + ch], w3 = p.pp->in[10][3072 + ch];
      const float cb = p.pp->in[11][ch];
      const int r0 = rg * 32;
      const int g0 = m0 + r0;
      float u3 = ((g0 & 2047) >= 3) ? bf2f(UG[(size_t)(g0 - 3) * 2048 + ch]) : 0.f;
      float u2 = ((g0 & 2047) >= 2) ? bf2f(UG[(size_t)(g0 - 2) * 2048 + ch]) : 0.f;
      float u1 = ((g0 & 2047) >= 1) ? bf2f(UG[(size_t)(g0 - 1) * 2048 + ch]) : 0.f;
#pragma unroll 8
      for (int r = 0; r < 32; ++r) {
        const float u0 = bf2f(UG[(size_t)(g0 + r) * 2048 + ch]);
        const float v = w0 * u3 + w1 * u2 + w2 * u1 + w3 * u0 + cb;
        UC[(r0 + r) * 65 + c] = v;
        Al[(r0 + r) * 72 + c] = f2bf(v);
        u3 = u2; u2 = u1; u1 = u0;
      }
#pragma unroll
      for (int i = 0; i < 2; ++i) {
        const int cidx = tid + i * NTHR;
        const int row = cidx >> 3, kc = (cidx & 7) * 8;
        *(uint4*)(Bl + row * 72 + kc) = *(const uint4*)(WG + (size_t)n * 8192 + row * 64 + kc);
      }
    }
    __syncthreads();
    f32x4 acc[4][4];
#pragma unroll
    for (int i = 0; i < 4; ++i)
#pragma unroll
      for (int j = 0; j < 4; ++j) acc[i][j] = (f32x4){0.f, 0.f, 0.f, 0.f};
#pragma unroll
    for (int ks = 0; ks < 2; ++ks) {
      bf16x8 af[4], bfr[4];
#pragma unroll
      for (int i = 0; i < 4; ++i) af[i] = *(const bf16x8*)(Al + (wr * 64 + i * 16 + fr) * 72 + ks * 32 + fq * 8);
#pragma unroll
      for (int j = 0; j < 4; ++j) bfr[j] = *(const bf16x8*)(Bl + (wc * 64 + j * 16 + fr) * 72 + ks * 32 + fq * 8);
#pragma unroll
      for (int i = 0; i < 4; ++i)
#pragma unroll
        for (int j = 0; j < 4; ++j) acc[i][j] = mfma16(af[i], bfr[j], acc[i][j]);
    }
#pragma unroll
    for (int jj = 0; jj < 2; ++jj) {
      const int d = wc * 32 + jj * 16 + fr;
      const int ch = n * 64 + d;
      const float ba = p.pp->in[13][ch], bx = p.pp->in[15][ch];
      const float spl = softplus_(-p.pp->in[16][ch]);
#pragma unroll
      for (int i = 0; i < 4; ++i)
#pragma unroll
        for (int r = 0; r < 4; ++r) {
          const int row = wr * 64 + i * 16 + fq * 4 + r;
          const float rr = sigmoid_(acc[i][jj * 2][r] + ba);
          const float ig = sigmoid_(acc[i][jj * 2 + 1][r] + bx);
          const float log_a = -8.f * rr * spl;
          const float a = __expf(log_a);
          const float bb = sqrtf(fmaxf(-expm1f(2.f * log_a), 0.f)) * (ig * UC[row * 65 + d]);
          const size_t o = (size_t)(m0 + row) * 1024 + ch;
          LA[o] = a; LB[o] = bb;
        }
    }
    __syncthreads();
  }
}


__device__ __forceinline__ void lru_fused_phase(const PAcc& p, char* lds) {
  const int tid = tid_(), lane = tid & 63, wave = tid >> 6;
  const int wr = wave >> 1, wc = wave & 1, fr = lane & 15, fq = lane >> 4;
  float* UB = (float*)lds;
  float* AA = UB + 128 * 65;
  u16* Al = (u16*)(AA + 128 * 65);
  u16* Bl = Al + 128 * 72;
  float* sA = (float*)(Bl + 128 * 72);
  float* sB = sA + 512;
  float* Hc = sB + 512;
  const u16* UG = (const u16*)(p.pp->ws + LRU_UG);
  const u16* WG = (const u16*)(p.pp->ws + WS_WT) + W_LRU_GATE;
  u16* OG = (u16*)(p.pp->ws + WS_H);
  const int c = tid & 63, rg = tid >> 6;
  for (int unit = blockIdx.x; unit < 256; unit += gridDim.x) {
    const int b = unit >> 4, n = unit & 15;
    const int ch = n * 64 + c;
    const float w0 = p.pp->in[10][ch], w1 = p.pp->in[10][1024 + ch], w2 = p.pp->in[10][2048 + ch], w3 = p.pp->in[10][3072 + ch];
    const float cb = p.pp->in[11][ch];
#pragma unroll
    for (int i = 0; i < 2; ++i) {
      const int cidx = tid + i * NTHR;
      const int row = cidx >> 3, kc = (cidx & 7) * 8;
      *(uint4*)(Bl + row * 72 + kc) = *(const uint4*)(WG + (size_t)n * 8192 + row * 64 + kc);
    }
    if (tid < 64) Hc[tid] = 0.f;
    float ba[2], bx[2], spl[2];
#pragma unroll
    for (int jj = 0; jj < 2; ++jj) {
      const int dch = n * 64 + wc * 32 + jj * 16 + fr;
      ba[jj] = p.pp->in[13][dch]; bx[jj] = p.pp->in[15][dch]; spl[jj] = softplus_(-p.pp->in[16][dch]);
    }
    u16 un[19], gn[16];
#define LRU_LOAD(mt_)                                                                      \
    { const size_t g0_ = (size_t)b * 2048 + (mt_) * 128 + rg * 16;                         \
      const int pos0_ = (mt_) * 128 + rg * 16;                                             \
      _Pragma("unroll") for (int r = 0; r < 3; ++r) un[r] = (pos0_ >= 3 - r) ? UG[(g0_ - 3 + r) * 2048 + ch] : (u16)0; \
      _Pragma("unroll") for (int r = 0; r < 16; ++r) { un[3 + r] = UG[(g0_ + r) * 2048 + ch]; gn[r] = UG[(g0_ + r) * 2048 + 1024 + ch]; } }
    LRU_LOAD(0);
#pragma unroll 1
    for (int mt = 0; mt < 16; ++mt) {
      const size_t m0 = (size_t)b * 2048 + mt * 128;
      const size_t g0 = m0 + rg * 16;
      u16 gg[16];
#pragma unroll
      for (int r = 0; r < 16; ++r) gg[r] = gn[r];
      {
        float u3 = bf2f(un[0]), u2 = bf2f(un[1]), u1 = bf2f(un[2]);
#pragma unroll
        for (int r = 0; r < 16; ++r) {
          const float u0 = bf2f(un[3 + r]);
          const float v = w0 * u3 + w1 * u2 + w2 * u1 + w3 * u0 + cb;
          UB[(rg * 16 + r) * 65 + c] = v;
          Al[(rg * 16 + r) * 72 + c] = f2bf(v);
          u3 = u2; u2 = u1; u1 = u0;
        }
      }
      if (mt + 1 < 16) LRU_LOAD(mt + 1);
      __syncthreads();
      f32x4 acc[2][4];
#pragma unroll
      for (int i = 0; i < 2; ++i)
#pragma unroll
        for (int j = 0; j < 4; ++j) acc[i][j] = (f32x4){0.f, 0.f, 0.f, 0.f};
#pragma unroll
      for (int ks = 0; ks < 2; ++ks) {
        bf16x8 af[2], bfr[4];
#pragma unroll
        for (int i = 0; i < 2; ++i) af[i] = *(const bf16x8*)(Al + (wr * 32 + i * 16 + fr) * 72 + ks * 32 + fq * 8);
#pragma unroll
        for (int j = 0; j < 4; ++j) bfr[j] = *(const bf16x8*)(Bl + (wc * 64 + j * 16 + fr) * 72 + ks * 32 + fq * 8);
#pragma unroll
        for (int i = 0; i < 2; ++i)
#pragma unroll
          for (int j = 0; j < 4; ++j) acc[i][j] = mfma16(af[i], bfr[j], acc[i][j]);
      }
#pragma unroll
      for (int jj = 0; jj < 2; ++jj) {
        const int d = wc * 32 + jj * 16 + fr;
#pragma unroll
        for (int i = 0; i < 2; ++i)
#pragma unroll
          for (int r = 0; r < 4; ++r) {
            const int row = wr * 32 + i * 16 + fq * 4 + r;
            const float rr = sigmoid_(acc[i][jj * 2][r] + ba[jj]);
            const float ig = sigmoid_(acc[i][jj * 2 + 1][r] + bx[jj]);
            const float log_a = -8.f * rr * spl[jj];
            const float av = __expf(log_a);
            AA[row * 65 + d] = av;
            UB[row * 65 + d] = sqrtf(fmaxf((1.f - av) * (1.f + av), 0.f)) * (ig * UB[row * 65 + d]);
          }
      }
      __syncthreads();
      {
        float Aa = 1.f, Bb = 0.f;
#pragma unroll
        for (int r = 0; r < 16; ++r) {
          const float a = AA[(rg * 16 + r) * 65 + c], bb = UB[(rg * 16 + r) * 65 + c];
          Bb = a * Bb + bb; Aa *= a;
        }
        sA[rg * 64 + c] = Aa; sB[rg * 64 + c] = Bb;
        __syncthreads();
        float h = Hc[c];
        for (int v = 0; v < rg; ++v) h = sA[v * 64 + c] * h + sB[v * 64 + c];
#pragma unroll
        for (int r = 0; r < 16; ++r) {
          const float a = AA[(rg * 16 + r) * 65 + c], bb = UB[(rg * 16 + r) * 65 + c];
          h = a * h + bb;
          OG[(g0 + r) * 1024 + ch] = f2bf(h * silu_(bf2f(gg[r])));
        }
        __syncthreads();
        if (rg == 7) Hc[c] = h;
      }
    }
    __syncthreads();
  }
}

#undef LRU_LOAD
__device__ __forceinline__ void lru_scan_phase(const PAcc& p, char* lds) {
  const int tid = tid_(), c = tid & 63, tc = tid >> 6;
  float* sA = (float*)lds;
  float* sB = sA + 512;
  const float* LA = (const float*)(p.pp->ws + LRU_A);
  const float* LB = (const float*)(p.pp->ws + LRU_B);
  const u16* UG = (const u16*)(p.pp->ws + LRU_UG);
  u16* OG = (u16*)(p.pp->ws + WS_H);
  for (int item = blockIdx.x; item < 256; item += gridDim.x) {
    const int b = item >> 4, ch = (item & 15) * 64 + c;
    const size_t row0 = (size_t)b * 2048 + tc * 256;
    float Aa = 1.f, Bb = 0.f;
#pragma unroll 8
    for (int t = 0; t < 256; ++t) {
      const float a = LA[(row0 + t) * 1024 + ch], bb = LB[(row0 + t) * 1024 + ch];
      Bb = a * Bb + bb; Aa *= a;
    }
    sA[tc * 64 + c] = Aa; sB[tc * 64 + c] = Bb;
    __syncthreads();
    float h = 0.f;
    for (int v = 0; v < tc; ++v) h = sA[v * 64 + c] * h + sB[v * 64 + c];
#pragma unroll 8
    for (int t = 0; t < 256; ++t) {
      const float a = LA[(row0 + t) * 1024 + ch], bb = LB[(row0 + t) * 1024 + ch];
      h = a * h + bb;
      const float g = bf2f(UG[(row0 + t) * 2048 + 1024 + ch]);
      OG[(row0 + t) * 1024 + ch] = f2bf(h * silu_(g));
    }
    __syncthreads();
  }
}

__device__ __forceinline__ void rwkv_rec_phase(const PAcc& p, char* lds, bool st) {
  const int tid = tid_(), lane = tid & 63, wave = tid >> 6;
  float* Wd = (float*)lds;
  float* NKK = Wd + 1024;
  float* KKA = NKK + 1024;
  float* KM = KKA + 1024;
  float* Rr = KM + 1024;
  float* Vv = Rr + 1024;
  float* Yy = Vv + 1024;
  float* RKs = Yy + 1024;
  u16* RKVG = (u16*)(p.pp->ws + RW_RKVG);
  const float* EW = (const float*)(p.pp->ws + RW_EW);
  const u16* AB = (const u16*)(p.pp->ws + RW_A);
  const int tl = tid >> 5, jp = tid & 31;
  const int il = lane >> 3, js = lane & 7;
  for (int item = blockIdx.x; item < 256; item += gridDim.x) {
    const int b = item >> 4, h = item & 15;
    const int hc = h * 64 + 2 * jp;
    const float kk0 = p.pp->in[26][hc], kk1 = p.pp->in[26][hc + 1];
    const float ka0 = p.pp->in[27][hc], ka1 = p.pp->in[27][hc + 1];
    const float rk0 = p.pp->in[28][hc], rk1 = p.pp->in[28][hc + 1];
    const float lw0 = p.pp->in[29][hc], lw1 = p.pp->in[29][hc + 1];
    const float lb0 = p.pp->in[30][hc], lb1 = p.pp->in[30][hc + 1];
    f32x4 SA = (f32x4){0.f, 0.f, 0.f, 0.f}, SB = SA;
    const int irow = wave * 8 + il;
    unsigned r2, k2, v2, a2, g2n, g2; float2 e2;
    {
      const size_t row = (size_t)b * 2048 + tl;
      r2 = *(const unsigned*)(RKVG + row * 4096 + hc);
      k2 = *(const unsigned*)(RKVG + row * 4096 + 1024 + hc);
      v2 = *(const unsigned*)(RKVG + row * 4096 + 2048 + hc);
      g2n = *(const unsigned*)(RKVG + row * 4096 + 3072 + hc);
      a2 = *(const unsigned*)(AB + row * 1024 + hc);
      e2 = *(const float2*)(EW + row * 1024 + hc);
    }
    for (int t0 = 0; t0 < 2048; t0 += 16) {
      g2 = g2n;
      {
        const float r0 = bflo(r2), r1 = bfhi(r2), k0 = bflo(k2), k1 = bfhi(k2), v0 = bflo(v2), v1 = bfhi(v2);
        const float a0 = bflo(a2), a1 = bfhi(a2);
        float q0 = k0 * kk0, q1 = k1 * kk1;
        float ss = q0 * q0 + q1 * q1;
        ss = red32(ss);
        const float inv = 1.f / fmaxf(sqrtf(ss), 1e-12f);
        q0 *= inv; q1 *= inv;
        const float km0 = k0 * (1.f + (a0 - 1.f) * ka0), km1 = k1 * (1.f + (a1 - 1.f) * ka1);
        float bon = r0 * km0 * rk0 + r1 * km1 * rk1;
        bon = red32(bon);
        const int o = tl * 64 + 2 * jp;
        *(float2*)(Wd + o) = make_float2(__expf(-e2.x), __expf(-e2.y));
        *(float2*)(NKK + o) = make_float2(-q0, -q1);
        *(float2*)(KKA + o) = make_float2(q0 * a0, q1 * a1);
        *(float2*)(KM + o) = make_float2(km0, km1);
        *(float2*)(Rr + o) = make_float2(r0, r1);
        *(float2*)(Vv + o) = make_float2(v0, v1);
        if (jp == 0) RKs[tl] = bon;
      }
      __syncthreads();
      if (t0 + 16 < 2048) {
        const size_t row = (size_t)b * 2048 + t0 + 16 + tl;
        r2 = *(const unsigned*)(RKVG + row * 4096 + hc);
        k2 = *(const unsigned*)(RKVG + row * 4096 + 1024 + hc);
        v2 = *(const unsigned*)(RKVG + row * 4096 + 2048 + hc);
        g2n = *(const unsigned*)(RKVG + row * 4096 + 3072 + hc);
        a2 = *(const unsigned*)(AB + row * 1024 + hc);
        e2 = *(const float2*)(EW + row * 1024 + hc);
      }
#define RW_RD(W, N, C, M, R, V, t_)                                                        \
      { const int o_ = (t_) * 64 + js * 8;                                                   \
        W[0] = *(const f32x4*)(Wd + o_); W[1] = *(const f32x4*)(Wd + o_ + 4);                \
        N[0] = *(const f32x4*)(NKK + o_); N[1] = *(const f32x4*)(NKK + o_ + 4);              \
        C[0] = *(const f32x4*)(KKA + o_); C[1] = *(const f32x4*)(KKA + o_ + 4);              \
        M[0] = *(const f32x4*)(KM + o_); M[1] = *(const f32x4*)(KM + o_ + 4);                \
        R[0] = *(const f32x4*)(Rr + o_); R[1] = *(const f32x4*)(Rr + o_ + 4);                \
        V = Vv[(t_) * 64 + irow]; }
#define RW_CP(W, N, C, M, R, V, yout)                                                      \
      { const f32x4 p0_ = SA * N[0], p1_ = SB * N[1];                                        \
        float sa_ = ((p0_[0] + p0_[1]) + (p0_[2] + p0_[3])) + ((p1_[0] + p1_[1]) + (p1_[2] + p1_[3])); \
        sa_ = red8(sa_);                                                                     \
        SA = SA * W[0] + (C[0] * sa_ + M[0] * V);                                            \
        SB = SB * W[1] + (C[1] * sa_ + M[1] * V);                                            \
        const f32x4 y0_ = SA * R[0], y1_ = SB * R[1];                                        \
        float y_ = ((y0_[0] + y0_[1]) + (y0_[2] + y0_[3])) + ((y1_[0] + y1_[1]) + (y1_[2] + y1_[3])); \
        yout = red8(y_); }
      {
        f32x4 aW[2], aN[2], aC[2], aM[2], aR[2], bW[2], bN[2], bC[2], bM[2], bR[2];
        float aV, bV;
        RW_RD(aW, aN, aC, aM, aR, aV, 0);
        RW_RD(bW, bN, bC, bM, bR, bV, 1);
#pragma unroll
        for (int t = 0; t < 16; t += 2) {
          float ya, yb;
          RW_CP(aW, aN, aC, aM, aR, aV, ya);
          if (t + 2 < 16) RW_RD(aW, aN, aC, aM, aR, aV, t + 2);
          RW_CP(bW, bN, bC, bM, bR, bV, yb);
          if (t + 3 < 16) RW_RD(bW, bN, bC, bM, bR, bV, t + 3);
          if (js == 0) { Yy[t * 64 + irow] = ya; Yy[(t + 1) * 64 + irow] = yb; }
        }
      }
#undef RW_RD
#undef RW_CP
      __syncthreads();
      {
        const int o = tl * 64 + 2 * jp;
        const float2 y = *(const float2*)(Yy + o);
        float sm = y.x + y.y;
        sm = red32(sm);
        const float mean = sm * (1.f / 64.f);
        const float d0 = y.x - mean, d1 = y.y - mean;
        float vs = d0 * d0 + d1 * d1;
        vs = red32(vs);
        const float rstd = rsqrtf(vs * (1.f / 64.f) + 64e-5f);
        const float2 vv = *(const float2*)(Vv + o);
        const float bon = RKs[tl];
        const size_t row = (size_t)b * 2048 + t0 + tl;
        const float o0 = (d0 * rstd * lw0 + lb0 + bon * vv.x) * silu_(bflo(g2));
        const float o1 = (d1 * rstd * lw1 + lb1 + bon * vv.y) * silu_(bfhi(g2));
        if (st) *(unsigned*)(RKVG + row * 4096 + hc) = pack2(o0, o1);
      }
      __syncthreads();
    }
  }
}

__device__ __forceinline__ f32x4 wave_mma(const u16* A, int lda, const u16* B, int ldb, int K, f32x4 acc, int fr, int fq) {
  for (int k = 0; k < K; k += 32) {
    const bf16x8 a = *(const bf16x8*)(A + fr * lda + k + fq * 8);
    const bf16x8 b = *(const bf16x8*)(B + fr * ldb + k + fq * 8);
    acc = mfma16(a, b, acc);
  }
  return acc;
}

__device__ __forceinline__ void gla_pre_phase(const PAcc& p, char* lds) {
  const int tid = tid_(), lane = tid & 63, wave = tid >> 6, fr = lane & 15, fq = lane >> 4;
  float* AL = (float*)lds;
  float* TOT = AL + 1024;
  u16* QD = (u16*)(TOT + 512);
  u16* KI = QD + 64 * 136;
  const u16* P = (const u16*)(p.pp->ws + GL_P);
  u16* QDg = (u16*)(p.pp->ws + GL_QD);
  u16* KETg = (u16*)(p.pp->ws + GL_KET);
  u16* ATTg = (u16*)((char*)p.pp->out + GL_ATT_OUT);
  u16* VTg = (u16*)(p.pp->ws + GL_VT);
  float* LASTg = (float*)((char*)p.pp->out + GL_LAST_OUT);
  const int d = tid & 127, tg = tid >> 7;
  for (int item = blockIdx.x; item < 2048; item += gridDim.x) {
    const int h = item & 3, bn = item >> 2;
    const size_t row0 = (size_t)bn * 64;
    float w2c[16];
#pragma unroll
    for (int r = 0; r < 16; ++r) w2c[r] = p.pp->in[33][r * 512 + h * 128 + d];
    const float ab = p.pp->in[34][h * 128 + d];
    for (int i = tid; i < 1024; i += NTHR) AL[i] = bf2f(P[(row0 + (i >> 4)) * 3088 + 3072 + (i & 15)]);
    {
      const int e = tid & 255, th = tid >> 8;
      u16 vv[32];
#pragma unroll
      for (int t = 0; t < 32; ++t) vv[t] = P[(row0 + th * 32 + t) * 3088 + 1024 + h * 256 + e];
      u16* dst = VTg + ((size_t)item * 256 + e) * 64 + th * 32;
#pragma unroll
      for (int q4 = 0; q4 < 4; ++q4) {
        uint4 s0;
        s0.x = vv[q4 * 8 + 0] | ((unsigned)vv[q4 * 8 + 1] << 16); s0.y = vv[q4 * 8 + 2] | ((unsigned)vv[q4 * 8 + 3] << 16);
        s0.z = vv[q4 * 8 + 4] | ((unsigned)vv[q4 * 8 + 5] << 16); s0.w = vv[q4 * 8 + 6] | ((unsigned)vv[q4 * 8 + 7] << 16);
        *(uint4*)(dst + q4 * 8) = s0;
      }
    }
    __syncthreads();
    float cum[16];
    {
      float run = 0.f;
#pragma unroll
      for (int t = 0; t < 16; ++t) {
        const float4* al = (const float4*)(AL + (tg * 16 + t) * 16);
        const float4 x0 = al[0], x1 = al[1], x2 = al[2], x3 = al[3];
        float z = ab + x0.x * w2c[0] + x0.y * w2c[1] + x0.z * w2c[2] + x0.w * w2c[3] + x1.x * w2c[4] + x1.y * w2c[5] + x1.z * w2c[6] + x1.w * w2c[7]
                + x2.x * w2c[8] + x2.y * w2c[9] + x2.z * w2c[10] + x2.w * w2c[11] + x3.x * w2c[12] + x3.y * w2c[13] + x3.z * w2c[14] + x3.w * w2c[15];
        run += -softplus_(-z) * (1.f / 16.f);
        cum[t] = run;
      }
      TOT[tg * 128 + d] = run;
    }
    __syncthreads();
    {
      float off = 0.f, last = 0.f;
#pragma unroll
      for (int g = 0; g < 4; ++g) { const float tv = TOT[g * 128 + d]; if (g < tg) off += tv; last += tv; }
      if (tg == 0) LASTg[(size_t)item * 128 + d] = last;
      u16 ke[16];
#pragma unroll
      for (int t = 0; t < 16; ++t) {
        const float c = cum[t] + off;
        const int tok = tg * 16 + t;
        const float q = bf2f(P[(row0 + tok) * 3088 + h * 128 + d]);
        const float k = bf2f(P[(row0 + tok) * 3088 + 512 + h * 128 + d]);
        const float ec = __expf(c), einv = 1.f / ec;
        const u16 qd = f2bf(q * 0.08838834764831845f * ec);
        QD[tok * 136 + d] = qd;
        QDg[(row0 + tok) * 512 + h * 128 + d] = qd;
        KI[tok * 136 + d] = f2bf(k * einv);
        ke[t] = f2bf(k * __expf(last) * einv);
      }
      uint4 s0, s1;
      s0.x = ke[0] | ((unsigned)ke[1] << 16); s0.y = ke[2] | ((unsigned)ke[3] << 16); s0.z = ke[4] | ((unsigned)ke[5] << 16); s0.w = ke[6] | ((unsigned)ke[7] << 16);
      s1.x = ke[8] | ((unsigned)ke[9] << 16); s1.y = ke[10] | ((unsigned)ke[11] << 16); s1.z = ke[12] | ((unsigned)ke[13] << 16); s1.w = ke[14] | ((unsigned)ke[15] << 16);
      u16* kd = KETg + ((size_t)item * 128 + d) * 64 + tg * 16;
      *(uint4*)kd = s0;
      *(uint4*)(kd + 8) = s1;
    }
    __syncthreads();
    {
      const int ti = wave >> 1;
#pragma unroll
      for (int x = 0; x < 2; ++x) {
        const int tj = (wave & 1) * 2 + x;
        f32x4 a = (f32x4){0.f, 0.f, 0.f, 0.f};
        if (tj <= ti) a = wave_mma(QD + ti * 16 * 136, 136, KI + tj * 16 * 136, 136, 128, a, fr, fq);
#pragma unroll
        for (int r = 0; r < 4; ++r) {
          const int i = ti * 16 + fq * 4 + r, j = tj * 16 + fr;
          ATTg[(size_t)item * 4096 + i * 64 + j] = f2bf((j <= i) ? a[r] : 0.f);
        }
      }
    }
    __syncthreads();
  }
}

__device__ __forceinline__ void gla_phase(const PAcc& p, char* lds) {
  const int tid = tid_(), lane = tid & 63, wave = tid >> 6, fr = lane & 15, fq = lane >> 4;
  float* LAST = (float*)lds;
  u16* QD = (u16*)(LAST + 128);
  u16* KET = QD + 64 * 136;
  u16* VT = KET + 128 * 72;
  u16* ATT = VT + 64 * 72;
  u16* ST = ATT + 64 * 72;
  const u16* QDg = (const u16*)(p.pp->ws + GL_QD);
  const u16* KETg = (const u16*)(p.pp->ws + GL_KET);
  const u16* ATTg = (const u16*)((const char*)p.pp->out + GL_ATT_OUT);
  const u16* VTg = (const u16*)(p.pp->ws + GL_VT);
  const float* LASTg = (const float*)((const char*)p.pp->out + GL_LAST_OUT);
  u16* O = (u16*)(p.pp->ws + GL_O);
  for (int item = blockIdx.x; item < 256; item += gridDim.x) {
    int bh_, es;
    if (gridDim.x == 256) { const int x_ = item & 7, j_ = item >> 3; bh_ = x_ * 8 + (j_ >> 2); es = j_ & 3; }
    else { bh_ = item >> 2; es = item & 3; }
    const int b = bh_ >> 2, h = bh_ & 3;
    f32x4 sacc[4];
#pragma unroll
    for (int i = 0; i < 4; ++i) sacc[i] = (f32x4){0.f, 0.f, 0.f, 0.f};
    for (int i = tid; i < 64 * 136 / 2; i += NTHR) ((unsigned*)ST)[i] = 0u;
    uint4 rA, rQ0, rQ1, rK0, rK1, rV; float rL = 0.f;
#define GLA_LOAD(n_)                                                                                            \
    {                                                                                                           \
      const size_t it_ = ((size_t)(b * 32 + (n_))) * 4 + h;                                                     \
      rA = *(const uint4*)(ATTg + it_ * 4096 + tid * 8);                                                        \
      { const int c0_ = tid, c1_ = tid + NTHR;                                                                  \
        rQ0 = *(const uint4*)(QDg + ((size_t)(b * 32 + (n_)) * 64 + (c0_ >> 4)) * 512 + h * 128 + (c0_ & 15) * 8); \
        rQ1 = *(const uint4*)(QDg + ((size_t)(b * 32 + (n_)) * 64 + (c1_ >> 4)) * 512 + h * 128 + (c1_ & 15) * 8); \
        rK0 = *(const uint4*)(KETg + it_ * 8192 + c0_ * 8);                                                     \
        rK1 = *(const uint4*)(KETg + it_ * 8192 + c1_ * 8); }                                                   \
      rV = *(const uint4*)(VTg + (it_ * 256 + es * 64) * 64 + tid * 8);                                         \
      if (tid < 128) rL = LASTg[it_ * 128 + tid];                                                               \
    }
    GLA_LOAD(0);
    for (int n = 0; n < 32; ++n) {
      const size_t row0 = (size_t)b * 2048 + n * 64;
      *(uint4*)(ATT + (tid >> 3) * 72 + (tid & 7) * 8) = rA;
      *(uint4*)(QD + (tid >> 4) * 136 + (tid & 15) * 8) = rQ0;
      *(uint4*)(QD + ((tid + NTHR) >> 4) * 136 + (tid & 15) * 8) = rQ1;
      *(uint4*)(KET + (tid >> 3) * 72 + (tid & 7) * 8) = rK0;
      *(uint4*)(KET + ((tid + NTHR) >> 3) * 72 + (tid & 7) * 8) = rK1;
      *(uint4*)(VT + (tid >> 3) * 72 + (tid & 7) * 8) = rV;
      if (tid < 128) LAST[tid] = rL;
      __syncthreads();
      if (n + 1 < 32) GLA_LOAD(n + 1);
      {
        const int ti = wave >> 1;
#pragma unroll
        for (int x = 0; x < 2; ++x) {
          const int te = (wave & 1) * 2 + x;
          f32x4 a = (f32x4){0.f, 0.f, 0.f, 0.f};
          a = wave_mma(ATT + ti * 16 * 72, 72, VT + te * 16 * 72, 72, 64, a, fr, fq);
          a = wave_mma(QD + ti * 16 * 136, 136, ST + te * 16 * 136, 136, 128, a, fr, fq);
#pragma unroll
          for (int r = 0; r < 4; ++r)
            O[(row0 + ti * 16 + fq * 4 + r) * 1024 + h * 256 + es * 64 + te * 16 + fr] = f2bf(a[r]);
        }
        const int et = wave >> 1;
#pragma unroll
        for (int x = 0; x < 4; ++x) {
          const int dt = (wave & 1) * 4 + x;
          const float dec = __expf(LAST[dt * 16 + fr]);
          f32x4 a = sacc[x];
          a[0] *= dec; a[1] *= dec; a[2] *= dec; a[3] *= dec;
          sacc[x] = wave_mma(VT + et * 16 * 72, 72, KET + dt * 16 * 72, 72, 64, a, fr, fq);
        }
      }
      __syncthreads();
      {
        const int et = wave >> 1;
#pragma unroll
        for (int x = 0; x < 4; ++x) {
          const int dt = (wave & 1) * 4 + x;
#pragma unroll
          for (int r = 0; r < 4; ++r) ST[(et * 16 + fq * 4 + r) * 136 + dt * 16 + fr] = f2bf(sacc[x][r]);
        }
      }
      __syncthreads();
    }
  }
}
#undef GLA_LOAD
__device__ __forceinline__ void gla_norm_phase(const PAcc& p) {
  const int lane = tid_() & 63;
  const int gw = blockIdx.x * (NTHR / 64) + (tid_() >> 6);
  const int nw = gridDim.x * (NTHR / 64);
  const u16* O = (const u16*)(p.pp->ws + GL_O);
  const u16* P = (const u16*)(p.pp->ws + GL_P);
  u16* OG = (u16*)(p.pp->ws + WS_H);
  const float4 gn = *(const float4*)(p.pp->in[35] + lane * 4);
  for (int row = gw; row < T_; row += nw) {
#pragma unroll
    for (int h = 0; h < 4; ++h) {
      const uint2 ov = *(const uint2*)(O + (size_t)row * 1024 + h * 256 + lane * 4);
      float4 v; v.x = bflo(ov.x); v.y = bfhi(ov.x); v.z = bflo(ov.y); v.w = bfhi(ov.y);
      float ss = v.x * v.x + v.y * v.y + v.z * v.z + v.w * v.w;
#pragma unroll
      for (int m = 32; m >= 1; m >>= 1) ss += __shfl_xor(ss, m);
      const float rstd = rsqrtf(ss * (1.f / 256.f) + 1e-6f);
      const uint2 g = *(const uint2*)(P + (size_t)row * 3088 + 2048 + h * 256 + lane * 4);
      uint2 o;
      o.x = pack2(v.x * rstd * gn.x * silu_(bflo(g.x)), v.y * rstd * gn.y * silu_(bfhi(g.x)));
      o.y = pack2(v.z * rstd * gn.z * silu_(bflo(g.y)), v.w * rstd * gn.w * silu_(bfhi(g.y)));
      *(uint2*)(OG + (size_t)row * 1024 + h * 256 + lane * 4) = o;
    }
  }
}


#define XB_TMO      128
#define XB_XCNT(j)  (256  + 64 * (j))
#define XB_XSUB(j)  (1280 + 64 * (j))
#define XB_XGEN(j)  (2304 + 64 * (j))
#define XB_TOP      3328
#define XB_TOPGEN   3392
#define XCD_BAR_WORDS 3456
#define XB_SPIN_CAP (1u << 18)
#define XLAS __attribute__((address_space(3)))
__device__ __forceinline__ unsigned xb_ld(unsigned* p)              { return __hip_atomic_load(p, __ATOMIC_RELAXED, __HIP_MEMORY_SCOPE_AGENT); }
__device__ __forceinline__ unsigned xb_add(unsigned* p, unsigned v) { return __hip_atomic_fetch_add(p, v, __ATOMIC_RELAXED, __HIP_MEMORY_SCOPE_AGENT); }
__device__ __forceinline__ unsigned xb_xcc_id() { return (unsigned)__builtin_amdgcn_s_getreg((3 << 11) | 20) & 0xFu; }
#define XB_SPIN(cond, bar) do { unsigned _sp = 0; while (cond) { __builtin_amdgcn_s_sleep(1); \
    if ((++_sp & 255u) == 0u) { if (xb_ld(&(bar)[XB_TMO])) break; if (_sp > XB_SPIN_CAP) { atomicAdd(&(bar)[XB_TMO], 1u); break; } } } } while (0)
struct XcdBarrier { unsigned* bar; unsigned x; volatile XLAS unsigned* st; };
__device__ __forceinline__ XcdBarrier xcd_barrier_post(unsigned* bar, volatile XLAS unsigned* st) {
  XcdBarrier b; b.bar = bar; b.x = xb_xcc_id(); b.st = st;
  if (tid_() == 0) (void)xb_add(&bar[XB_XCNT(b.x)], 1u);
  return b;
}
__device__ __forceinline__ void xcd_barrier_complete(unsigned* bar, unsigned x, unsigned& nloc, unsigned& nx) {
  const unsigned G = gridDim.x * gridDim.y * gridDim.z;
  unsigned sum, cnt, mine, sp = 0u;
  for (;;) {
    sum = 0u; cnt = 0u; mine = 0u;
#pragma unroll
    for (unsigned j = 0; j < 16; ++j) { const unsigned c = xb_ld(&bar[XB_XCNT(j)]); sum += c; cnt += (c > 0u) ? 1u : 0u; mine = (j == x) ? c : mine; }
    if (sum == G) break;
    __builtin_amdgcn_s_sleep(1);
    if ((++sp & 255u) == 0u) { if (xb_ld(&bar[XB_TMO])) break; if (sp > XB_SPIN_CAP) { atomicAdd(&bar[XB_TMO], 1u); break; } }
  }
  nloc = mine > 0u ? mine : 1u; nx = cnt > 0u ? cnt : 1u;
}
__device__ __forceinline__ void xcd_barrier(const XcdBarrier& b) {
  asm volatile("s_waitcnt vmcnt(0)" ::: "memory");
  __syncthreads();
  if (tid_() == 0) {
    unsigned* bar = b.bar;
    __builtin_amdgcn_s_waitcnt(0);
    unsigned nloc = b.st[0], nx = b.st[1];
    if (nloc == 0u) { xcd_barrier_complete(bar, b.x, nloc, nx); b.st[0] = nloc; b.st[1] = nx; }
    const unsigned old = xb_add(&bar[XB_XSUB(b.x)], 1u);
    const unsigned gen = old / nloc;
    if (old + 1u == (gen + 1u) * nloc) {
      __builtin_amdgcn_fence(__ATOMIC_RELEASE, "agent");
      asm volatile("s_waitcnt vmcnt(0)" ::: "memory");
      const unsigned og = xb_add(&bar[XB_TOP], 1u);
      const unsigned tg = og / nx;
      if (og + 1u == (tg + 1u) * nx) xb_add(&bar[XB_TOPGEN], 1u);
      else XB_SPIN(xb_ld(&bar[XB_TOPGEN]) == tg, bar);
      __builtin_amdgcn_fence(__ATOMIC_ACQUIRE, "agent");
      xb_add(&bar[XB_XGEN(b.x)], 1u);
      asm volatile("s_waitcnt vmcnt(0)" ::: "memory");
    } else {
      XB_SPIN(xb_ld(&bar[XB_XGEN(b.x)]) == gen, bar);
      __builtin_amdgcn_fence(__ATOMIC_ACQUIRE, "agent");
      asm volatile("s_waitcnt vmcnt(0)" ::: "memory");
    }
  }
  __syncthreads();
}

__global__ void __launch_bounds__(NTHR) fwd_megakernel(Params pk) {
  extern __shared__ __attribute__((aligned(16))) char lds[];
  cg::grid_group grid = cg::this_grid();
  PAcc p;
  p.pp = (CParamsPtr)__builtin_amdgcn_kernarg_segment_ptr();
  asm volatile("" : "+s"(p.pp));
  unsigned* xbar = (unsigned*)(p.pp->ws + WS_XBAR);
  volatile XLAS unsigned* xst = (volatile XLAS unsigned*)(lds + 128 * 1024);
  if (tid_() < 2) xst[tid_()] = 0u;
  if (blockIdx.x == 0) for (int i = tid_(); i < XCD_BAR_WORDS; i += NTHR) xbar[i] = 0u;
  const u16* WT = (const u16*)(p.pp->ws + WS_WT);
  u16* H = (u16*)(p.pp->ws + WS_H);
  u16* H2 = (u16*)(p.pp->ws + WS_H2);
  const float* MOD = (const float*)(p.pp->ws + WS_MOD);
  const float* xcur = p.pp->in[0];

#if DUP == 11
  for (int r_ = 0; r_ < 20; ++r_) grid.sync();
#endif
#if DUP == 5
  prep_phase(p, lds);
  grid.sync();
#endif
  prep_phase(p, lds);
  grid.sync();
  const XcdBarrier xb = xcd_barrier_post(xbar, xst);

  if (LAYER_MASK & 1) {
    for (int r_ = 0; r_ < ((DUP == 10) ? 2 : 1); ++r_) norm_phase<false, true, false>(p, p.pp->in[0], 0, H, nullptr);
    xcd_barrier(xb);
    for (int r_ = 0; r_ < ((DUP == 9) ? 2 : 1); ++r_) {
      pg8::EpiDsaMain e{(u16*)(p.pp->ws + DSA_QKVG), p.pp->in[6], p.pp->in[7], (const float2*)(p.pp->ws + WS_ROPE64), (u16*)(p.pp->ws + DSA_VT)};
      pg8::run<pg8::EpiDsaMain, true>(lds, H, H, H, WT + W_DSA_MAIN, WT + W_DSA_MAIN, WT + W_DSA_MAIN, 1024, 1024, 4, 1, 2560, e);
      pg8::EpiDsaIdx e2{(u16*)(p.pp->ws + DSA_QIHI), (u16*)(p.pp->ws + DSA_QILO), (u16*)(p.pp->ws + DSA_KIHI), (u16*)(p.pp->ws + DSA_KILO), (float*)(p.pp->ws + DSA_WI),
                        (const float2*)(p.pp->ws + WS_ROPE128)};
      pg8::run<pg8::EpiDsaIdx, true>(lds, H, H, H, WT + W_DSA_IDX_HI, WT + W_DSA_IDX_HI, WT + W_DSA_IDX_HI, 1024, 1024, 4, 1, 1280, e2);
    }
    xcd_barrier(xb);
#if DUP == 1
    dsa_unit_phase(p, lds, p.pp->ws == nullptr);
    xcd_barrier(xb);
#endif
    dsa_unit_phase(p, lds, true);
    xcd_barrier(xb);
    for (int r_ = 0; r_ < ((DUP == 9) ? 2 : 1); ++r_) {
      pg8::EpiResid<false, true> e{p.pp->ws + XR1, p.pp->in[0], MOD + 0 * 16 * 3072};
      const u16* A = (const u16*)(p.pp->ws + DSA_QKVG);
      pg8::run(lds, A, A, A, WT + W_DSA_OUT, WT + W_DSA_OUT, WT + W_DSA_OUT, 2560, 1024, 4, 1, 1024, e);
    }
    xcd_barrier(xb);
    xcur = p.pp->out;
  }
  if (LAYER_MASK & 2) {
    for (int r_ = 0; r_ < ((DUP == 10) ? 2 : 1); ++r_) norm_phase<false, false, true>(p, p.pp->ws + XR1, 1, H, nullptr);
    xcd_barrier(xb);
    for (int r_ = 0; r_ < ((DUP == 9) ? 2 : 1); ++r_) {
      pg8::EpiPlain e{(u16*)(p.pp->ws + LRU_UG), 2048, 2048};
      pg8::run(lds, H, H, H, WT + W_LRU_IN, WT + W_LRU_IN, WT + W_LRU_IN, 1024, 1024, 4, 1, 2048, e);
    }
    xcd_barrier(xb);
#if DUP == 4
    lru_fused_phase(p, lds);
    xcd_barrier(xb);
#endif
    lru_fused_phase(p, lds);
    xcd_barrier(xb);
    {
      pg8::EpiResid<true, true> e{p.pp->out, p.pp->ws + XR1, MOD + 1 * 16 * 3072};
      pg8::run(lds, H, H, H, WT + W_LRU_OUT, WT + W_LRU_OUT, WT + W_LRU_OUT, 1024, 1024, 4, 1, 1024, e);
    }
    xcd_barrier(xb);
    xcur = p.pp->out;
  }
  if (LAYER_MASK & 4) {
    for (int r_ = 0; r_ < ((DUP == 10) ? 2 : 1); ++r_) norm_phase<true, false, true>(p, p.pp->out, 2, H, nullptr);
    xcd_barrier(xb);
    for (int r_ = 0; r_ < ((DUP == 9) ? 2 : 1); ++r_) {
      pg8::EpiPlain e{(u16*)(p.pp->ws + RW_RKVG), 4096, 4096};
      pg8::run(lds, H, H, H, WT + W_RWKV_IN, WT + W_RWKV_IN, WT + W_RWKV_IN, 2048, 2048, 5, 1, 4096, e);
      EpiP e2{}; e2.o16 = (u16*)(p.pp->ws + RW_L1);
      gemm_phase<EPI_RWKV_L1>(p, H, H, H, WT + W_RWKV_L1, WT + W_RWKV_L1, WT + W_RWKV_L1, 2048, 2048, 2048, 1, 0, 1, e2, lds);
    }
    xcd_barrier(xb);
    for (int r_ = 0; r_ < ((DUP == 9) ? 2 : 1); ++r_) {
      const u16* L1 = (const u16*)(p.pp->ws + RW_L1);
      EpiP e{}; e.of = (float*)(p.pp->ws + RW_EW); e.f0 = p.pp->in[20];
      gemm_phase<EPI_RWKV_W>(p, L1, L1, L1, WT + W_RWKV_W2, WT + W_RWKV_W2, WT + W_RWKV_W2, 128, 64, 64, 1, 0, 8, e, lds);
      EpiP e2{}; e2.o16 = (u16*)(p.pp->ws + RW_A); e2.f0 = p.pp->in[23];
      gemm_phase<EPI_RWKV_A>(p, L1 + 64, L1 + 64, L1 + 64, WT + W_RWKV_A2, WT + W_RWKV_A2, WT + W_RWKV_A2, 128, 64, 64, 1, 0, 8, e2, lds);
    }
    xcd_barrier(xb);
#if DUP == 2
    rwkv_rec_phase(p, lds, p.pp->ws == nullptr);
    xcd_barrier(xb);
#endif
    rwkv_rec_phase(p, lds, true);
    xcd_barrier(xb);
    {
      pg8::EpiResid<true, true> e{p.pp->ws + XR3, p.pp->out, MOD + 2 * 16 * 3072};
      const u16* A = (const u16*)(p.pp->ws + RW_RKVG);
      pg8::run(lds, A, A, A, WT + W_RWKV_OUT, WT + W_RWKV_OUT, WT + W_RWKV_OUT, 4096, 1024, 4, 1, 1024, e);
    }
    xcd_barrier(xb);
    xcur = p.pp->out;
  }
  if (LAYER_MASK & 8) {
    for (int r_ = 0; r_ < ((DUP == 10) ? 2 : 1); ++r_) norm_phase<false, false, true>(p, p.pp->ws + XR3, 3, H, nullptr);
    xcd_barrier(xb);
    for (int r_ = 0; r_ < ((DUP == 9) ? 2 : 1); ++r_) {
      pg8::EpiPlain e{(u16*)(p.pp->ws + GL_P), 3088, 3088};
      pg8::run(lds, H, H, H, WT + W_GLA_IN, WT + W_GLA_IN, WT + W_GLA_IN, 1024, 1024, 4, 1, 3328, e);
    }
    xcd_barrier(xb);
    gla_pre_phase(p, lds);
    xcd_barrier(xb);
#if DUP == 3
    gla_phase(p, lds);
    xcd_barrier(xb);
#endif
    gla_phase(p, lds);
    xcd_barrier(xb);
    for (int r_ = 0; r_ < ((DUP == 10) ? 2 : 1); ++r_) gla_norm_phase(p);
    xcd_barrier(xb);
    {
      pg8::EpiResid<true, false> e{p.pp->out, p.pp->ws + XR3, MOD + 3 * 16 * 3072};
      pg8::run(lds, H, H, H, WT + W_GLA_OUT, WT + W_GLA_OUT, WT + W_GLA_OUT, 1024, 1024, 4, 1, 1024, e);
    }
    xcur = p.pp->out;
  }
  if (xcur != p.pp->out) {
    for (size_t i = (size_t)blockIdx.x * NTHR + tid_(); i < (size_t)T_ * 1024 / 4; i += (size_t)gridDim.x * NTHR)
      ((float4*)p.pp->out)[i] = ((const float4*)p.pp->in[0])[i];
  }
}

extern "C" void kernel_launch(void* const* d_in, const int* in_sizes, int n_in, void* d_out, int out_size, void* d_ws, size_t ws_size,
                              hipStream_t stream) {
  static int grid_blocks = 0;
  if (!grid_blocks) {
    int dev = 0, cus = 0, per_cu = 0;
    hipGetDevice(&dev);
    hipDeviceGetAttribute(&cus, hipDeviceAttributeMultiprocessorCount, dev);
    hipFuncSetAttribute((const void*)fwd_megakernel, hipFuncAttributeMaxDynamicSharedMemorySize, LDS_BYTES);
    hipOccupancyMaxActiveBlocksPerMultiprocessor(&per_cu, (const void*)fwd_megakernel, NTHR, LDS_BYTES);
    if (per_cu < 1) { fprintf(stderr, "occupancy query says %d blocks/CU\n", per_cu); per_cu = 1; }
    grid_blocks = cus;
  }
  Params p{};
  for (int i = 0; i < 37; ++i) p.in[i] = (const float*)d_in[i];
  p.out = (float*)d_out;
  p.ws = (unsigned char*)d_ws;
  for (int i = 0; i < 64; ++i) p.invf128[i] = (float)pow(10000.0, -(double)i / 64.0);
  for (int i = 0; i < 32; ++i) p.invf64[i] = (float)pow(10000.0, -(double)i / 32.0);
  void* args[] = {&p};
  hipError_t e = hipLaunchCooperativeKernel((const void*)fwd_megakernel, dim3(grid_blocks), dim3(NTHR), args, LDS_BYTES, stream);
  if (e != hipSuccess) fprintf(stderr, "cooperative launch failed: %s (grid %d)\n", hipGetErrorString(e), grid_blocks);
}
```

```cpp
#include <hip/hip_runtime.h>
#include <hip/hip_cooperative_groups.h>
#include <cstdio>
#include <cmath>
namespace cg = cooperative_groups;

#ifndef DUP
#define DUP 0
#endif
#ifndef LAYER_MASK
#define LAYER_MASK 15
#endif

typedef unsigned short u16;
using bf16x8 = __attribute__((ext_vector_type(8))) short;
using f32x4 = __attribute__((ext_vector_type(4))) float;

#define NTHR 512
constexpr int T_ = 32768;
constexpr size_t MiB = 1ull << 20;
constexpr int LDS_BYTES = 128 * 1024 + 64;
constexpr size_t WS_XBAR = 896 * 1024;

constexpr size_t WS_MOD = 0;
constexpr size_t WS_ROPE128 = 1 * MiB;
constexpr size_t WS_ROPE64 = 2 * MiB;
constexpr size_t WS_WT = 4 * MiB;
constexpr size_t WS_H = 52 * MiB;
constexpr size_t WS_H2 = 116 * MiB;
constexpr size_t WS_P = 180 * MiB;

constexpr size_t W_DSA_MAIN = 0;
constexpr size_t W_DSA_IDX_HI = W_DSA_MAIN + 2560ull * 1024;
constexpr size_t W_DSA_IDX_LO = W_DSA_IDX_HI + 1280ull * 1024;
constexpr size_t W_DSA_OUT = W_DSA_IDX_LO + 1280ull * 1024;
constexpr size_t W_LRU_IN = W_DSA_OUT + 1024ull * 1024;
constexpr size_t W_LRU_GATE = W_LRU_IN + 2048ull * 1024;
constexpr size_t W_LRU_OUT = W_LRU_GATE + 16ull * 128 * 64;
constexpr size_t W_RWKV_IN = W_LRU_OUT + 1024ull * 1024;
constexpr size_t W_RWKV_L1 = W_RWKV_IN + 4096ull * 2048;
constexpr size_t W_RWKV_W2 = W_RWKV_L1 + 128ull * 2048;
constexpr size_t W_RWKV_A2 = W_RWKV_W2 + 1024ull * 64;
constexpr size_t W_RWKV_OUT = W_RWKV_A2 + 1024ull * 64;
constexpr size_t W_GLA_IN = W_RWKV_OUT + 1024ull * 1024;
constexpr size_t W_GLA_OUT = W_GLA_IN + 3328ull * 1024;
constexpr size_t W_END = W_GLA_OUT + 1024ull * 1024;
static_assert(W_END * 2 <= 48 * MiB, "weights region");

constexpr size_t DSA_QKVG = WS_P;
constexpr size_t DSA_QIHI = WS_P + 160 * MiB;
constexpr size_t DSA_QILO = WS_P + 224 * MiB;
constexpr size_t DSA_KIHI = WS_P + 288 * MiB;
constexpr size_t DSA_KILO = WS_P + 296 * MiB;
constexpr size_t DSA_WI = WS_P + 304 * MiB;
constexpr size_t DSA_VT = WS_P + 306 * MiB;
constexpr size_t DSA_SCR = WS_H;
constexpr size_t LRU_UG = WS_H2;
constexpr size_t LRU_A = WS_H2 + 128 * MiB;
constexpr size_t LRU_B = WS_H2 + 256 * MiB;
constexpr size_t RW_RKVG = WS_P;
constexpr size_t RW_L1 = WS_P + 256 * MiB;
constexpr size_t RW_EW = WS_H;
constexpr size_t RW_A = WS_P + 264 * MiB;
constexpr size_t GL_P = WS_H2;
constexpr size_t GL_O = WS_H2 + 194 * MiB;
constexpr size_t GL_QD = WS_H2 + 258 * MiB;
constexpr size_t GL_KET = WS_H2 + 290 * MiB;
constexpr size_t GL_ATT_OUT = 0;
constexpr size_t GL_LAST_OUT = 16 * MiB;
constexpr size_t XR1 = 448 * MiB;
constexpr size_t XR3 = 438 * MiB;
constexpr size_t GL_VT = WS_H;

struct Params {
  const float* in[37];
  float* out;
  unsigned char* ws;
  float invf128[64];
  float invf64[32];
};

typedef const Params __attribute__((address_space(4))) * CParamsPtr;
struct PAcc { CParamsPtr pp; };

__device__ __forceinline__ int tid_() { int t = __builtin_amdgcn_workitem_id_x(); asm volatile("" : "+v"(t)); return t; }
__device__ __forceinline__ u16 f2bf(float f) {
  unsigned u = __float_as_uint(f);
  u += 0x7fffu + ((u >> 16) & 1u);
  return (u16)(u >> 16);
}
__device__ __forceinline__ float bf2f(u16 h) { return __uint_as_float(((unsigned)h) << 16); }
__device__ __forceinline__ float bflo(unsigned w) { return __uint_as_float(w << 16); }
__device__ __forceinline__ float bfhi(unsigned w) { return __uint_as_float(w & 0xffff0000u); }
__device__ __forceinline__ unsigned pack2(float a, float b) { return (unsigned)f2bf(a) | ((unsigned)f2bf(b) << 16); }
__device__ __forceinline__ float sigmoid_(float x) { return 1.f / (1.f + __expf(-x)); }
__device__ __forceinline__ float silu_(float x) { return x / (1.f + __expf(-x)); }
__device__ __forceinline__ float softplus_(float x) { return x > 20.f ? x : log1pf(__expf(x)); }
template <int CTRL> __device__ __forceinline__ float dpp(float x) {
  return __builtin_bit_cast(float, __builtin_amdgcn_mov_dpp(__builtin_bit_cast(int, x), CTRL, 0xf, 0xf, true));
}
__device__ __forceinline__ float red8(float x) {
  x += dpp<0xB1>(x); x += dpp<0x4E>(x); x += dpp<0x141>(x); return x;
}
typedef _Float16 f16x8_t __attribute__((ext_vector_type(8)));
typedef _Float16 f16x2_t __attribute__((ext_vector_type(2)));
__device__ __forceinline__ f32x4 mfma16h(bf16x8 a, bf16x8 b, f32x4 c) {
  return __builtin_amdgcn_mfma_f32_16x16x32_f16(__builtin_bit_cast(f16x8_t, a), __builtin_bit_cast(f16x8_t, b), c, 0, 0, 0);
}
__device__ __forceinline__ unsigned packh2(float a, float b) {
  f16x2_t v; v.x = (_Float16)a; v.y = (_Float16)b; return __builtin_bit_cast(unsigned, v);
}
__device__ __forceinline__ float hlo(unsigned w) { return (float)__builtin_bit_cast(f16x2_t, w).x; }
__device__ __forceinline__ float hhi(unsigned w) { return (float)__builtin_bit_cast(f16x2_t, w).y; }
__device__ __forceinline__ u16 f2h(float a) { return __builtin_bit_cast(u16, (_Float16)a); }
__device__ __forceinline__ float red32(float x) {
  x += dpp<0xB1>(x); x += dpp<0x4E>(x); x += dpp<0x141>(x); x += dpp<0x140>(x);
  const auto s_ = __builtin_amdgcn_permlane16_swap(__float_as_uint(x), __float_as_uint(x), false, false);
  return __uint_as_float(s_[0]) + __uint_as_float(s_[1]);
}
__device__ __forceinline__ f32x4 mfma16(bf16x8 a, bf16x8 b, f32x4 c) {
  return __builtin_amdgcn_mfma_f32_16x16x32_bf16(a, b, c, 0, 0, 0);
}
__device__ __forceinline__ void sincos_d(double x, float& c, float& s) {
  double k = rint(x * 0.63661977236758134308);
  double r = fma(-k, 1.57079632679489655800, x);
  r = fma(-k, 6.12323399573676603587e-17, r);
  int q = ((int)k) & 3;
  double r2 = r * r;
  double sp = r * (1.0 + r2 * (-1.0 / 6 + r2 * (1.0 / 120 + r2 * (-1.0 / 5040 + r2 * (1.0 / 362880 + r2 * (-1.0 / 39916800 + r2 * (1.0 / 6227020800.0)))))));
  double cp = 1.0 + r2 * (-0.5 + r2 * (1.0 / 24 + r2 * (-1.0 / 720 + r2 * (1.0 / 40320 + r2 * (-1.0 / 3628800 + r2 * (1.0 / 479001600.0 + r2 * (-1.0 / 87178291200.0)))))));
  double ss = (q == 0) ? sp : (q == 1) ? cp : (q == 2) ? -sp : -cp;
  double cc = (q == 0) ? cp : (q == 1) ? -sp : (q == 2) ? -cp : sp;
  c = (float)cc; s = (float)ss;
}

__device__ __forceinline__ int idx_perm(int p) {
  int wc = p >> 6, jn = (p >> 4) & 3, fr = p & 15;
  return wc * 32 + (jn & 1) * 16 + fr + 64 * (jn >> 1);
}
__device__ __forceinline__ void tconv_job(const float* __restrict__ src, int ld_src, int K, int nrows, int colmode, int col_off, int nvalid,
                          u16* __restrict__ dst, u16* __restrict__ dst_lo, int ldd, int dst_col0,
                          const float* __restrict__ mu, int smode, float* tl, int fmt = 0) {
  const int tid = tid_();
  const int tk = K >> 6, tn = nrows >> 6;
  for (int tile = blockIdx.x; tile < tk * tn; tile += gridDim.x) {
    const int k0 = (tile % tk) << 6, j0 = (tile / tk) << 6;
    {
      const int jn = tid & 63;
      const int j = j0 + jn;
      int col;
      if (colmode == 0) col = (j < nvalid) ? col_off + j : -1;
      else if (colmode == 2) {
        if (j < 1280) { const int P = j & 255; col = (j & ~255) + ((P >> 5) & 3) * 64 + 32 * (P >> 7) + (P & 31); }
        else col = j;
      } else {
        const int P = j & 255, bj = P >> 7, wcc = (P >> 5) & 3, r5 = P & 31;
        if (j < 1024) col = 2560 + ((j >> 8) * 2 + (wcc >> 1)) * 128 + 32 * (wcc & 1) + r5 + 64 * bj;
        else if (wcc < 2) col = 3592 + 32 * (wcc & 1) + r5 + 64 * bj;
        else if (wcc == 2 && bj == 0 && r5 < 8) col = 3584 + r5;
        else col = -1;
      }
#pragma unroll
      for (int i = 0; i < 8; ++i) {
        const int kr = i * 8 + (tid >> 6);
        float v = 0.f;
        if (col >= 0) v = src[(size_t)(k0 + kr) * ld_src + col];
        if (smode == 1) v *= (1.f - mu[k0 + kr]);
        else if (smode == 2) v *= mu[k0 + kr];
        tl[kr * 65 + jn] = v;
      }
    }
    __syncthreads();
    {
      const int kr = tid & 63;
#pragma unroll
      for (int i = 0; i < 8; ++i) {
        const int jn = i * 8 + (tid >> 6);
        float v = tl[kr * 65 + jn];
        u16 hi = fmt ? f2h(v) : f2bf(v);
        size_t o = (size_t)(j0 + jn) * ldd + dst_col0 + k0 + kr;
        dst[o] = hi;
        if (dst_lo) dst_lo[o] = f2bf(v - bf2f(hi));
      }
    }
    __syncthreads();
  }
}

__device__ __forceinline__ void prep_phase(const PAcc& p, char* lds) {
  const int tid = tid_();
  u16* WT = (u16*)(p.pp->ws + WS_WT);
  float* fl = (float*)lds;
  if (blockIdx.x < 192) {
    float* cact = fl;
    float* red = fl + 16384;
    const float* c = p.pp->in[1];
    for (int i = tid; i < 16384; i += NTHR) { int b = i >> 10, k = i & 1023; cact[k * 16 + b] = silu_(c[i]); }
    __syncthreads();
    for (int item = blockIdx.x; item < 192; item += gridDim.x) {
      const int l = item / 48, n0 = (item % 48) * 64;
      const int col = tid & 63, kq = tid >> 6;
      float acc[16];
#pragma unroll
      for (int b = 0; b < 16; ++b) acc[b] = 0.f;
      const float* w = p.pp->in[3] + (size_t)l * 1024 * 3072 + n0 + col;
#pragma unroll 16
      for (int k = kq * 128; k < kq * 128 + 128; ++k) {
        float wv = w[(size_t)k * 3072];
        const float4* cp = (const float4*)(cact + k * 16);
        float4 c0 = cp[0], c1 = cp[1], c2 = cp[2], c3 = cp[3];
        acc[0] += c0.x * wv; acc[1] += c0.y * wv; acc[2] += c0.z * wv; acc[3] += c0.w * wv;
        acc[4] += c1.x * wv; acc[5] += c1.y * wv; acc[6] += c1.z * wv; acc[7] += c1.w * wv;
        acc[8] += c2.x * wv; acc[9] += c2.y * wv; acc[10] += c2.z * wv; acc[11] += c2.w * wv;
        acc[12] += c3.x * wv; acc[13] += c3.y * wv; acc[14] += c3.z * wv; acc[15] += c3.w * wv;
      }
#pragma unroll
      for (int b = 0; b < 16; ++b) red[(kq * 16 + b) * 64 + col] = acc[b];
      __syncthreads();
      for (int o = tid; o < 1024; o += NTHR) {
        int b = o >> 6, cc = o & 63;
        float s = 0.f;
#pragma unroll
        for (int q = 0; q < 8; ++q) s += red[(q * 16 + b) * 64 + cc];
        ((float*)(p.pp->ws + WS_MOD))[((size_t)l * 16 + b) * 3072 + n0 + cc] = s + p.pp->in[4][l * 3072 + n0 + cc];
      }
      __syncthreads();
    }
  }
  __syncthreads();
  {
    const float f128 = p.pp->invf128[tid & 63], f64 = p.pp->invf64[tid & 31];
    float2* r128 = (float2*)(p.pp->ws + WS_ROPE128);
    float2* r64 = (float2*)(p.pp->ws + WS_ROPE64);
    for (int idx = blockIdx.x * NTHR + tid; idx < 2048 * 64; idx += gridDim.x * NTHR) {
      int pos = idx >> 6;
      float ang = (float)pos * f128;
      float c_, s_; sincos_d((double)ang, c_, s_);
      r128[idx] = make_float2(c_, s_);
    }
    for (int idx = blockIdx.x * NTHR + tid; idx < 2048 * 32; idx += gridDim.x * NTHR) {
      int pos = idx >> 5;
      float ang = (float)pos * f64;
      float c_, s_; sincos_d((double)ang, c_, s_);
      r64[idx] = make_float2(c_, s_);
    }
  }
  float* tl = fl;
  tconv_job(p.pp->in[5], 3720, 1024, 2560, 2, 0, 2560, WT + W_DSA_MAIN, nullptr, 1024, 0, nullptr, 0, tl, 1);
  tconv_job(p.pp->in[5], 3720, 1024, 1280, 3, 0, 0, WT + W_DSA_IDX_HI, nullptr, 1024, 0, nullptr, 0, tl, 1);
  tconv_job(p.pp->in[8], 1024, 1024, 1024, 0, 0, 1024, WT + W_DSA_OUT, nullptr, 1024, 0, nullptr, 0, tl);
  tconv_job(p.pp->in[9], 2048, 1024, 2048, 0, 0, 2048, WT + W_LRU_IN, nullptr, 1024, 0, nullptr, 0, tl);
  tconv_job(p.pp->in[17], 1024, 1024, 1024, 0, 0, 1024, WT + W_LRU_OUT, nullptr, 1024, 0, nullptr, 0, tl);
  for (int n = 0; n < 4; ++n) {
    tconv_job(p.pp->in[19] + (size_t)n * 1024 * 1024, 1024, 1024, 1024, 0, 0, 1024, WT + W_RWKV_IN + (size_t)n * 1024 * 2048, nullptr, 2048, 0, p.pp->in[18] + n * 1024, 1, tl);
    tconv_job(p.pp->in[19] + (size_t)n * 1024 * 1024, 1024, 1024, 1024, 0, 0, 1024, WT + W_RWKV_IN + (size_t)n * 1024 * 2048, nullptr, 2048, 1024, p.pp->in[18] + n * 1024, 2, tl);
  }
  tconv_job(p.pp->in[21], 64, 1024, 64, 0, 0, 64, WT + W_RWKV_L1, nullptr, 2048, 0, p.pp->in[18] + 4 * 1024, 1, tl);
  tconv_job(p.pp->in[21], 64, 1024, 64, 0, 0, 64, WT + W_RWKV_L1, nullptr, 2048, 1024, p.pp->in[18] + 4 * 1024, 2, tl);
  tconv_job(p.pp->in[24], 64, 1024, 64, 0, 0, 64, WT + W_RWKV_L1 + 64 * 2048, nullptr, 2048, 0, p.pp->in[18] + 5 * 1024, 1, tl);
  tconv_job(p.pp->in[24], 64, 1024, 64, 0, 0, 64, WT + W_RWKV_L1 + 64 * 2048, nullptr, 2048, 1024, p.pp->in[18] + 5 * 1024, 2, tl);
  tconv_job(p.pp->in[22], 1024, 64, 1024, 0, 0, 1024, WT + W_RWKV_W2, nullptr, 64, 0, nullptr, 0, tl);
  tconv_job(p.pp->in[25], 1024, 64, 1024, 0, 0, 1024, WT + W_RWKV_A2, nullptr, 64, 0, nullptr, 0, tl);
  tconv_job(p.pp->in[31], 1024, 1024, 1024, 0, 0, 1024, WT + W_RWKV_OUT, nullptr, 1024, 0, nullptr, 0, tl);
  tconv_job(p.pp->in[32], 3088, 1024, 3328, 0, 0, 3088, WT + W_GLA_IN, nullptr, 1024, 0, nullptr, 0, tl);
  tconv_job(p.pp->in[36], 1024, 1024, 1024, 0, 0, 1024, WT + W_GLA_OUT, nullptr, 1024, 0, nullptr, 0, tl);
  for (int idx = blockIdx.x * NTHR + tid; idx < 16 * 128 * 64; idx += gridDim.x * NTHR) {
    int n = idx >> 13, pp = (idx >> 6) & 127, k = idx & 63;
    int wc = pp >> 6, jn = (pp >> 4) & 3, fr = pp & 15;
    int type = jn & 1, d = wc * 32 + (jn >> 1) * 16 + fr;
    const float* src = type ? p.pp->in[14] : p.pp->in[12];
    WT[W_LRU_GATE + idx] = f2bf(src[n * 4096 + k * 64 + d]);
  }
}

template <bool SHIFT, bool F16 = false, bool IN16 = false>
__device__ __forceinline__ void norm_phase(const PAcc& p, const void* __restrict__ xin, int layer, u16* __restrict__ Hhi, u16* __restrict__ Hlo) {
  const int lane = tid_() & 63;
  const int gw = blockIdx.x * (NTHR / 64) + (tid_() >> 6);
  const int nw = gridDim.x * (NTHR / 64);
  const float* gain = p.pp->in[2] + layer * 1024;
  const float* mod = (const float*)(p.pp->ws + WS_MOD) + (size_t)layer * 16 * 3072;
  for (int row = gw; row < T_; row += nw) {
    float4 v[4];
    float ss = 0.f;
    if (IN16) {
      const uint2* xr = (const uint2*)((const u16*)xin + (size_t)row * 1024);
#pragma unroll
      for (int i = 0; i < 4; ++i) { const uint2 t = xr[i * 64 + lane]; v[i] = make_float4(bflo(t.x), bfhi(t.x), bflo(t.y), bfhi(t.y)); }
    } else {
      const float4* xr = (const float4*)((const float*)xin + (size_t)row * 1024);
#pragma unroll
      for (int i = 0; i < 4; ++i) v[i] = xr[i * 64 + lane];
    }
#pragma unroll
    for (int i = 0; i < 4; ++i) ss += v[i].x * v[i].x + v[i].y * v[i].y + v[i].z * v[i].z + v[i].w * v[i].w;
#pragma unroll
    for (int m = 32; m >= 1; m >>= 1) ss += __shfl_xor(ss, m);
    const float rstd = rsqrtf(ss * (1.f / 1024.f) + 1e-6f);
    const float* mb = mod + (size_t)(row >> 11) * 3072;
#pragma unroll
    for (int i = 0; i < 4; ++i) {
      const int c = i * 256 + lane * 4;
      float4 g = *(const float4*)(gain + c);
      float4 sh = *(const float4*)(mb + c);
      float4 sc = *(const float4*)(mb + 1024 + c);
      float y0 = v[i].x * rstd * g.x * (1.f + sc.x) + sh.x;
      float y1 = v[i].y * rstd * g.y * (1.f + sc.y) + sh.y;
      float y2 = v[i].z * rstd * g.z * (1.f + sc.z) + sh.z;
      float y3 = v[i].w * rstd * g.w * (1.f + sc.w) + sh.w;
      uint2 o;
      if (F16) { o.x = packh2(y0, y1); o.y = packh2(y2, y3); }
      else { o.x = pack2(y0, y1); o.y = pack2(y2, y3); }
      if (SHIFT) {
        *(uint2*)(Hhi + (size_t)row * 2048 + c) = o;
        if (((row + 1) & 2047) != 0) *(uint2*)(Hhi + (size_t)(row + 1) * 2048 + 1024 + c) = o;
        if ((row & 2047) == 0) *(uint2*)(Hhi + (size_t)row * 2048 + 1024 + c) = make_uint2(0u, 0u);
      } else {
        *(uint2*)(Hhi + (size_t)row * 1024 + c) = o;
      }
      if (!SHIFT && Hlo) {
        uint2 l;
        l.x = packh2(y0 - hlo(o.x), y1 - hhi(o.x));
        l.y = packh2(y2 - hlo(o.y), y3 - hhi(o.y));
        *(uint2*)(Hlo + (size_t)row * 1024 + c) = l;
      }
    }
  }
}

enum { EPI_PLAIN = 0, EPI_DSA_MAIN, EPI_DSA_IDX, EPI_RESID, EPI_RWKV_L1, EPI_RWKV_W, EPI_RWKV_A };
struct EpiP {
  u16* o16; u16* o16b; u16* o16c; u16* o16d; float* of; const float* f0; const float* f1; const float* f2; const float* f3;
  int ldc; int nvalid;
};
constexpr int LROW = 40;

template <int EPI>
__device__ __forceinline__ void gemm_epilogue(const EpiP& e, const PAcc& p, f32x4 (&acc)[4][4], int rowbase, int colbase, int nt, int wc, int fr, int fq) {
  if (EPI == EPI_PLAIN) {
#pragma unroll
    for (int i = 0; i < 4; ++i)
#pragma unroll
      for (int j = 0; j < 4; ++j) {
        const int col = colbase + j * 16 + fr;
        if (col < e.nvalid) {
#pragma unroll
          for (int r = 0; r < 4; ++r) e.o16[(size_t)(rowbase + i * 16 + fq * 4 + r) * e.ldc + col] = f2bf(acc[i][j][r]);
        }
      }
  } else if (EPI == EPI_DSA_MAIN) {
    if (nt < 10) {
      const float* gain = (nt < 8) ? e.f0 : e.f1;
      const float g0 = gain[fr], g1 = gain[16 + fr], g2 = gain[32 + fr], g3 = gain[48 + fr];
      const float2* rope = (const float2*)(p.pp->ws + WS_ROPE64);
#pragma unroll
      for (int i = 0; i < 4; ++i)
#pragma unroll
        for (int r = 0; r < 4; ++r) {
          float v0 = acc[i][0][r], v1 = acc[i][1][r], v2 = acc[i][2][r], v3 = acc[i][3][r];
          float ss = v0 * v0 + v1 * v1 + v2 * v2 + v3 * v3;
          ss += __shfl_xor(ss, 1); ss += __shfl_xor(ss, 2); ss += __shfl_xor(ss, 4); ss += __shfl_xor(ss, 8);
          const float rstd = rsqrtf(ss * (1.f / 64.f) + 1e-6f);
          v0 *= rstd * g0; v1 *= rstd * g1; v2 *= rstd * g2; v3 *= rstd * g3;
          const int row = rowbase + i * 16 + fq * 4 + r;
          const int pos = row & 2047;
          const float2 ca = rope[pos * 32 + fr], cb = rope[pos * 32 + 16 + fr];
          const float o0 = v0 * ca.x - v2 * ca.y, o2 = v2 * ca.x + v0 * ca.y;
          const float o1 = v1 * cb.x - v3 * cb.y, o3 = v3 * cb.x + v1 * cb.y;
          u16* d = e.o16 + (size_t)row * 2560 + colbase + fr;
          d[0] = f2bf(o0); d[16] = f2bf(o1); d[32] = f2bf(o2); d[48] = f2bf(o3);
        }
    } else {
#pragma unroll
      for (int i = 0; i < 4; ++i)
#pragma unroll
        for (int j = 0; j < 4; ++j)
#pragma unroll
          for (int r = 0; r < 4; ++r) e.o16[(size_t)(rowbase + i * 16 + fq * 4 + r) * 2560 + colbase + j * 16 + fr] = f2bf(acc[i][j][r]);
    }
  } else if (EPI == EPI_DSA_IDX) {
    if (nt < 9) {
      const float2* rope = (const float2*)(p.pp->ws + WS_ROPE128);
#pragma unroll
      for (int i = 0; i < 4; ++i)
#pragma unroll
        for (int r = 0; r < 4; ++r) {
          const int row = rowbase + i * 16 + fq * 4 + r;
          const int pos = row & 2047;
#pragma unroll
          for (int jj = 0; jj < 2; ++jj) {
            const int ii = wc * 32 + jj * 16 + fr;
            const float2 cs = rope[pos * 64 + ii];
            const float x1 = acc[i][jj][r], x2 = acc[i][jj + 2][r];
            const float o1 = x1 * cs.x - x2 * cs.y, o2 = x2 * cs.x + x1 * cs.y;
            const u16 h1 = f2bf(o1), h2 = f2bf(o2);
            const u16 l1 = f2bf(o1 - bf2f(h1)), l2 = f2bf(o2 - bf2f(h2));
            if (nt < 8) {
              size_t o = (size_t)row * 1024 + nt * 128 + ii;
              e.o16[o] = h1; e.o16[o + 64] = h2; e.o16b[o] = l1; e.o16b[o + 64] = l2;
            } else {
              size_t o = (size_t)row * 128 + ii;
              e.o16c[o] = h1; e.o16c[o + 64] = h2; e.o16d[o] = l1; e.o16d[o + 64] = l2;
            }
          }
        }
    } else {
      if (wc == 0 && fr < 8) {
#pragma unroll
        for (int i = 0; i < 4; ++i)
#pragma unroll
          for (int r = 0; r < 4; ++r) e.of[(size_t)(rowbase + i * 16 + fq * 4 + r) * 8 + fr] = acc[i][0][r] * 0.03125f;
      }
    }
  } else if (EPI == EPI_RESID) {
#pragma unroll
    for (int i = 0; i < 4; ++i)
#pragma unroll
      for (int j = 0; j < 4; ++j) {
        const int col = colbase + j * 16 + fr;
#pragma unroll
        for (int r = 0; r < 4; ++r) {
          const int row = rowbase + i * 16 + fq * 4 + r;
          const float gate = e.f1[(size_t)(row >> 11) * 3072 + 2048 + col];
          const size_t o = (size_t)row * 1024 + col;
          e.of[o] = e.f0[o] + gate * acc[i][j][r];
        }
      }
  } else if (EPI == EPI_RWKV_L1) {
#pragma unroll
    for (int i = 0; i < 4; ++i)
#pragma unroll
      for (int j = 0; j < 4; ++j) {
        const int col = colbase + j * 16 + fr;
#pragma unroll
        for (int r = 0; r < 4; ++r) {
          float v = acc[i][j][r];
          if (col < 64) v = tanhf(v);
          e.o16[(size_t)(rowbase + i * 16 + fq * 4 + r) * 128 + col] = f2bf(v);
        }
      }
  } else if (EPI == EPI_RWKV_W) {
#pragma unroll
    for (int i = 0; i < 4; ++i)
#pragma unroll
      for (int j = 0; j < 4; ++j) {
        const int col = colbase + j * 16 + fr;
        const float w0 = e.f0[col];
#pragma unroll
        for (int r = 0; r < 4; ++r) {
          const float w = w0 + acc[i][j][r];
          e.of[(size_t)(rowbase + i * 16 + fq * 4 + r) * 1024 + col] = __expf(-softplus_(-w) - 0.5f);
        }
      }
  } else if (EPI == EPI_RWKV_A) {
#pragma unroll
    for (int i = 0; i < 4; ++i)
#pragma unroll
      for (int j = 0; j < 4; ++j) {
        const int col = colbase + j * 16 + fr;
        const float a0 = e.f0[col];
#pragma unroll
        for (int r = 0; r < 4; ++r)
          e.o16[(size_t)(rowbase + i * 16 + fq * 4 + r) * 1024 + col] = f2bf(sigmoid_(a0 + acc[i][j][r]));
      }
  }
}

template <int EPI>
__device__ __forceinline__ void gemm_phase(const PAcc& p, const u16* A0, const u16* A1, const u16* A2, const u16* B0, const u16* B1, const u16* B2,
                           int lda, int ldb, int kseg, int nseg, int shiftmask, int ntn, const EpiP& e, char* ldsc) {
  const int tid = tid_(), lane = tid & 63, wave = tid >> 6;
  const int wr = wave >> 1, wc = wave & 1, fr = lane & 15, fq = lane >> 4;
  u16* As = (u16*)ldsc;
  u16* Bs = As + 2 * 256 * LROW;
  const int kps = kseg >> 5;
  const int nk = nseg * kps;
  const int ntiles = 128 * ntn;
  const int lrow = tid >> 2, lkc = (tid & 3) * 8;
  for (int tile = blockIdx.x; tile < ntiles; tile += gridDim.x) {
    const int mt = tile / ntn, nt = tile - mt * ntn;
    const int m0 = mt * 256, n0 = nt * 128;
    f32x4 acc[4][4];
#pragma unroll
    for (int i = 0; i < 4; ++i)
#pragma unroll
      for (int j = 0; j < 4; ++j) acc[i][j] = (f32x4){0.f, 0.f, 0.f, 0.f};
    uint4 ra0, ra1, rb;
#define GLOAD(ks_)                                                                           \
  {                                                                                          \
    const int s_ = (ks_) / kps;                                                              \
    const int kk_ = ((ks_) - s_ * kps) << 5;                                                 \
    const u16* Ap_ = s_ == 0 ? A0 : (s_ == 1 ? A1 : A2);                                     \
    const u16* Bp_ = s_ == 0 ? B0 : (s_ == 1 ? B1 : B2);                                     \
    const int sh_ = (shiftmask >> s_) & 1;                                                   \
    const int g0_ = m0 + lrow, g1_ = m0 + 128 + lrow;                                        \
    ra0 = (sh_ && (g0_ & 2047) == 0) ? make_uint4(0, 0, 0, 0) : *(const uint4*)(Ap_ + (size_t)(g0_ - sh_) * lda + kk_ + lkc); \
    ra1 = (sh_ && (g1_ & 2047) == 0) ? make_uint4(0, 0, 0, 0) : *(const uint4*)(Ap_ + (size_t)(g1_ - sh_) * lda + kk_ + lkc); \
    rb = *(const uint4*)(Bp_ + (size_t)(n0 + lrow) * ldb + kk_ + lkc);                       \
  }
#define LSTORE(buf_)                                                                         \
  {                                                                                          \
    *(uint4*)(As + ((buf_) * 256 + lrow) * LROW + lkc) = ra0;                                \
    *(uint4*)(As + ((buf_) * 256 + 128 + lrow) * LROW + lkc) = ra1;                          \
    *(uint4*)(Bs + ((buf_) * 128 + lrow) * LROW + lkc) = rb;                                 \
  }
    GLOAD(0);
    LSTORE(0);
    __syncthreads();
    for (int ks = 0; ks < nk; ++ks) {
      const int buf = ks & 1;
      if (ks + 1 < nk) GLOAD(ks + 1);
      bf16x8 af[4], bfr[4];
#pragma unroll
      for (int i = 0; i < 4; ++i) af[i] = *(const bf16x8*)(As + (buf * 256 + wr * 64 + i * 16 + fr) * LROW + fq * 8);
#pragma unroll
      for (int j = 0; j < 4; ++j) bfr[j] = *(const bf16x8*)(Bs + (buf * 128 + wc * 64 + j * 16 + fr) * LROW + fq * 8);
#pragma unroll
      for (int i = 0; i < 4; ++i)
#pragma unroll
        for (int j = 0; j < 4; ++j) acc[i][j] = mfma16(af[i], bfr[j], acc[i][j]);
      if (ks + 1 < nk) LSTORE(buf ^ 1);
      __syncthreads();
    }
#undef GLOAD
#undef LSTORE
    gemm_epilogue<EPI>(e, p, acc, m0 + wr * 64, n0 + wc * 64, nt, wc, fr, fq);
  }
}


namespace pg8 {
#define PG8_LAS __attribute__((address_space(3)))
typedef unsigned u32x4 __attribute__((ext_vector_type(4)));
constexpr int BM = 256, BK = 64, HALF = 128, HTB = HALF * BK * 2, NXCD = 8, WGM = 8;
__device__ __forceinline__ int lds_byte(int r, int c) { const int st = (r >> 4) * 2 + (c >> 5), rr = r & 15, cc = c & 31, ob = rr * 64 + cc * 2; return st * 1024 + (ob ^ (((ob >> 9) & 1) << 5)); }
__device__ __forceinline__ void stage_rc(int b, int& R, int& C) { const int st = b / 1024, sb = b % 1024, swz = sb ^ (((sb >> 9) & 1) << 5); R = (st >> 1) * 16 + swz / 64; C = (st & 1) * 32 + (swz % 64) / 2; }
__device__ __forceinline__ int perm32(int rho) { const int n = rho >> 4, i = rho & 15; return 8 * (i >> 2) + 4 * n + (i & 3); }
struct Unit { int pm, pn; };
struct GemmD { const u16 *A0, *A1, *A2, *B0, *B1, *B2; int lda, ldb, lgnts, nseg, M, N; };
struct StaticOrder {
  int nM, nN, nwg, G, c;
  __device__ void init(int M, int N, int G_, int c_) { nM = M / BM; nN = N / BM; nwg = nM * nN; G = G_; c = c_; }
  __device__ bool next(int i, Unit& u) const {
    const long L = (long)i * G + c; if (L >= nwg) return false;
    int wgid = (int)L; { const int q = nwg / NXCD, r = nwg % NXCD, xcd = wgid % NXCD, off = wgid / NXCD; wgid = (xcd < r ? xcd * (q + 1) : r * (q + 1) + (xcd - r) * q) + off; }
    const int nig = WGM * nN, gid = wgid / nig, fm = gid * WGM, gsz = (nM - fm) < WGM ? (nM - fm) : WGM;
    u.pm = fm + ((wgid % nig) % gsz); u.pn = (wgid % nig) / gsz; return true;
  }
};
__device__ __forceinline__ unsigned cvt_pk_bf16(float lo, float hi) { unsigned r; asm volatile("v_cvt_pk_bf16_f32 %0, %1, %2" : "=v"(r) : "v"(lo), "v"(hi)); return r; }

struct EpiPlain {
  static constexpr bool PERM = true;
  u16* O; int ldc; int nvalid;
  __device__ __forceinline__ void operator()(const f32x4 (&acc)[2][2][4][2], const Unit& u, int wr, int wc, int fr, int fq) const {
    asm volatile("" : "+v"(fr), "+v"(fq));
    const int row0 = u.pm * BM + wr * 64 + fr, col0 = u.pn * BM + wc * 32 + 8 * fq;
#pragma unroll
    for (int ai = 0; ai < 2; ++ai)
#pragma unroll
      for (int m = 0; m < 4; ++m) {
        u16* rowp = O + (size_t)(row0 + ai * HALF + m * 16) * ldc;
#pragma unroll
        for (int bj = 0; bj < 2; ++bj) {
          const int col = col0 + bj * HALF;
          if (col < nvalid) {
            const f32x4 v0 = acc[ai][bj][m][0], v1 = acc[ai][bj][m][1];
            u32x4 w; w.x = cvt_pk_bf16(v0[0], v0[1]); w.y = cvt_pk_bf16(v0[2], v0[3]); w.z = cvt_pk_bf16(v1[0], v1[1]); w.w = cvt_pk_bf16(v1[2], v1[3]);
            *(u32x4*)(rowp + col) = w;
          }
        }
      }
  }
};
template <bool IN16, bool OUT16>
struct EpiResid {
  static constexpr bool PERM = true;
  void* out; const void* xin; const float* mod;
  __device__ __forceinline__ void operator()(const f32x4 (&acc)[2][2][4][2], const Unit& u, int wr, int wc, int fr, int fq) const {
    asm volatile("" : "+v"(fr), "+v"(fq));
    const int row0 = u.pm * BM + wr * 64 + fr, col0 = u.pn * BM + wc * 32 + 8 * fq;
#pragma unroll
    for (int ai = 0; ai < 2; ++ai)
#pragma unroll
      for (int m = 0; m < 4; ++m) {
        const int row = row0 + ai * HALF + m * 16;
        const float* gp = mod + (size_t)(row >> 11) * 3072 + 2048;
#pragma unroll
        for (int bj = 0; bj < 2; ++bj) {
          const int col = col0 + bj * HALF;
          const size_t o = (size_t)row * 1024 + col;
          const f32x4 g0 = *(const f32x4*)(gp + col), g1 = *(const f32x4*)(gp + col + 4);
          f32x4 x0, x1;
          if (IN16) {
            const u32x4 xv = *(const u32x4*)((const u16*)xin + o);
            x0 = (f32x4){bflo(xv.x), bfhi(xv.x), bflo(xv.y), bfhi(xv.y)};
            x1 = (f32x4){bflo(xv.z), bfhi(xv.z), bflo(xv.w), bfhi(xv.w)};
          } else {
            x0 = *(const f32x4*)((const float*)xin + o); x1 = *(const f32x4*)((const float*)xin + o + 4);
          }
          const f32x4 y0 = x0 + g0 * acc[ai][bj][m][0], y1 = x1 + g1 * acc[ai][bj][m][1];
          if (OUT16) {
            u32x4 w; w.x = cvt_pk_bf16(y0[0], y0[1]); w.y = cvt_pk_bf16(y0[2], y0[3]); w.z = cvt_pk_bf16(y1[0], y1[1]); w.w = cvt_pk_bf16(y1[2], y1[3]);
            *(u32x4*)((u16*)out + o) = w;
          } else {
            *(f32x4*)((float*)out + o) = y0; *(f32x4*)((float*)out + o + 4) = y1;
          }
        }
      }
  }
};
struct EpiDsaMain {
  static constexpr bool PERM = true;
  u16* O; const float* qg; const float* kg; const float2* rope; u16* VT;
  __device__ __forceinline__ void operator()(const f32x4 (&acc)[2][2][4][2], const Unit& u, int wr, int wc, int fr, int fq) const {
    asm volatile("" : "+v"(fr), "+v"(fq));
    const int row0 = u.pm * BM + wr * 64 + fr;
    if (u.pn <= 4) {
      const float* gain = (u.pn < 4) ? qg : kg;
      const int cb = u.pn * 256 + wc * 64 + 8 * fq;
#pragma unroll
      for (int ai = 0; ai < 2; ++ai)
#pragma unroll
        for (int m = 0; m < 4; ++m) {
          const int row = row0 + ai * HALF + m * 16;
          float ss = 0.f;
#pragma unroll
          for (int n = 0; n < 2; ++n)
#pragma unroll
            for (int j = 0; j < 4; ++j) { const float x = acc[ai][0][m][n][j], y = acc[ai][1][m][n][j]; ss += x * x + y * y; }
          ss += __shfl_xor(ss, 16); ss += __shfl_xor(ss, 32);
          const float rstd = rsqrtf(ss * (1.f / 64.f) + 1e-6f);
          const float2* rp = rope + (row & 2047) * 32 + 8 * fq;
          u16* d = O + (size_t)row * 2560 + cb;
#pragma unroll
          for (int n = 0; n < 2; ++n) {
            float ol[4], oh[4];
#pragma unroll
            for (int j = 0; j < 4; ++j) {
              const int e = 4 * n + j;
              const float2 cs = rp[e];
              const float xn = acc[ai][0][m][n][j] * rstd * gain[8 * fq + e], yn = acc[ai][1][m][n][j] * rstd * gain[32 + 8 * fq + e];
              ol[j] = xn * cs.x - yn * cs.y; oh[j] = yn * cs.x + xn * cs.y;
            }
            uint2 w; w.x = cvt_pk_bf16(ol[0], ol[1]); w.y = cvt_pk_bf16(ol[2], ol[3]);
            *(uint2*)(d + 4 * n) = w;
            w.x = cvt_pk_bf16(oh[0], oh[1]); w.y = cvt_pk_bf16(oh[2], oh[3]);
            *(uint2*)(d + 32 + 4 * n) = w;
          }
        }
    } else if (u.pn == 5) {
#pragma unroll
      for (int ai = 0; ai < 2; ++ai)
#pragma unroll
        for (int m = 0; m < 4; ++m) {
          const int row = row0 + ai * HALF + m * 16;
          u16* vb = VT + (size_t)(row >> 11) * 256 * 2048 + (row & 2047);
#pragma unroll
          for (int bj = 0; bj < 2; ++bj)
#pragma unroll
            for (int n = 0; n < 2; ++n)
#pragma unroll
              for (int j = 0; j < 4; ++j) vb[(size_t)(128 * bj + 32 * wc + 8 * fq + 4 * n + j) * 2048] = f2bf(acc[ai][bj][m][n][j]);
        }
    } else {
      const int col0 = u.pn * BM + wc * 32 + 8 * fq;
#pragma unroll
      for (int ai = 0; ai < 2; ++ai)
#pragma unroll
        for (int m = 0; m < 4; ++m) {
          u16* rowp = O + (size_t)(row0 + ai * HALF + m * 16) * 2560 + col0;
#pragma unroll
          for (int bj = 0; bj < 2; ++bj) {
            const f32x4 v0 = acc[ai][bj][m][0], v1 = acc[ai][bj][m][1];
            u32x4 w; w.x = cvt_pk_bf16(v0[0], v0[1]); w.y = cvt_pk_bf16(v0[2], v0[3]); w.z = cvt_pk_bf16(v1[0], v1[1]); w.w = cvt_pk_bf16(v1[2], v1[3]);
            *(u32x4*)(rowp + bj * HALF) = w;
          }
        }
    }
  }
};
struct EpiDsaIdx {
  static constexpr bool PERM = true;
  u16 *qh, *ql, *kh, *kl; float* wi; const float2* rope;
  __device__ __forceinline__ void operator()(const f32x4 (&acc)[2][2][4][2], const Unit& u, int wr, int wc, int fr, int fq) const {
    asm volatile("" : "+v"(fr), "+v"(fq));
    const int row0 = u.pm * BM + wr * 64 + fr;
    if (u.pn < 4 || wc < 2) {
      const int dl = 32 * (wc & 1) + 8 * fq;
      u16* dh; size_t ld; int cb;
      if (u.pn < 4) { dh = qh; ld = 1024; cb = (u.pn * 2 + (wc >> 1)) * 128 + dl; }
      else { dh = kh; ld = 128; cb = dl; }
#pragma unroll
      for (int ai = 0; ai < 2; ++ai)
#pragma unroll
        for (int m = 0; m < 4; ++m) {
          const int row = row0 + ai * HALF + m * 16;
          const float2* rp = rope + (row & 2047) * 64 + dl;
          const size_t o = (size_t)row * ld + cb;
#pragma unroll
          for (int n = 0; n < 2; ++n) {
            float o1[4], o2[4];
#pragma unroll
            for (int j = 0; j < 4; ++j) {
              const float2 cs = rp[4 * n + j];
              const float x = acc[ai][0][m][n][j], y = acc[ai][1][m][n][j];
              o1[j] = x * cs.x - y * cs.y; o2[j] = y * cs.x + x * cs.y;
            }
            uint2 h1, h2;
            h1.x = packh2(o1[0], o1[1]); h1.y = packh2(o1[2], o1[3]);
            h2.x = packh2(o2[0], o2[1]); h2.y = packh2(o2[2], o2[3]);
            *(uint2*)(dh + o + 4 * n) = h1; *(uint2*)(dh + o + 64 + 4 * n) = h2;
          }
        }
    } else if (wc == 2 && fq == 0) {
#pragma unroll
      for (int ai = 0; ai < 2; ++ai)
#pragma unroll
        for (int m = 0; m < 4; ++m) {
          const int row = row0 + ai * HALF + m * 16;
          *(f32x4*)(wi + (size_t)row * 8) = acc[ai][0][m][0] * 0.03125f;
          *(f32x4*)(wi + (size_t)row * 8 + 4) = acc[ai][0][m][1] * 0.03125f;
        }
    }
  }
};

template <class Epi, bool F16>
__device__ __forceinline__ void gemm_phase(PG8_LAS unsigned char* lds, const GemmD g, const StaticOrder& S, const Epi& E) {
  const int tid = tid_(), wid = __builtin_amdgcn_readfirstlane(tid >> 6), lane = tid & 63, wr = wid >> 2, wc = wid & 3, fr = lane & 15, fq = lane >> 4;
  const int lg = g.lgnts, nts = 1 << lg, nt = nts * g.nseg;
  unsigned voffA[2], voffB[2];
#pragma unroll
  for (int i = 0; i < 2; ++i) { int R, C; stage_rc(tid * 16 + i * 8192, R, C); const int Rb = Epi::PERM ? ((R & ~31) + perm32(R & 31)) : R;
    voffA[i] = (unsigned)(R * g.lda + C) * 2u; voffB[i] = (unsigned)(Rb * g.ldb + C) * 2u; }
  const size_t kstep = (size_t)(BK * 2);
  const size_t hstepA = (size_t)HALF * g.lda * 2, hstepB = (size_t)HALF * g.ldb * 2;
  const size_t tstepA = 2 * hstepA, tstepB = 2 * hstepB;
  const unsigned ldsw = (unsigned)wid * 1024u;
  const int aoff = lds_byte(wr * 64 + fr, fq * 8), boff = lds_byte(wc * 32 + fr, fq * 8);
#define PG8_APTR(pm_, t_) ((const char*)((((t_) >> lg) == 0) ? g.A0 : ((((t_) >> lg) == 1) ? g.A1 : g.A2)) + (size_t)(pm_) * tstepA + (size_t)((t_) & (nts - 1)) * kstep)
#define PG8_BPTR(pn_, t_) ((const char*)((((t_) >> lg) == 0) ? g.B0 : ((((t_) >> lg) == 1) ? g.B1 : g.B2)) + (size_t)(pn_) * tstepB + (size_t)((t_) & (nts - 1)) * kstep)
#define PG8_SA(b, h) (((b) * 2 + (h)) * HTB)
#define PG8_SB(b, h) ((4 + (b) * 2 + (h)) * HTB)
#define PG8_STAGE(bufoff, gbase, voff) do { _Pragma("unroll") for (int _i = 0; _i < 2; ++_i) \
    __builtin_amdgcn_global_load_lds((const unsigned*)((const char*)(gbase) + (voff)[_i]), (PG8_LAS unsigned*)(lds + (bufoff) + ldsw + _i * 8192), 16, 0, 0); } while (0)
#define PG8_LDA(dst, b, h) do { _Pragma("unroll") for (int m = 0; m < 4; ++m) _Pragma("unroll") for (int k = 0; k < 2; ++k) dst[m][k] = *(const PG8_LAS bf16x8*)(lds + PG8_SA(b, h) + aoff + m * 2048 + k * 1024); } while (0)
#define PG8_LDB(dst, b, h) do { _Pragma("unroll") for (int n = 0; n < 2; ++n) _Pragma("unroll") for (int k = 0; k < 2; ++k) dst[n][k] = *(const PG8_LAS bf16x8*)(lds + PG8_SB(b, h) + boff + n * 2048 + k * 1024); } while (0)
#define PG8_MMA(ai, bj, At, Bt) do { __builtin_amdgcn_s_setprio(1); _Pragma("unroll") for (int m = 0; m < 4; ++m) _Pragma("unroll") for (int n = 0; n < 2; ++n) _Pragma("unroll") for (int k = 0; k < 2; ++k) \
    acc[ai][bj][m][n] = F16 ? mfma16h(Bt[n][k], At[m][k], acc[ai][bj][m][n]) : __builtin_amdgcn_mfma_f32_16x16x32_bf16(Bt[n][k], At[m][k], acc[ai][bj][m][n], 0, 0, 0); __builtin_amdgcn_s_setprio(0); } while (0)
#define PG8_WAIT_V(n) asm volatile("s_waitcnt vmcnt(" #n ")" ::: "memory")
#define PG8_WAIT_L(n) asm volatile("s_waitcnt lgkmcnt(" #n ")" ::: "memory")
#define PG8_BAR __builtin_amdgcn_s_barrier()
#define PG8_SCHED __builtin_amdgcn_sched_barrier(0)
  Unit cur, nxt; int ui = 0;
  if (!S.next(0, cur)) return;
  f32x4 acc[2][2][4][2];
#pragma unroll
  for (int a = 0; a < 2; ++a)
#pragma unroll
    for (int b = 0; b < 2; ++b)
#pragma unroll
      for (int m = 0; m < 4; ++m)
#pragma unroll
        for (int n = 0; n < 2; ++n) acc[a][b][m][n] = (f32x4){0.f, 0.f, 0.f, 0.f};
  bf16x8 At[4][2], B0[2][2], B1[2][2];
  {
    const char* cA = PG8_APTR(cur.pm, 0); const char* cB = PG8_BPTR(cur.pn, 0);
    PG8_STAGE(PG8_SB(0, 0), cB, voffB); PG8_STAGE(PG8_SA(0, 0), cA, voffA); PG8_STAGE(PG8_SB(0, 1), cB + hstepB, voffB); PG8_STAGE(PG8_SA(0, 1), cA + hstepA, voffA);
    if (wr == 1) PG8_BAR;
    PG8_WAIT_V(4); PG8_BAR;
    PG8_STAGE(PG8_SB(1, 0), cB + kstep, voffB); PG8_STAGE(PG8_SA(1, 0), cA + kstep, voffA); PG8_STAGE(PG8_SB(1, 1), cB + hstepB + kstep, voffB);
    PG8_WAIT_V(6); PG8_BAR;
  }
  for (;;) {
    const bool has_next = S.next(ui + 1, nxt);
    const int npm = has_next ? nxt.pm : cur.pm, npn = has_next ? nxt.pn : cur.pn;
    for (int t = 0; t < nt; t += 2) {
      const bool last = (t == nt - 2);
      const char* a1 = PG8_APTR(cur.pm, t + 1);
      const char* a2 = last ? PG8_APTR(npm, 0) : PG8_APTR(cur.pm, t + 2);
      const char* b2 = last ? PG8_BPTR(npn, 0) : PG8_BPTR(cur.pn, t + 2);
      const char* a3 = a2 + kstep; const char* b3 = b2 + kstep;
      PG8_LDB(B0, 0, 0); PG8_SCHED; PG8_LDA(At, 0, 0); PG8_STAGE(PG8_SA(1, 1), a1 + hstepA, voffA);
      PG8_WAIT_L(8); PG8_BAR; PG8_WAIT_L(0); PG8_MMA(0, 0, At, B0); PG8_BAR; PG8_SCHED;
      PG8_LDB(B1, 0, 1); PG8_STAGE(PG8_SB(0, 0), b2, voffB);
      PG8_BAR; PG8_WAIT_L(0); PG8_MMA(0, 1, At, B1); PG8_BAR;
      PG8_LDA(At, 0, 1); PG8_STAGE(PG8_SA(0, 0), a2, voffA);
      PG8_BAR; PG8_WAIT_L(0); PG8_MMA(1, 0, At, B0); PG8_BAR; PG8_SCHED;
      PG8_STAGE(PG8_SB(0, 1), b2 + hstepB, voffB);
      PG8_WAIT_V(6); PG8_BAR; PG8_MMA(1, 1, At, B1); PG8_BAR;
      PG8_LDB(B0, 1, 0); PG8_SCHED; PG8_LDA(At, 1, 0); PG8_STAGE(PG8_SA(0, 1), a2 + hstepA, voffA);
      PG8_WAIT_L(8); PG8_BAR; PG8_WAIT_L(0); PG8_MMA(0, 0, At, B0); PG8_BAR; PG8_SCHED;
      PG8_LDB(B1, 1, 1); PG8_STAGE(PG8_SB(1, 0), b3, voffB);
      PG8_BAR; PG8_WAIT_L(0); PG8_MMA(0, 1, At, B1); PG8_BAR;
      PG8_LDA(At, 1, 1); PG8_STAGE(PG8_SA(1, 0), a3, voffA);
      PG8_BAR; PG8_WAIT_L(0); PG8_MMA(1, 0, At, B0); PG8_BAR; PG8_SCHED;
      PG8_STAGE(PG8_SB(1, 1), b3 + hstepB, voffB);
      PG8_WAIT_V(6); PG8_BAR; PG8_MMA(1, 1, At, B1); PG8_BAR;
    }
    E(acc, cur, wr, wc, fr, fq);
    if (!has_next) break;
#pragma unroll
    for (int a = 0; a < 2; ++a)
#pragma unroll
      for (int b = 0; b < 2; ++b)
#pragma unroll
        for (int m = 0; m < 4; ++m)
#pragma unroll
          for (int n = 0; n < 2; ++n) acc[a][b][m][n] = (f32x4){0.f, 0.f, 0.f, 0.f};
    cur = nxt; ++ui;
  }
  PG8_WAIT_V(0);
  if (wr == 0) PG8_BAR;
  PG8_BAR;
#undef PG8_APTR
#undef PG8_BPTR
#undef PG8_SA
#undef PG8_SB
#undef PG8_STAGE
#undef PG8_LDA
#undef PG8_LDB
#undef PG8_MMA
#undef PG8_WAIT_V
#undef PG8_WAIT_L
#undef PG8_BAR
#undef PG8_SCHED
}
template <class Epi, bool F16 = false>
__device__ __forceinline__ void run(char* lds, const u16* A0, const u16* A1, const u16* A2, const u16* B0, const u16* B1, const u16* B2,
                                    int lda, int ldb, int lgnts, int nseg, int N, const Epi& E) {
  GemmD g; g.A0 = A0; g.A1 = A1; g.A2 = A2; g.B0 = B0; g.B1 = B1; g.B2 = B2; g.lda = lda; g.ldb = ldb; g.lgnts = lgnts; g.nseg = nseg; g.M = T_; g.N = N;
  StaticOrder S; S.init(T_, N, (int)gridDim.x, (int)blockIdx.x);
  gemm_phase<Epi, F16>((PG8_LAS unsigned char*)lds, g, S, E);
}
}


template <int NE>
__device__ __forceinline__ void topk_row(const float* __restrict__ srow, int qpos, int lane, unsigned* __restrict__ mrow) {
  unsigned uk[NE];
#pragma unroll
  for (int e = 0; e < NE; ++e) {
    const int key = e * 64 + lane;
    const float v = srow[key];
    unsigned uu = __float_as_uint(v);
    uu = (uu & 0x80000000u) ? ~uu : (uu | 0x80000000u);
    uk[e] = (key <= qpos) ? uu : 0u;
  }
  unsigned prefix = 0u;
  for (int bit = 31; bit >= 0; --bit) {
    const unsigned cand = prefix | (1u << bit);
    int cnt = 0;
#pragma unroll
    for (int e = 0; e < NE; ++e) cnt += __popcll(__ballot(uk[e] >= cand));
    if (cnt >= 256) { prefix = cand; if (cnt == 256) break; }
  }
  int cgt = 0;
#pragma unroll
  for (int e = 0; e < NE; ++e) cgt += __popcll(__ballot(uk[e] > prefix));
  const int need = 256 - cgt;
  int eqused = 0;
  const unsigned long long lt = (1ull << lane) - 1ull;
#pragma unroll
  for (int e = 0; e < NE; ++e) {
    const bool gt = uk[e] > prefix, eq = uk[e] == prefix;
    const unsigned long long meq = __ballot(eq);
    const bool take = gt || (eq && (eqused + __popcll(meq & lt)) < need);
    const unsigned long long ms = __ballot(take);
    if (lane == 0) { mrow[2 * e] = (unsigned)ms; mrow[2 * e + 1] = (unsigned)(ms >> 32); }
    eqused += __popcll(meq);
  }
}

__device__ __forceinline__ void dsa_unit_phase(const PAcc& p, char* lds, bool st) {
  u16* qihi = (u16*)lds;
  unsigned* MASK = (unsigned*)lds;
  const u16* VT = (const u16*)(p.pp->ws + DSA_VT);
  float* wis = (float*)(lds + 73728);
  u16* QKVG = (u16*)(p.pp->ws + DSA_QKVG);
  const u16* QIH = (const u16*)(p.pp->ws + DSA_QIHI);
  const u16* KIH = (const u16*)(p.pp->ws + DSA_KIHI);
  const float* WI = (const float*)(p.pp->ws + DSA_WI);
  float* scr = (float*)(p.pp->ws + DSA_SCR) + (size_t)blockIdx.x * 16 * 2048;

  const bool xmap = (gridDim.x == 256);
  for (int u = blockIdx.x; u < 2048; u += gridDim.x) {
    const int tid = tid_(), lane = tid & 63, wave = tid >> 6, fr = lane & 15, fq = lane >> 4;
    int qt, b;
    if (xmap) { const int v = (blockIdx.x >> 3) + 32 * (u >> 8); b = 2 * (blockIdx.x & 7) + (v & 1); qt = 127 - (v >> 1); }
    else { qt = 127 - (u >> 4); b = u & 15; }
    const int q0 = qt * 16;
    const size_t tok0 = (size_t)b * 2048 + q0;
    const bool full = (q0 < 256);
    if (!full) {
#pragma unroll
      for (int i = 0; i < 4; ++i) {
        const int c = tid + i * NTHR;
        const int row = c >> 7, ch = c & 127;
        *(uint4*)(qihi + row * 1032 + ch * 8) = *(const uint4*)(QIH + (tok0 + row) * 1024 + ch * 8);
      }
      if (tid < 128) wis[tid] = WI[tok0 * 8 + tid];
      __syncthreads();
      const int nkeys = q0 + 16;
      const int nch = (nkeys + 31) >> 5;
      for (int rep_ = 0; rep_ < ((DUP == 6) ? 2 : 1); ++rep_)
      for (int c = wave; c < nch; c += 8) {
        const int kbase = c * 32;
        bf16x8 khi[2][4];
#pragma unroll
        for (int mt = 0; mt < 2; ++mt)
#pragma unroll
          for (int ks = 0; ks < 4; ++ks) {
            const size_t o = ((size_t)b * 2048 + kbase + mt * 16 + fr) * 128 + ks * 32 + fq * 8;
            khi[mt][ks] = *(const bf16x8*)(KIH + o);
          }
        f32x4 sc[2];
        sc[0] = (f32x4){0.f, 0.f, 0.f, 0.f}; sc[1] = sc[0];
#pragma unroll 1
        for (int h = 0; h < 8; ++h) {
          const float wv = wis[fr * 8 + h];
          f32x4 lg[2];
          lg[0] = (f32x4){0.f, 0.f, 0.f, 0.f}; lg[1] = lg[0];
#pragma unroll
          for (int ks = 0; ks < 4; ++ks) {
            const bf16x8 bh = *(const bf16x8*)(qihi + fr * 1032 + h * 128 + ks * 32 + fq * 8);
#pragma unroll
            for (int mt = 0; mt < 2; ++mt) {
              lg[mt] = mfma16h(khi[mt][ks], bh, lg[mt]);
            }
          }
#pragma unroll
          for (int mt = 0; mt < 2; ++mt)
#pragma unroll
            for (int r = 0; r < 4; ++r) sc[mt][r] += wv * fmaxf(lg[mt][r], 0.f);
        }
#pragma unroll
        for (int mt = 0; mt < 2; ++mt) *(f32x4*)(scr + fr * 2048 + kbase + mt * 16 + fq * 4) = sc[mt];
      }
    }
    __syncthreads();
    u16* QF = (u16*)(lds + 81920);
#pragma unroll
    for (int i = 0; i < 4; ++i) {
      const int c = tid + i * NTHR;
      const int row = c >> 7, ch = c & 127;
      *(uint4*)(QF + row * 1032 + ch * 8) = *(const uint4*)(QKVG + (tok0 + row) * 2560 + ch * 8);
    }
#pragma unroll 1
    for (int qi2 = 0; qi2 < ((DUP == 7) ? 4 : 2); ++qi2) {
      const int qq = wave * 2 + (qi2 & 1);
      const int qpos = q0 + qq;
      if (!full) {
        const int ng = ((q0 + 15) >> 8) + 1;
        const float* sr = scr + qq * 2048; unsigned* mr = MASK + qq * 64;
        switch (ng) {
          case 2: topk_row<8>(sr, qpos, lane, mr); break;
          case 3: topk_row<12>(sr, qpos, lane, mr); break;
          case 4: topk_row<16>(sr, qpos, lane, mr); break;
          case 5: topk_row<20>(sr, qpos, lane, mr); break;
          case 6: topk_row<24>(sr, qpos, lane, mr); break;
          case 7: topk_row<28>(sr, qpos, lane, mr); break;
          default: topk_row<32>(sr, qpos, lane, mr); break;
        }
      } else {
#pragma unroll
        for (int e = 0; e < 32; ++e) {
          const unsigned long long ms = __ballot((e * 64 + lane) <= qpos);
          if (lane == 0) { MASK[qq * 64 + 2 * e] = (unsigned)ms; MASK[qq * 64 + 2 * e + 1] = (unsigned)(ms >> 32); }
        }
      }
    }
    __syncthreads();
    {
      int fr_a = fr, fq_a = fq, lane_a = lane;
      asm volatile("" : "+v"(fr_a), "+v"(fq_a), "+v"(lane_a));
#define fr fr_a
#define fq fq_a
#define lane lane_a
      const int g = wave >> 1, half = wave & 1;
      float mq = fabsf(p.pp->in[6][lane]), mk = fabsf(p.pp->in[7][lane]);
#pragma unroll
      for (int mm = 32; mm >= 1; mm >>= 1) { mq = fmaxf(mq, __shfl_xor(mq, mm)); mk = fmaxf(mk, __shfl_xor(mk, mm)); }
      const float shift = 8.f * mq * mk; const float nshift2 = -shift * 1.44269504089f;
      const u16* qfp = QF + fr * 1032 + g * 256 + fq * 8;
      f32x4 o[4][4];
#pragma unroll
      for (int rr = 0; rr < 4; ++rr)
#pragma unroll
        for (int mt = 0; mt < 4; ++mt) o[rr][mt] = (f32x4){0.f, 0.f, 0.f, 0.f};
      float lsum[4] = {0.f, 0.f, 0.f, 0.f};
      const u16* Kb = QKVG + (size_t)b * 2048 * 2560 + 1024 + g * 64 + fq * 8 + (size_t)(8 * (fr >> 2) + (fr & 3)) * 2560;
      const u16* Vb = VT + (size_t)(b * 256 + g * 64 + fr) * 2048 + 8 * fq;
      const int nb = (q0 + 16 + 31) >> 5;
      bf16x8 kf[2][2], vf[4];
      {
        const int k0 = (half < nb ? half : 0) * 32;
#pragma unroll
        for (int s2 = 0; s2 < 2; ++s2)
#pragma unroll
          for (int ks = 0; ks < 2; ++ks) kf[s2][ks] = *(const bf16x8*)(Kb + (size_t)(k0 + 4 * s2) * 2560 + ks * 32);
#pragma unroll
        for (int mt = 0; mt < 4; ++mt) vf[mt] = *(const bf16x8*)(Vb + (size_t)mt * 16 * 2048 + k0);
      }
#pragma unroll 1
      for (int blk = half; blk < nb; blk += 2) {
        bf16x8 kn[2][2], vn[4];
        const int nx = (blk + 2 < nb) ? (blk + 2) * 32 : blk * 32;
#pragma unroll
        for (int s2 = 0; s2 < 2; ++s2)
#pragma unroll
          for (int ks = 0; ks < 2; ++ks) kn[s2][ks] = *(const bf16x8*)(Kb + (size_t)(nx + 4 * s2) * 2560 + ks * 32);
#pragma unroll
        for (int mt = 0; mt < 4; ++mt) vn[mt] = *(const bf16x8*)(Vb + (size_t)mt * 16 * 2048 + nx);
        const unsigned mw = MASK[fr * 64 + blk] >> (8 * fq);
        f32x4 mf[2];
#pragma unroll
        for (int s2 = 0; s2 < 2; ++s2)
#pragma unroll
          for (int r = 0; r < 4; ++r) mf[s2][r] = (float)((mw >> (4 * s2 + r)) & 1u);
#pragma unroll
        for (int rr = 0; rr < 4; ++rr) {
          float pv[8];
          f32x4 pq[2];
#pragma unroll
          for (int s2 = 0; s2 < 2; ++s2) {
            f32x4 stv = (f32x4){0.f, 0.f, 0.f, 0.f};
            stv = mfma16(kf[s2][0], *(const bf16x8*)(qfp + rr * 64), stv);
            stv = mfma16(kf[s2][1], *(const bf16x8*)(qfp + rr * 64 + 32), stv);
            stv = stv * (0.125f * 1.44269504089f) + nshift2;
#pragma unroll
            for (int r = 0; r < 4; ++r) stv[r] = __builtin_amdgcn_exp2f(stv[r]);
            pq[s2] = stv * mf[s2];
          }
          {
            const f32x4 sm_ = pq[0] + pq[1];
            lsum[rr] += (sm_[0] + sm_[1]) + (sm_[2] + sm_[3]);
          }
#pragma unroll
          for (int r = 0; r < 4; ++r) { pv[r] = pq[0][r]; pv[4 + r] = pq[1][r]; }
          union { bf16x8 v; unsigned w[4]; } pk;
          pk.w[0] = pg8::cvt_pk_bf16(pv[0], pv[1]); pk.w[1] = pg8::cvt_pk_bf16(pv[2], pv[3]);
          pk.w[2] = pg8::cvt_pk_bf16(pv[4], pv[5]); pk.w[3] = pg8::cvt_pk_bf16(pv[6], pv[7]);
#pragma unroll
          for (int mt = 0; mt < 4; ++mt) o[rr][mt] = mfma16(vf[mt], pk.v, o[rr][mt]);
        }
#pragma unroll
        for (int s2 = 0; s2 < 2; ++s2)
#pragma unroll
          for (int ks = 0; ks < 2; ++ks) kf[s2][ks] = kn[s2][ks];
#pragma unroll
        for (int mt = 0; mt < 4; ++mt) vf[mt] = vn[mt];
      }
      float* CB = (float*)(lds + 8192) + (size_t)g * 68 * 64 + lane;
      if (half == 1) {
#pragma unroll
        for (int rr = 0; rr < 4; ++rr) {
#pragma unroll
          for (int mt = 0; mt < 4; ++mt)
#pragma unroll
            for (int r = 0; r < 4; ++r) CB[((rr * 4 + mt) * 4 + r) * 64] = o[rr][mt][r];
          CB[(64 + rr) * 64] = lsum[rr];
        }
      }
      __syncthreads();
      if (half == 0) {
#pragma unroll
        for (int rr = 0; rr < 4; ++rr) {
          float l = lsum[rr] + CB[(64 + rr) * 64];
          l += __shfl_xor(l, 16); l += __shfl_xor(l, 32);
          const float inv = 1.f / l;
          const int h = g * 4 + rr;
#pragma unroll
          for (int mt = 0; mt < 4; ++mt) {
            u16* op = QKVG + (tok0 + fr) * 2560 + h * 64 + mt * 16 + fq * 4;
            const uint2 gg = *(const uint2*)(op + 1536);
            const float v0 = o[rr][mt][0] + CB[((rr * 4 + mt) * 4 + 0) * 64], v1 = o[rr][mt][1] + CB[((rr * 4 + mt) * 4 + 1) * 64];
            const float v2 = o[rr][mt][2] + CB[((rr * 4 + mt) * 4 + 2) * 64], v3 = o[rr][mt][3] + CB[((rr * 4 + mt) * 4 + 3) * 64];
            uint2 w;
            w.x = pg8::cvt_pk_bf16(v0 * inv * silu_(bflo(gg.x)), v1 * inv * silu_(bfhi(gg.x)));
            w.y = pg8::cvt_pk_bf16(v2 * inv * silu_(bflo(gg.y)), v3 * inv * silu_(bfhi(gg.y)));
            if (st) *(uint2*)op = w;
          }
        }
      }
#undef fr
#undef fq
#undef lane
    }
    __syncthreads();
  }
}

__device__ __forceinline__ void lru_gate_phase(const PAcc& p, char* lds) {
  const int tid = tid_(), lane = tid & 63, wave = tid >> 6;
  const int wr = wave >> 1, wc = wave & 1, fr = lane & 15, fq = lane >> 4;
  float* UC = (float*)lds;
  u16* Al = (u16*)(lds + 256 * 65 * 4);
  u16* Bl = Al + 256 * 72;
  const u16* UG = (const u16*)(p.pp->ws + LRU_UG);
  const u16* WG = (const u16*)(p.pp->ws + WS_WT) + W_LRU_GATE;
  float* LA = (float*)(p.pp->ws + LRU_A);
  float* LB = (float*)(p.pp->ws + LRU_B);
  for (int unit = blockIdx.x; unit < 2048; unit += gridDim.x) {
    const int n = unit & 15, mt = unit >> 4;
    const int m0 = mt * 256;
    {
      const int c = tid & 63, rg = tid >> 6;
      const int ch = n * 64 + c;
      const float w0 = p.pp->in[10][ch], w1 = p.pp->in[10][1024 + ch], w2 = p.pp->in[10][2048 + ch], w3 = p.pp->in[10][3072 + ch];
      const float cb = p.pp->in[11][ch];
      const int r0 = rg * 32;
      const int g0 = m0 + r0;
      float u3 = ((g0 & 2047) >= 3) ? bf2f(UG[(size_t)(g0 - 3) * 2048 + ch]) : 0.f;
      float u2 = ((g0 & 2047) >= 2) ? bf2f(UG[(size_t)(g0 - 2) * 2048 + ch]) : 0.f;
      float u1 = ((g0 & 2047) >= 1) ? bf2f(UG[(size_t)(g0 - 1) * 2048 + ch]) : 0.f;
#pragma unroll 8
      for (int r = 0; r < 32; ++r) {
        const float u0 = bf2f(UG[(size_t)(g0 + r) * 2048 + ch]);
        const float v = w0 * u3 + w1 * u2 + w2 * u1 + w3 * u0 + cb;
        UC[(r0 + r) * 65 + c] = v;
        Al[(r0 + r) * 72 + c] = f2bf(v);
        u3 = u2; u2 = u1; u1 = u0;
      }
#pragma unroll
      for (int i = 0; i < 2; ++i) {
        const int cidx = tid + i * NTHR;
        const int row = cidx >> 3, kc = (cidx & 7) * 8;
        *(uint4*)(Bl + row * 72 + kc) = *(const uint4*)(WG + (size_t)n * 8192 + row * 64 + kc);
      }
    }
    __syncthreads();
    f32x4 acc[4][4];
#pragma unroll
    for (int i = 0; i < 4; ++i)
#pragma unroll
      for (int j = 0; j < 4; ++j) acc[i][j] = (f32x4){0.f, 0.f, 0.f, 0.f};
#pragma unroll
    for (int ks = 0; ks < 2; ++ks) {
      bf16x8 af[4], bfr[4];
#pragma unroll
      for (int i = 0; i < 4; ++i) af[i] = *(const bf16x8*)(Al + (wr * 64 + i * 16 + fr) * 72 + ks * 32 + fq * 8);
#pragma unroll
      for (int j = 0; j < 4; ++j) bfr[j] = *(const bf16x8*)(Bl + (wc * 64 + j * 16 + fr) * 72 + ks * 32 + fq * 8);
#pragma unroll
      for (int i = 0; i < 4; ++i)
#pragma unroll
        for (int j = 0; j < 4; ++j) acc[i][j] = mfma16(af[i], bfr[j], acc[i][j]);
    }
#pragma unroll
    for (int jj = 0; jj < 2; ++jj) {
      const int d = wc * 32 + jj * 16 + fr;
      const int ch = n * 64 + d;
      const float ba = p.pp->in[13][ch], bx = p.pp->in[15][ch];
      const float spl = softplus_(-p.pp->in[16][ch]);
#pragma unroll
      for (int i = 0; i < 4; ++i)
#pragma unroll
        for (int r = 0; r < 4; ++r) {
          const int row = wr * 64 + i * 16 + fq * 4 + r;
          const float rr = sigmoid_(acc[i][jj * 2][r] + ba);
          const float ig = sigmoid_(acc[i][jj * 2 + 1][r] + bx);
          const float log_a = -8.f * rr * spl;
          const float a = __expf(log_a);
          const float bb = sqrtf(fmaxf(-expm1f(2.f * log_a), 0.f)) * (ig * UC[row * 65 + d]);
          const size_t o = (size_t)(m0 + row) * 1024 + ch;
          LA[o] = a; LB[o] = bb;
        }
    }
    __syncthreads();
  }
}


__device__ __forceinline__ void lru_fused_phase(const PAcc& p, char* lds) {
  const int tid = tid_(), lane = tid & 63, wave = tid >> 6;
  const int wr = wave >> 1, wc = wave & 1, fr = lane & 15, fq = lane >> 4;
  float* UB = (float*)lds;
  float* AA = UB + 128 * 65;
  u16* Al = (u16*)(AA + 128 * 65);
  u16* Bl = Al + 128 * 72;
  float* sA = (float*)(Bl + 128 * 72);
  float* sB = sA + 512;
  float* Hc = sB + 512;
  const u16* UG = (const u16*)(p.pp->ws + LRU_UG);
  const u16* WG = (const u16*)(p.pp->ws + WS_WT) + W_LRU_GATE;
  u16* OG = (u16*)(p.pp->ws + WS_H);
  const int c = tid & 63, rg = tid >> 6;
  for (int unit = blockIdx.x; unit < 256; unit += gridDim.x) {
    const int b = unit >> 4, n = unit & 15;
    const int ch = n * 64 + c;
    const float w0 = p.pp->in[10][ch], w1 = p.pp->in[10][1024 + ch], w2 = p.pp->in[10][2048 + ch], w3 = p.pp->in[10][3072 + ch];
    const float cb = p.pp->in[11][ch];
#pragma unroll
    for (int i = 0; i < 2; ++i) {
      const int cidx = tid + i * NTHR;
      const int row = cidx >> 3, kc = (cidx & 7) * 8;
      *(uint4*)(Bl + row * 72 + kc) = *(const uint4*)(WG + (size_t)n * 8192 + row * 64 + kc);
    }
    if (tid < 64) Hc[tid] = 0.f;
    float ba[2], bx[2], spl[2];
#pragma unroll
    for (int jj = 0; jj < 2; ++jj) {
      const int dch = n * 64 + wc * 32 + jj * 16 + fr;
      ba[jj] = p.pp->in[13][dch]; bx[jj] = p.pp->in[15][dch]; spl[jj] = softplus_(-p.pp->in[16][dch]);
    }
    u16 un[19], gn[16];
#define LRU_LOAD(mt_)                                                                      \
    { const size_t g0_ = (size_t)b * 2048 + (mt_) * 128 + rg * 16;                         \
      const int pos0_ = (mt_) * 128 + rg * 16;                                             \
      _Pragma("unroll") for (int r = 0; r < 3; ++r) un[r] = (pos0_ >= 3 - r) ? UG[(g0_ - 3 + r) * 2048 + ch] : (u16)0; \
      _Pragma("unroll") for (int r = 0; r < 16; ++r) { un[3 + r] = UG[(g0_ + r) * 2048 + ch]; gn[r] = UG[(g0_ + r) * 2048 + 1024 + ch]; } }
    LRU_LOAD(0);
#pragma unroll 1
    for (int mt = 0; mt < 16; ++mt) {
      const size_t m0 = (size_t)b * 2048 + mt * 128;
      const size_t g0 = m0 + rg * 16;
      u16 gg[16];
#pragma unroll
      for (int r = 0; r < 16; ++r) gg[r] = gn[r];
      {
        float u3 = bf2f(un[0]), u2 = bf2f(un[1]), u1 = bf2f(un[2]);
#pragma unroll
        for (int r = 0; r < 16; ++r) {
          const float u0 = bf2f(un[3 + r]);
          const float v = w0 * u3 + w1 * u2 + w2 * u1 + w3 * u0 + cb;
          UB[(rg * 16 + r) * 65 + c] = v;
          Al[(rg * 16 + r) * 72 + c] = f2bf(v);
          u3 = u2; u2 = u1; u1 = u0;
        }
      }
      if (mt + 1 < 16) LRU_LOAD(mt + 1);
      __syncthreads();
      f32x4 acc[2][4];
#pragma unroll
      for (int i = 0; i < 2; ++i)
#pragma unroll
        for (int j = 0; j < 4; ++j) acc[i][j] = (f32x4){0.f, 0.f, 0.f, 0.f};
#pragma unroll
      for (int ks = 0; ks < 2; ++ks) {
        bf16x8 af[2], bfr[4];
#pragma unroll
        for (int i = 0; i < 2; ++i) af[i] = *(const bf16x8*)(Al + (wr * 32 + i * 16 + fr) * 72 + ks * 32 + fq * 8);
#pragma unroll
        for (int j = 0; j < 4; ++j) bfr[j] = *(const bf16x8*)(Bl + (wc * 64 + j * 16 + fr) * 72 + ks * 32 + fq * 8);
#pragma unroll
        for (int i = 0; i < 2; ++i)
#pragma unroll
          for (int j = 0; j < 4; ++j) acc[i][j] = mfma16(af[i], bfr[j], acc[i][j]);
      }
#pragma unroll
      for (int jj = 0; jj < 2; ++jj) {
        const int d = wc * 32 + jj * 16 + fr;
#pragma unroll
        for (int i = 0; i < 2; ++i)
#pragma unroll
          for (int r = 0; r < 4; ++r) {
            const int row = wr * 32 + i * 16 + fq * 4 + r;
            const float rr = sigmoid_(acc[i][jj * 2][r] + ba[jj]);
            const float ig = sigmoid_(acc[i][jj * 2 + 1][r] + bx[jj]);
            const float log_a = -8.f * rr * spl[jj];
            const float av = __expf(log_a);
            AA[row * 65 + d] = av;
            UB[row * 65 + d] = sqrtf(fmaxf((1.f - av) * (1.f + av), 0.f)) * (ig * UB[row * 65 + d]);
          }
      }
      __syncthreads();
      {
        float Aa = 1.f, Bb = 0.f;
#pragma unroll
        for (int r = 0; r < 16; ++r) {
          const float a = AA[(rg * 16 + r) * 65 + c], bb = UB[(rg * 16 + r) * 65 + c];
          Bb = a * Bb + bb; Aa *= a;
        }
        sA[rg * 64 + c] = Aa; sB[rg * 64 + c] = Bb;
        __syncthreads();
        float h = Hc[c];
        for (int v = 0; v < rg; ++v) h = sA[v * 64 + c] * h + sB[v * 64 + c];
#pragma unroll
        for (int r = 0; r < 16; ++r) {
          const float a = AA[(rg * 16 + r) * 65 + c], bb = UB[(rg * 16 + r) * 65 + c];
          h = a * h + bb;
          OG[(g0 + r) * 1024 + ch] = f2bf(h * silu_(bf2f(gg[r])));
        }
        __syncthreads();
        if (rg == 7) Hc[c] = h;
      }
    }
    __syncthreads();
  }
}

#undef LRU_LOAD
__device__ __forceinline__ void lru_scan_phase(const PAcc& p, char* lds) {
  const int tid = tid_(), c = tid & 63, tc = tid >> 6;
  float* sA = (float*)lds;
  float* sB = sA + 512;
  const float* LA = (const float*)(p.pp->ws + LRU_A);
  const float* LB = (const float*)(p.pp->ws + LRU_B);
  const u16* UG = (const u16*)(p.pp->ws + LRU_UG);
  u16* OG = (u16*)(p.pp->ws + WS_H);
  for (int item = blockIdx.x; item < 256; item += gridDim.x) {
    const int b = item >> 4, ch = (item & 15) * 64 + c;
    const size_t row0 = (size_t)b * 2048 + tc * 256;
    float Aa = 1.f, Bb = 0.f;
#pragma unroll 8
    for (int t = 0; t < 256; ++t) {
      const float a = LA[(row0 + t) * 1024 + ch], bb = LB[(row0 + t) * 1024 + ch];
      Bb = a * Bb + bb; Aa *= a;
    }
    sA[tc * 64 + c] = Aa; sB[tc * 64 + c] = Bb;
    __syncthreads();
    float h = 0.f;
    for (int v = 0; v < tc; ++v) h = sA[v * 64 + c] * h + sB[v * 64 + c];
#pragma unroll 8
    for (int t = 0; t < 256; ++t) {
      const float a = LA[(row0 + t) * 1024 + ch], bb = LB[(row0 + t) * 1024 + ch];
      h = a * h + bb;
      const float g = bf2f(UG[(row0 + t) * 2048 + 1024 + ch]);
      OG[(row0 + t) * 1024 + ch] = f2bf(h * silu_(g));
    }
    __syncthreads();
  }
}

__device__ __forceinline__ void rwkv_rec_phase(const PAcc& p, char* lds, bool st) {
  const int tid = tid_(), lane = tid & 63, wave = tid >> 6;
  float* Wd = (float*)lds;
  float* NKK = Wd + 1024;
  float* KKA = NKK + 1024;
  float* KM = KKA + 1024;
  float* Rr = KM + 1024;
  float* Vv = Rr + 1024;
  float* Yy = Vv + 1024;
  float* RKs = Yy + 1024;
  u16* RKVG = (u16*)(p.pp->ws + RW_RKVG);
  const float* EW = (const float*)(p.pp->ws + RW_EW);
  const u16* AB = (const u16*)(p.pp->ws + RW_A);
  const int tl = tid >> 5, jp = tid & 31;
  const int il = lane >> 3, js = lane & 7;
  for (int item = blockIdx.x; item < 256; item += gridDim.x) {
    const int b = item >> 4, h = item & 15;
    const int hc = h * 64 + 2 * jp;
    const float kk0 = p.pp->in[26][hc], kk1 = p.pp->in[26][hc + 1];
    const float ka0 = p.pp->in[27][hc], ka1 = p.pp->in[27][hc + 1];
    const float rk0 = p.pp->in[28][hc], rk1 = p.pp->in[28][hc + 1];
    const float lw0 = p.pp->in[29][hc], lw1 = p.pp->in[29][hc + 1];
    const float lb0 = p.pp->in[30][hc], lb1 = p.pp->in[30][hc + 1];
    f32x4 SA = (f32x4){0.f, 0.f, 0.f, 0.f}, SB = SA;
    const int irow = wave * 8 + il;
    unsigned r2, k2, v2, a2, g2n, g2; float2 e2;
    {
      const size_t row = (size_t)b * 2048 + tl;
      r2 = *(const unsigned*)(RKVG + row * 4096 + hc);
      k2 = *(const unsigned*)(RKVG + row * 4096 + 1024 + hc);
      v2 = *(const unsigned*)(RKVG + row * 4096 + 2048 + hc);
      g2n = *(const unsigned*)(RKVG + row * 4096 + 3072 + hc);
      a2 = *(const unsigned*)(AB + row * 1024 + hc);
      e2 = *(const float2*)(EW + row * 1024 + hc);
    }
    for (int t0 = 0; t0 < 2048; t0 += 16) {
      g2 = g2n;
      {
        const float r0 = bflo(r2), r1 = bfhi(r2), k0 = bflo(k2), k1 = bfhi(k2), v0 = bflo(v2), v1 = bfhi(v2);
        const float a0 = bflo(a2), a1 = bfhi(a2);
        float q0 = k0 * kk0, q1 = k1 * kk1;
        float ss = q0 * q0 + q1 * q1;
        ss = red32(ss);
        const float inv = rsqrtf(fmaxf(ss, 1e-24f));
        q0 *= inv; q1 *= inv;
        const float km0 = k0 * (1.f + (a0 - 1.f) * ka0), km1 = k1 * (1.f + (a1 - 1.f) * ka1);
        float bon = r0 * km0 * rk0 + r1 * km1 * rk1;
        bon = red32(bon);
        const int o = tl * 64 + 2 * jp;
        *(float2*)(Wd + o) = make_float2(__expf(-e2.x), __expf(-e2.y));
        *(float2*)(NKK + o) = make_float2(-q0, -q1);
        *(float2*)(KKA + o) = make_float2(q0 * a0, q1 * a1);
        *(float2*)(KM + o) = make_float2(km0, km1);
        *(float2*)(Rr + o) = make_float2(r0, r1);
        *(float2*)(Vv + o) = make_float2(v0, v1);
        if (jp == 0) RKs[tl] = bon;
      }
      __syncthreads();
      if (t0 + 16 < 2048) {
        const size_t row = (size_t)b * 2048 + t0 + 16 + tl;
        r2 = *(const unsigned*)(RKVG + row * 4096 + hc);
        k2 = *(const unsigned*)(RKVG + row * 4096 + 1024 + hc);
        v2 = *(const unsigned*)(RKVG + row * 4096 + 2048 + hc);
        g2n = *(const unsigned*)(RKVG + row * 4096 + 3072 + hc);
        a2 = *(const unsigned*)(AB + row * 1024 + hc);
        e2 = *(const float2*)(EW + row * 1024 + hc);
      }
#define RW_RD(W, N, C, M, R, V, t_)                                                        \
      { const int o_ = (t_) * 64 + js * 8;                                                   \
        W[0] = *(const f32x4*)(Wd + o_); W[1] = *(const f32x4*)(Wd + o_ + 4);                \
        N[0] = *(const f32x4*)(NKK + o_); N[1] = *(const f32x4*)(NKK + o_ + 4);              \
        C[0] = *(const f32x4*)(KKA + o_); C[1] = *(const f32x4*)(KKA + o_ + 4);              \
        M[0] = *(const f32x4*)(KM + o_); M[1] = *(const f32x4*)(KM + o_ + 4);                \
        R[0] = *(const f32x4*)(Rr + o_); R[1] = *(const f32x4*)(Rr + o_ + 4);                \
        V = Vv[(t_) * 64 + irow]; }
#define RW_CP(W, N, C, M, R, V, yout)                                                      \
      { const f32x4 p0_ = SA * N[0], p1_ = SB * N[1];                                        \
        float sa_ = ((p0_[0] + p0_[1]) + (p0_[2] + p0_[3])) + ((p1_[0] + p1_[1]) + (p1_[2] + p1_[3])); \
        sa_ = red8(sa_);                                                                     \
        SA = SA * W[0] + (C[0] * sa_ + M[0] * V);                                            \
        SB = SB * W[1] + (C[1] * sa_ + M[1] * V);                                            \
        const f32x4 y0_ = SA * R[0], y1_ = SB * R[1];                                        \
        float y_ = ((y0_[0] + y0_[1]) + (y0_[2] + y0_[3])) + ((y1_[0] + y1_[1]) + (y1_[2] + y1_[3])); \
        yout = red8(y_); }
      {
        f32x4 aW[2], aN[2], aC[2], aM[2], aR[2], bW[2], bN[2], bC[2], bM[2], bR[2];
        float aV, bV;
        RW_RD(aW, aN, aC, aM, aR, aV, 0);
        RW_RD(bW, bN, bC, bM, bR, bV, 1);
#pragma unroll
        for (int t = 0; t < 16; t += 2) {
          float ya, yb;
          RW_CP(aW, aN, aC, aM, aR, aV, ya);
          if (t + 2 < 16) RW_RD(aW, aN, aC, aM, aR, aV, t + 2);
          RW_CP(bW, bN, bC, bM, bR, bV, yb);
          if (t + 3 < 16) RW_RD(bW, bN, bC, bM, bR, bV, t + 3);
          if (js == 0) { Yy[t * 64 + irow] = ya; Yy[(t + 1) * 64 + irow] = yb; }
        }
      }
#undef RW_RD
#undef RW_CP
      __syncthreads();
      {
        const int o = tl * 64 + 2 * jp;
        const float2 y = *(const float2*)(Yy + o);
        float sm = y.x + y.y;
        sm = red32(sm);
        const float mean = sm * (1.f / 64.f);
        const float d0 = y.x - mean, d1 = y.y - mean;
        float vs = d0 * d0 + d1 * d1;
        vs = red32(vs);
        const float rstd = rsqrtf(vs * (1.f / 64.f) + 64e-5f);
        const float2 vv = *(const float2*)(Vv + o);
        const float bon = RKs[tl];
        const size_t row = (size_t)b * 2048 + t0 + tl;
        const float o0 = (d0 * rstd * lw0 + lb0 + bon * vv.x) * silu_(bflo(g2));
        const float o1 = (d1 * rstd * lw1 + lb1 + bon * vv.y) * silu_(bfhi(g2));
        if (st) *(unsigned*)(RKVG + row * 4096 + hc) = pack2(o0, o1);
      }
      __syncthreads();
    }
  }
}

__device__ __forceinline__ f32x4 wave_mma(const u16* A, int lda, const u16* B, int ldb, int K, f32x4 acc, int fr, int fq) {
  for (int k = 0; k < K; k += 32) {
    const bf16x8 a = *(const bf16x8*)(A + fr * lda + k + fq * 8);
    const bf16x8 b = *(const bf16x8*)(B + fr * ldb + k + fq * 8);
    acc = mfma16(a, b, acc);
  }
  return acc;
}

__device__ __forceinline__ void gla_pre_phase(const PAcc& p, char* lds) {
  const int tid = tid_(), lane = tid & 63, wave = tid >> 6, fr = lane & 15, fq = lane >> 4;
  float* AL = (float*)lds;
  float* TOT = AL + 1024;
  u16* QD = (u16*)(TOT + 512);
  u16* KI = QD + 64 * 136;
  const u16* P = (const u16*)(p.pp->ws + GL_P);
  u16* QDg = (u16*)(p.pp->ws + GL_QD);
  u16* KETg = (u16*)(p.pp->ws + GL_KET);
  u16* ATTg = (u16*)((char*)p.pp->out + GL_ATT_OUT);
  u16* VTg = (u16*)(p.pp->ws + GL_VT);
  float* LASTg = (float*)((char*)p.pp->out + GL_LAST_OUT);
  const int d = tid & 127, tg = tid >> 7;
  for (int item = blockIdx.x; item < 2048; item += gridDim.x) {
    const int h = item & 3, bn = item >> 2;
    const size_t row0 = (size_t)bn * 64;
    float w2c[16];
#pragma unroll
    for (int r = 0; r < 16; ++r) w2c[r] = p.pp->in[33][r * 512 + h * 128 + d];
    const float ab = p.pp->in[34][h * 128 + d];
    for (int i = tid; i < 1024; i += NTHR) AL[i] = bf2f(P[(row0 + (i >> 4)) * 3088 + 3072 + (i & 15)]);
    {
      const int e = tid & 255, th = tid >> 8;
      u16 vv[32];
#pragma unroll
      for (int t = 0; t < 32; ++t) vv[t] = P[(row0 + th * 32 + t) * 3088 + 1024 + h * 256 + e];
      u16* dst = VTg + ((size_t)item * 256 + e) * 64 + th * 32;
#pragma unroll
      for (int q4 = 0; q4 < 4; ++q4) {
        uint4 s0;
        s0.x = vv[q4 * 8 + 0] | ((unsigned)vv[q4 * 8 + 1] << 16); s0.y = vv[q4 * 8 + 2] | ((unsigned)vv[q4 * 8 + 3] << 16);
        s0.z = vv[q4 * 8 + 4] | ((unsigned)vv[q4 * 8 + 5] << 16); s0.w = vv[q4 * 8 + 6] | ((unsigned)vv[q4 * 8 + 7] << 16);
        *(uint4*)(dst + q4 * 8) = s0;
      }
    }
    __syncthreads();
    float cum[16];
    {
      float run = 0.f;
#pragma unroll
      for (int t = 0; t < 16; ++t) {
        const float4* al = (const float4*)(AL + (tg * 16 + t) * 16);
        const float4 x0 = al[0], x1 = al[1], x2 = al[2], x3 = al[3];
        float z = ab + x0.x * w2c[0] + x0.y * w2c[1] + x0.z * w2c[2] + x0.w * w2c[3] + x1.x * w2c[4] + x1.y * w2c[5] + x1.z * w2c[6] + x1.w * w2c[7]
                + x2.x * w2c[8] + x2.y * w2c[9] + x2.z * w2c[10] + x2.w * w2c[11] + x3.x * w2c[12] + x3.y * w2c[13] + x3.z * w2c[14] + x3.w * w2c[15];
        run += -((-z > 20.f) ? -z : __logf(1.f + __expf(-z))) * (1.f / 16.f);
        cum[t] = run;
      }
      TOT[tg * 128 + d] = run;
    }
    __syncthreads();
    {
      float off = 0.f, last = 0.f;
#pragma unroll
      for (int g = 0; g < 4; ++g) { const float tv = TOT[g * 128 + d]; if (g < tg) off += tv; last += tv; }
      if (tg == 0) LASTg[(size_t)item * 128 + d] = last;
      const float elast = __expf(last);
      u16 ke[16];
#pragma unroll
      for (int t = 0; t < 16; ++t) {
        const float c = cum[t] + off;
        const int tok = tg * 16 + t;
        const float q = bf2f(P[(row0 + tok) * 3088 + h * 128 + d]);
        const float k = bf2f(P[(row0 + tok) * 3088 + 512 + h * 128 + d]);
        const float ec = __expf(c), einv = 1.f / ec;
        const u16 qd = f2bf(q * 0.08838834764831845f * ec);
        QD[tok * 136 + d] = qd;
        QDg[(row0 + tok) * 512 + h * 128 + d] = qd;
        KI[tok * 136 + d] = f2bf(k * einv);
        ke[t] = f2bf(k * elast * einv);
      }
      uint4 s0, s1;
      s0.x = ke[0] | ((unsigned)ke[1] << 16); s0.y = ke[2] | ((unsigned)ke[3] << 16); s0.z = ke[4] | ((unsigned)ke[5] << 16); s0.w = ke[6] | ((unsigned)ke[7] << 16);
      s1.x = ke[8] | ((unsigned)ke[9] << 16); s1.y = ke[10] | ((unsigned)ke[11] << 16); s1.z = ke[12] | ((unsigned)ke[13] << 16); s1.w = ke[14] | ((unsigned)ke[15] << 16);
      u16* kd = KETg + ((size_t)item * 128 + d) * 64 + tg * 16;
      *(uint4*)kd = s0;
      *(uint4*)(kd + 8) = s1;
    }
    __syncthreads();
    {
      const int ti = wave >> 1;
#pragma unroll
      for (int x = 0; x < 2; ++x) {
        const int tj = (wave & 1) * 2 + x;
        f32x4 a = (f32x4){0.f, 0.f, 0.f, 0.f};
        if (tj <= ti) a = wave_mma(QD + ti * 16 * 136, 136, KI + tj * 16 * 136, 136, 128, a, fr, fq);
#pragma unroll
        for (int r = 0; r < 4; ++r) {
          const int i = ti * 16 + fq * 4 + r, j = tj * 16 + fr;
          ATTg[(size_t)item * 4096 + i * 64 + j] = f2bf((j <= i) ? a[r] : 0.f);
        }
      }
    }
    __syncthreads();
  }
}

__device__ __forceinline__ void gla_phase(const PAcc& p, char* lds) {
  const int tid = tid_(), lane = tid & 63, wave = tid >> 6, fr = lane & 15, fq = lane >> 4;
  float* LAST = (float*)lds;
  u16* QD = (u16*)(LAST + 128);
  u16* KET = QD + 64 * 136;
  u16* VT = KET + 128 * 72;
  u16* ATT = VT + 64 * 72;
  u16* ST = ATT + 64 * 72;
  const u16* QDg = (const u16*)(p.pp->ws + GL_QD);
  const u16* KETg = (const u16*)(p.pp->ws + GL_KET);
  const u16* ATTg = (const u16*)((const char*)p.pp->out + GL_ATT_OUT);
  const u16* VTg = (const u16*)(p.pp->ws + GL_VT);
  const float* LASTg = (const float*)((const char*)p.pp->out + GL_LAST_OUT);
  u16* O = (u16*)(p.pp->ws + GL_O);
  for (int item = blockIdx.x; item < 256; item += gridDim.x) {
    const int b = item >> 4, h = (item >> 2) & 3, es = item & 3;
    f32x4 sacc[4];
#pragma unroll
    for (int i = 0; i < 4; ++i) sacc[i] = (f32x4){0.f, 0.f, 0.f, 0.f};
    for (int i = tid; i < 64 * 136 / 2; i += NTHR) ((unsigned*)ST)[i] = 0u;
    uint4 rA, rQ0, rQ1, rK0, rK1, rV; float rL = 0.f;
#define GLA_LOAD(n_)                                                                                            \
    {                                                                                                           \
      const size_t it_ = ((size_t)(b * 32 + (n_))) * 4 + h;                                                     \
      rA = *(const uint4*)(ATTg + it_ * 4096 + tid * 8);                                                        \
      { const int c0_ = tid, c1_ = tid + NTHR;                                                                  \
        rQ0 = *(const uint4*)(QDg + ((size_t)(b * 32 + (n_)) * 64 + (c0_ >> 4)) * 512 + h * 128 + (c0_ & 15) * 8); \
        rQ1 = *(const uint4*)(QDg + ((size_t)(b * 32 + (n_)) * 64 + (c1_ >> 4)) * 512 + h * 128 + (c1_ & 15) * 8); \
        rK0 = *(const uint4*)(KETg + it_ * 8192 + c0_ * 8);                                                     \
        rK1 = *(const uint4*)(KETg + it_ * 8192 + c1_ * 8); }                                                   \
      rV = *(const uint4*)(VTg + (it_ * 256 + es * 64) * 64 + tid * 8);                                         \
      if (tid < 128) rL = LASTg[it_ * 128 + tid];                                                               \
    }
    GLA_LOAD(0);
    for (int n = 0; n < 32; ++n) {
      const size_t row0 = (size_t)b * 2048 + n * 64;
      *(uint4*)(ATT + (tid >> 3) * 72 + (tid & 7) * 8) = rA;
      *(uint4*)(QD + (tid >> 4) * 136 + (tid & 15) * 8) = rQ0;
      *(uint4*)(QD + ((tid + NTHR) >> 4) * 136 + (tid & 15) * 8) = rQ1;
      *(uint4*)(KET + (tid >> 3) * 72 + (tid & 7) * 8) = rK0;
      *(uint4*)(KET + ((tid + NTHR) >> 3) * 72 + (tid & 7) * 8) = rK1;
      *(uint4*)(VT + (tid >> 3) * 72 + (tid & 7) * 8) = rV;
      if (tid < 128) LAST[tid] = rL;
      __syncthreads();
      if (n + 1 < 32) GLA_LOAD(n + 1);
      {
        const int ti = wave >> 1;
#pragma unroll
        for (int x = 0; x < 2; ++x) {
          const int te = (wave & 1) * 2 + x;
          f32x4 a = (f32x4){0.f, 0.f, 0.f, 0.f};
          a = wave_mma(ATT + ti * 16 * 72, 72, VT + te * 16 * 72, 72, 64, a, fr, fq);
          a = wave_mma(QD + ti * 16 * 136, 136, ST + te * 16 * 136, 136, 128, a, fr, fq);
#pragma unroll
          for (int r = 0; r < 4; ++r)
            O[(row0 + ti * 16 + fq * 4 + r) * 1024 + h * 256 + es * 64 + te * 16 + fr] = f2bf(a[r]);
        }
        const int et = wave >> 1;
#pragma unroll
        for (int x = 0; x < 4; ++x) {
          const int dt = (wave & 1) * 4 + x;
          const float dec = __expf(LAST[dt * 16 + fr]);
          f32x4 a = sacc[x];
          a[0] *= dec; a[1] *= dec; a[2] *= dec; a[3] *= dec;
          sacc[x] = wave_mma(VT + et * 16 * 72, 72, KET + dt * 16 * 72, 72, 64, a, fr, fq);
        }
      }
      __syncthreads();
      {
        const int et = wave >> 1;
#pragma unroll
        for (int x = 0; x < 4; ++x) {
          const int dt = (wave & 1) * 4 + x;
#pragma unroll
          for (int r = 0; r < 4; ++r) ST[(et * 16 + fq * 4 + r) * 136 + dt * 16 + fr] = f2bf(sacc[x][r]);
        }
      }
      __syncthreads();
    }
  }
}
#undef GLA_LOAD
__device__ __forceinline__ void gla_norm_phase(const PAcc& p) {
  const int lane = tid_() & 63;
  const int gw = blockIdx.x * (NTHR / 64) + (tid_() >> 6);
  const int nw = gridDim.x * (NTHR / 64);
  const u16* O = (const u16*)(p.pp->ws + GL_O);
  const u16* P = (const u16*)(p.pp->ws + GL_P);
  u16* OG = (u16*)(p.pp->ws + WS_H);
  const float4 gn = *(const float4*)(p.pp->in[35] + lane * 4);
  for (int row = gw; row < T_; row += nw) {
#pragma unroll
    for (int h = 0; h < 4; ++h) {
      const uint2 ov = *(const uint2*)(O + (size_t)row * 1024 + h * 256 + lane * 4);
      float4 v; v.x = bflo(ov.x); v.y = bfhi(ov.x); v.z = bflo(ov.y); v.w = bfhi(ov.y);
      float ss = v.x * v.x + v.y * v.y + v.z * v.z + v.w * v.w;
#pragma unroll
      for (int m = 32; m >= 1; m >>= 1) ss += __shfl_xor(ss, m);
      const float rstd = rsqrtf(ss * (1.f / 256.f) + 1e-6f);
      const uint2 g = *(const uint2*)(P + (size_t)row * 3088 + 2048 + h * 256 + lane * 4);
      uint2 o;
      o.x = pack2(v.x * rstd * gn.x * silu_(bflo(g.x)), v.y * rstd * gn.y * silu_(bfhi(g.x)));
      o.y = pack2(v.z * rstd * gn.z * silu_(bflo(g.y)), v.w * rstd * gn.w * silu_(bfhi(g.y)));
      *(uint2*)(OG + (size_t)row * 1024 + h * 256 + lane * 4) = o;
    }
  }
}


#define XB_TMO      128
#define XB_XCNT(j)  (256  + 64 * (j))
#define XB_XSUB(j)  (1280 + 64 * (j))
#define XB_XGEN(j)  (2304 + 64 * (j))
#define XB_TOP      3328
#define XB_TOPGEN   3392
#define XCD_BAR_WORDS 3456
#define XB_SPIN_CAP (1u << 18)
#define XLAS __attribute__((address_space(3)))
__device__ __forceinline__ unsigned xb_ld(unsigned* p)              { return __hip_atomic_load(p, __ATOMIC_RELAXED, __HIP_MEMORY_SCOPE_AGENT); }
__device__ __forceinline__ unsigned xb_add(unsigned* p, unsigned v) { return __hip_atomic_fetch_add(p, v, __ATOMIC_RELAXED, __HIP_MEMORY_SCOPE_AGENT); }
__device__ __forceinline__ unsigned xb_xcc_id() { return (unsigned)__builtin_amdgcn_s_getreg((3 << 11) | 20) & 0xFu; }
#define XB_SPIN(cond, bar) do { unsigned _sp = 0; while (cond) { __builtin_amdgcn_s_sleep(1); \
    if ((++_sp & 255u) == 0u) { if (xb_ld(&(bar)[XB_TMO])) break; if (_sp > XB_SPIN_CAP) { atomicAdd(&(bar)[XB_TMO], 1u); break; } } } } while (0)
struct XcdBarrier { unsigned* bar; unsigned x; volatile XLAS unsigned* st; };
__device__ __forceinline__ XcdBarrier xcd_barrier_post(unsigned* bar, volatile XLAS unsigned* st) {
  XcdBarrier b; b.bar = bar; b.x = xb_xcc_id(); b.st = st;
  if (tid_() == 0) (void)xb_add(&bar[XB_XCNT(b.x)], 1u);
  return b;
}
__device__ __forceinline__ void xcd_barrier_complete(unsigned* bar, unsigned x, unsigned& nloc, unsigned& nx) {
  const unsigned G = gridDim.x * gridDim.y * gridDim.z;
  unsigned sum, cnt, mine, sp = 0u;
  for (;;) {
    sum = 0u; cnt = 0u; mine = 0u;
#pragma unroll
    for (unsigned j = 0; j < 16; ++j) { const unsigned c = xb_ld(&bar[XB_XCNT(j)]); sum += c; cnt += (c > 0u) ? 1u : 0u; mine = (j == x) ? c : mine; }
    if (sum == G) break;
    __builtin_amdgcn_s_sleep(1);
    if ((++sp & 255u) == 0u) { if (xb_ld(&bar[XB_TMO])) break; if (sp > XB_SPIN_CAP) { atomicAdd(&bar[XB_TMO], 1u); break; } }
  }
  nloc = mine > 0u ? mine : 1u; nx = cnt > 0u ? cnt : 1u;
}
__device__ __forceinline__ void xcd_barrier(const XcdBarrier& b) {
  asm volatile("s_waitcnt vmcnt(0)" ::: "memory");
  __syncthreads();
  if (tid_() == 0) {
    unsigned* bar = b.bar;
    __builtin_amdgcn_s_waitcnt(0);
    unsigned nloc = b.st[0], nx = b.st[1];
    if (nloc == 0u) { xcd_barrier_complete(bar, b.x, nloc, nx); b.st[0] = nloc; b.st[1] = nx; }
    const unsigned old = xb_add(&bar[XB_XSUB(b.x)], 1u);
    const unsigned gen = old / nloc;
    if (old + 1u == (gen + 1u) * nloc) {
      __builtin_amdgcn_fence(__ATOMIC_RELEASE, "agent");
      asm volatile("s_waitcnt vmcnt(0)" ::: "memory");
      const unsigned og = xb_add(&bar[XB_TOP], 1u);
      const unsigned tg = og / nx;
      if (og + 1u == (tg + 1u) * nx) xb_add(&bar[XB_TOPGEN], 1u);
      else XB_SPIN(xb_ld(&bar[XB_TOPGEN]) == tg, bar);
      __builtin_amdgcn_fence(__ATOMIC_ACQUIRE, "agent");
      xb_add(&bar[XB_XGEN(b.x)], 1u);
      asm volatile("s_waitcnt vmcnt(0)" ::: "memory");
    } else {
      XB_SPIN(xb_ld(&bar[XB_XGEN(b.x)]) == gen, bar);
      __builtin_amdgcn_fence(__ATOMIC_ACQUIRE, "agent");
      asm volatile("s_waitcnt vmcnt(0)" ::: "memory");
    }
  }
  __syncthreads();
}

__global__ void __launch_bounds__(NTHR) fwd_megakernel(Params pk) {
  extern __shared__ __attribute__((aligned(16))) char lds[];
  cg::grid_group grid = cg::this_grid();
  PAcc p;
  p.pp = (CParamsPtr)__builtin_amdgcn_kernarg_segment_ptr();
  asm volatile("" : "+s"(p.pp));
  unsigned* xbar = (unsigned*)(p.pp->ws + WS_XBAR);
  volatile XLAS unsigned* xst = (volatile XLAS unsigned*)(lds + 128 * 1024);
  if (tid_() < 2) xst[tid_()] = 0u;
  if (blockIdx.x == 0) for (int i = tid_(); i < XCD_BAR_WORDS; i += NTHR) xbar[i] = 0u;
  const u16* WT = (const u16*)(p.pp->ws + WS_WT);
  u16* H = (u16*)(p.pp->ws + WS_H);
  u16* H2 = (u16*)(p.pp->ws + WS_H2);
  const float* MOD = (const float*)(p.pp->ws + WS_MOD);
  const float* xcur = p.pp->in[0];

#if DUP == 11
  for (int r_ = 0; r_ < 20; ++r_) grid.sync();
#endif
#if DUP == 5
  prep_phase(p, lds);
  grid.sync();
#endif
  prep_phase(p, lds);
  grid.sync();
  const XcdBarrier xb = xcd_barrier_post(xbar, xst);

  if (LAYER_MASK & 1) {
    for (int r_ = 0; r_ < ((DUP == 10) ? 2 : 1); ++r_) norm_phase<false, true, false>(p, p.pp->in[0], 0, H, nullptr);
    xcd_barrier(xb);
    for (int r_ = 0; r_ < ((DUP == 9) ? 2 : 1); ++r_) {
      pg8::EpiDsaMain e{(u16*)(p.pp->ws + DSA_QKVG), p.pp->in[6], p.pp->in[7], (const float2*)(p.pp->ws + WS_ROPE64), (u16*)(p.pp->ws + DSA_VT)};
      pg8::run<pg8::EpiDsaMain, true>(lds, H, H, H, WT + W_DSA_MAIN, WT + W_DSA_MAIN, WT + W_DSA_MAIN, 1024, 1024, 4, 1, 2560, e);
      pg8::EpiDsaIdx e2{(u16*)(p.pp->ws + DSA_QIHI), (u16*)(p.pp->ws + DSA_QILO), (u16*)(p.pp->ws + DSA_KIHI), (u16*)(p.pp->ws + DSA_KILO), (float*)(p.pp->ws + DSA_WI),
                        (const float2*)(p.pp->ws + WS_ROPE128)};
      pg8::run<pg8::EpiDsaIdx, true>(lds, H, H, H, WT + W_DSA_IDX_HI, WT + W_DSA_IDX_HI, WT + W_DSA_IDX_HI, 1024, 1024, 4, 1, 1280, e2);
    }
    xcd_barrier(xb);
#if DUP == 1
    dsa_unit_phase(p, lds, p.pp->ws == nullptr);
    xcd_barrier(xb);
#endif
    dsa_unit_phase(p, lds, true);
    xcd_barrier(xb);
    for (int r_ = 0; r_ < ((DUP == 9) ? 2 : 1); ++r_) {
      pg8::EpiResid<false, true> e{p.pp->ws + XR1, p.pp->in[0], MOD + 0 * 16 * 3072};
      const u16* A = (const u16*)(p.pp->ws + DSA_QKVG);
      pg8::run(lds, A, A, A, WT + W_DSA_OUT, WT + W_DSA_OUT, WT + W_DSA_OUT, 2560, 1024, 4, 1, 1024, e);
    }
    xcd_barrier(xb);
    xcur = p.pp->out;
  }
  if (LAYER_MASK & 2) {
    for (int r_ = 0; r_ < ((DUP == 10) ? 2 : 1); ++r_) norm_phase<false, false, true>(p, p.pp->ws + XR1, 1, H, nullptr);
    xcd_barrier(xb);
    for (int r_ = 0; r_ < ((DUP == 9) ? 2 : 1); ++r_) {
      pg8::EpiPlain e{(u16*)(p.pp->ws + LRU_UG), 2048, 2048};
      pg8::run(lds, H, H, H, WT + W_LRU_IN, WT + W_LRU_IN, WT + W_LRU_IN, 1024, 1024, 4, 1, 2048, e);
    }
    xcd_barrier(xb);
#if DUP == 4
    lru_fused_phase(p, lds);
    xcd_barrier(xb);
#endif
    lru_fused_phase(p, lds);
    xcd_barrier(xb);
    {
      pg8::EpiResid<true, true> e{p.pp->out, p.pp->ws + XR1, MOD + 1 * 16 * 3072};
      pg8::run(lds, H, H, H, WT + W_LRU_OUT, WT + W_LRU_OUT, WT + W_LRU_OUT, 1024, 1024, 4, 1, 1024, e);
    }
    xcd_barrier(xb);
    xcur = p.pp->out;
  }
  if (LAYER_MASK & 4) {
    for (int r_ = 0; r_ < ((DUP == 10) ? 2 : 1); ++r_) norm_phase<true, false, true>(p, p.pp->out, 2, H, nullptr);
    xcd_barrier(xb);
    for (int r_ = 0; r_ < ((DUP == 9) ? 2 : 1); ++r_) {
      pg8::EpiPlain e{(u16*)(p.pp->ws + RW_RKVG), 4096, 4096};
      pg8::run(lds, H, H, H, WT + W_RWKV_IN, WT + W_RWKV_IN, WT + W_RWKV_IN, 2048, 2048, 5, 1, 4096, e);
      EpiP e2{}; e2.o16 = (u16*)(p.pp->ws + RW_L1);
      gemm_phase<EPI_RWKV_L1>(p, H, H, H, WT + W_RWKV_L1, WT + W_RWKV_L1, WT + W_RWKV_L1, 2048, 2048, 2048, 1, 0, 1, e2, lds);
    }
    xcd_barrier(xb);
    for (int r_ = 0; r_ < ((DUP == 9) ? 2 : 1); ++r_) {
      const u16* L1 = (const u16*)(p.pp->ws + RW_L1);
      EpiP e{}; e.of = (float*)(p.pp->ws + RW_EW); e.f0 = p.pp->in[20];
      gemm_phase<EPI_RWKV_W>(p, L1, L1, L1, WT + W_RWKV_W2, WT + W_RWKV_W2, WT + W_RWKV_W2, 128, 64, 64, 1, 0, 8, e, lds);
      EpiP e2{}; e2.o16 = (u16*)(p.pp->ws + RW_A); e2.f0 = p.pp->in[23];
      gemm_phase<EPI_RWKV_A>(p, L1 + 64, L1 + 64, L1 + 64, WT + W_RWKV_A2, WT + W_RWKV_A2, WT + W_RWKV_A2, 128, 64, 64, 1, 0, 8, e2, lds);
    }
    xcd_barrier(xb);
#if DUP == 2
    rwkv_rec_phase(p, lds, p.pp->ws == nullptr);
    xcd_barrier(xb);
#endif
    rwkv_rec_phase(p, lds, true);
    xcd_barrier(xb);
    {
      pg8::EpiResid<true, true> e{p.pp->ws + XR3, p.pp->out, MOD + 2 * 16 * 3072};
      const u16* A = (const u16*)(p.pp->ws + RW_RKVG);
      pg8::run(lds, A, A, A, WT + W_RWKV_OUT, WT + W_RWKV_OUT, WT + W_RWKV_OUT, 4096, 1024, 4, 1, 1024, e);
    }
    xcd_barrier(xb);
    xcur = p.pp->out;
  }
  if (LAYER_MASK & 8) {
    for (int r_ = 0; r_ < ((DUP == 10) ? 2 : 1); ++r_) norm_phase<false, false, true>(p, p.pp->ws + XR3, 3, H, nullptr);
    xcd_barrier(xb);
    for (int r_ = 0; r_ < ((DUP == 9) ? 2 : 1); ++r_) {
      pg8::EpiPlain e{(u16*)(p.pp->ws + GL_P), 3088, 3088};
      pg8::run(lds, H, H, H, WT + W_GLA_IN, WT + W_GLA_IN, WT + W_GLA_IN, 1024, 1024, 4, 1, 3328, e);
    }
    xcd_barrier(xb);
    gla_pre_phase(p, lds);
    xcd_barrier(xb);
#if DUP == 3
    gla_phase(p, lds);
    xcd_barrier(xb);
#endif
    gla_phase(p, lds);
    xcd_barrier(xb);
    for (int r_ = 0; r_ < ((DUP == 10) ? 2 : 1); ++r_) gla_norm_phase(p);
    xcd_barrier(xb);
    {
      pg8::EpiResid<true, false> e{p.pp->out, p.pp->ws + XR3, MOD + 3 * 16 * 3072};
      pg8::run(lds, H, H, H, WT + W_GLA_OUT, WT + W_GLA_OUT, WT + W_GLA_OUT, 1024, 1024, 4, 1, 1024, e);
    }
    xcur = p.pp->out;
  }
  if (xcur != p.pp->out) {
    for (size_t i = (size_t)blockIdx.x * NTHR + tid_(); i < (size_t)T_ * 1024 / 4; i += (size_t)gridDim.x * NTHR)
      ((float4*)p.pp->out)[i] = ((const float4*)p.pp->in[0])[i];
  }
}

extern "C" void kernel_launch(void* const* d_in, const int* in_sizes, int n_in, void* d_out, int out_size, void* d_ws, size_t ws_size,
                              hipStream_t stream) {
  static int grid_blocks = 0;
  if (!grid_blocks) {
    int dev = 0, cus = 0, per_cu = 0;
    hipGetDevice(&dev);
    hipDeviceGetAttribute(&cus, hipDeviceAttributeMultiprocessorCount, dev);
    hipFuncSetAttribute((const void*)fwd_megakernel, hipFuncAttributeMaxDynamicSharedMemorySize, LDS_BYTES);
    hipOccupancyMaxActiveBlocksPerMultiprocessor(&per_cu, (const void*)fwd_megakernel, NTHR, LDS_BYTES);
    if (per_cu < 1) { fprintf(stderr, "occupancy query says %d blocks/CU\n", per_cu); per_cu = 1; }
    grid_blocks = cus;
  }
  Params p{};
  for (int i = 0; i < 37; ++i) p.in[i] = (const float*)d_in[i];
  p.out = (float*)d_out;
  p.ws = (unsigned char*)d_ws;
  for (int i = 0; i < 64; ++i) p.invf128[i] = (float)pow(10000.0, -(double)i / 64.0);
  for (int i = 0; i < 32; ++i) p.invf64[i] = (float)pow(10000.0, -(double)i / 32.0);
  void* args[] = {&p};
  hipError_t e = hipLaunchCooperativeKernel((const void*)fwd_megakernel, dim3(grid_blocks), dim3(NTHR), args, LDS_BYTES, stream);
  if (e != hipSuccess) fprintf(stderr, "cooperative launch failed: %s (grid %d)\n", hipGetErrorString(e), grid_blocks);
}
```

```cpp
#include <hip/hip_runtime.h>
#include <hip/hip_cooperative_groups.h>
#include <cstdio>
#include <cmath>
namespace cg = cooperative_groups;

#ifndef DUP
#define DUP 0
#endif
#ifndef LAYER_MASK
#define LAYER_MASK 15
#endif

typedef unsigned short u16;
using bf16x8 = __attribute__((ext_vector_type(8))) short;
using f32x4 = __attribute__((ext_vector_type(4))) float;

#define NTHR 512
constexpr int T_ = 32768;
constexpr size_t MiB = 1ull << 20;
constexpr int LDS_BYTES = 128 * 1024 + 64;
constexpr size_t WS_XBAR = 896 * 1024;

constexpr size_t WS_MOD = 0;
constexpr size_t WS_ROPE128 = 1 * MiB;
constexpr size_t WS_ROPE64 = 2 * MiB;
constexpr size_t WS_WT = 4 * MiB;
constexpr size_t WS_H = 52 * MiB;
constexpr size_t WS_H2 = 116 * MiB;
constexpr size_t WS_P = 180 * MiB;

constexpr size_t W_DSA_MAIN = 0;
constexpr size_t W_DSA_IDX_HI = W_DSA_MAIN + 2560ull * 1024;
constexpr size_t W_DSA_IDX_LO = W_DSA_IDX_HI + 1280ull * 1024;
constexpr size_t W_DSA_OUT = W_DSA_IDX_LO + 1280ull * 1024;
constexpr size_t W_LRU_IN = W_DSA_OUT + 1024ull * 1024;
constexpr size_t W_LRU_GATE = W_LRU_IN + 2048ull * 1024;
constexpr size_t W_LRU_OUT = W_LRU_GATE + 16ull * 128 * 64;
constexpr size_t W_RWKV_IN = W_LRU_OUT + 1024ull * 1024;
constexpr size_t W_RWKV_L1 = W_RWKV_IN + 4096ull * 2048;
constexpr size_t W_RWKV_W2 = W_RWKV_L1 + 128ull * 2048;
constexpr size_t W_RWKV_A2 = W_RWKV_W2 + 1024ull * 64;
constexpr size_t W_RWKV_OUT = W_RWKV_A2 + 1024ull * 64;
constexpr size_t W_GLA_IN = W_RWKV_OUT + 1024ull * 1024;
constexpr size_t W_GLA_OUT = W_GLA_IN + 3328ull * 1024;
constexpr size_t W_END = W_GLA_OUT + 1024ull * 1024;
static_assert(W_END * 2 <= 48 * MiB, "weights region");

constexpr size_t DSA_QKVG = WS_P;
constexpr size_t DSA_QIHI = WS_P + 160 * MiB;
constexpr size_t DSA_QILO = WS_P + 224 * MiB;
constexpr size_t DSA_KIHI = WS_P + 288 * MiB;
constexpr size_t DSA_KILO = WS_P + 296 * MiB;
constexpr size_t DSA_WI = WS_P + 304 * MiB;
constexpr size_t DSA_VT = WS_P + 306 * MiB;
constexpr size_t DSA_SCR = WS_H;
constexpr size_t LRU_UG = WS_H2;
constexpr size_t LRU_A = WS_H2 + 128 * MiB;
constexpr size_t LRU_B = WS_H2 + 256 * MiB;
constexpr size_t RW_RKVG = WS_P;
constexpr size_t RW_L1 = WS_P + 256 * MiB;
constexpr size_t RW_EW = WS_H;
constexpr size_t RW_A = WS_P + 264 * MiB;
constexpr size_t GL_P = WS_H2;
constexpr size_t GL_O = WS_H2 + 194 * MiB;
constexpr size_t GL_QD = WS_H2 + 258 * MiB;
constexpr size_t GL_KET = WS_H2 + 290 * MiB;
constexpr size_t GL_ATT_OUT = 0;
constexpr size_t GL_LAST_OUT = 16 * MiB;
constexpr size_t XR1 = 448 * MiB;
constexpr size_t XR3 = 438 * MiB;
constexpr size_t GL_VT = WS_H;

struct Params {
  const float* in[37];
  float* out;
  unsigned char* ws;
  float invf128[64];
  float invf64[32];
};

typedef const Params __attribute__((address_space(4))) * CParamsPtr;
struct PAcc { CParamsPtr pp; };

__device__ __forceinline__ int tid_() { int t = __builtin_amdgcn_workitem_id_x(); asm volatile("" : "+v"(t)); return t; }
__device__ __forceinline__ u16 f2bf(float f) {
  unsigned u = __float_as_uint(f);
  u += 0x7fffu + ((u >> 16) & 1u);
  return (u16)(u >> 16);
}
__device__ __forceinline__ float bf2f(u16 h) { return __uint_as_float(((unsigned)h) << 16); }
__device__ __forceinline__ float bflo(unsigned w) { return __uint_as_float(w << 16); }
__device__ __forceinline__ float bfhi(unsigned w) { return __uint_as_float(w & 0xffff0000u); }
__device__ __forceinline__ unsigned pack2(float a, float b) { return (unsigned)f2bf(a) | ((unsigned)f2bf(b) << 16); }
__device__ __forceinline__ float sigmoid_(float x) { return __builtin_amdgcn_rcpf(1.f + __expf(-x)); }
__device__ __forceinline__ float silu_(float x) { return x * __builtin_amdgcn_rcpf(1.f + __expf(-x)); }
__device__ __forceinline__ float softplus_(float x) { return x > 20.f ? x : log1pf(__expf(x)); }
template <int CTRL> __device__ __forceinline__ float dpp(float x) {
  return __builtin_bit_cast(float, __builtin_amdgcn_mov_dpp(__builtin_bit_cast(int, x), CTRL, 0xf, 0xf, true));
}
__device__ __forceinline__ float red8(float x) {
  x += dpp<0xB1>(x); x += dpp<0x4E>(x); x += dpp<0x141>(x); return x;
}
typedef _Float16 f16x8_t __attribute__((ext_vector_type(8)));
typedef _Float16 f16x2_t __attribute__((ext_vector_type(2)));
__device__ __forceinline__ f32x4 mfma16h(bf16x8 a, bf16x8 b, f32x4 c) {
  return __builtin_amdgcn_mfma_f32_16x16x32_f16(__builtin_bit_cast(f16x8_t, a), __builtin_bit_cast(f16x8_t, b), c, 0, 0, 0);
}
__device__ __forceinline__ unsigned packh2(float a, float b) {
  f16x2_t v; v.x = (_Float16)a; v.y = (_Float16)b; return __builtin_bit_cast(unsigned, v);
}
__device__ __forceinline__ float hlo(unsigned w) { return (float)__builtin_bit_cast(f16x2_t, w).x; }
__device__ __forceinline__ float hhi(unsigned w) { return (float)__builtin_bit_cast(f16x2_t, w).y; }
__device__ __forceinline__ u16 f2h(float a) { return __builtin_bit_cast(u16, (_Float16)a); }
__device__ __forceinline__ float red32(float x) {
  x += dpp<0xB1>(x); x += dpp<0x4E>(x); x += dpp<0x141>(x); x += dpp<0x140>(x);
  const auto s_ = __builtin_amdgcn_permlane16_swap(__float_as_uint(x), __float_as_uint(x), false, false);
  return __uint_as_float(s_[0]) + __uint_as_float(s_[1]);
}
__device__ __forceinline__ f32x4 mfma16(bf16x8 a, bf16x8 b, f32x4 c) {
  return __builtin_amdgcn_mfma_f32_16x16x32_bf16(a, b, c, 0, 0, 0);
}
__device__ __forceinline__ void sincos_d(double x, float& c, float& s) {
  double k = rint(x * 0.63661977236758134308);
  double r = fma(-k, 1.57079632679489655800, x);
  r = fma(-k, 6.12323399573676603587e-17, r);
  int q = ((int)k) & 3;
  double r2 = r * r;
  double sp = r * (1.0 + r2 * (-1.0 / 6 + r2 * (1.0 / 120 + r2 * (-1.0 / 5040 + r2 * (1.0 / 362880 + r2 * (-1.0 / 39916800 + r2 * (1.0 / 6227020800.0)))))));
  double cp = 1.0 + r2 * (-0.5 + r2 * (1.0 / 24 + r2 * (-1.0 / 720 + r2 * (1.0 / 40320 + r2 * (-1.0 / 3628800 + r2 * (1.0 / 479001600.0 + r2 * (-1.0 / 87178291200.0)))))));
  double ss = (q == 0) ? sp : (q == 1) ? cp : (q == 2) ? -sp : -cp;
  double cc = (q == 0) ? cp : (q == 1) ? -sp : (q == 2) ? -cp : sp;
  c = (float)cc; s = (float)ss;
}

__device__ __forceinline__ int idx_perm(int p) {
  int wc = p >> 6, jn = (p >> 4) & 3, fr = p & 15;
  return wc * 32 + (jn & 1) * 16 + fr + 64 * (jn >> 1);
}
__device__ __forceinline__ void tconv_job(const float* __restrict__ src, int ld_src, int K, int nrows, int colmode, int col_off, int nvalid,
                          u16* __restrict__ dst, u16* __restrict__ dst_lo, int ldd, int dst_col0,
                          const float* __restrict__ mu, int smode, float* tl, int fmt = 0) {
  const int tid = tid_();
  const int tk = K >> 6, tn = nrows >> 6;
  for (int tile = blockIdx.x; tile < tk * tn; tile += gridDim.x) {
    const int k0 = (tile % tk) << 6, j0 = (tile / tk) << 6;
    {
      const int jn = tid & 63;
      const int j = j0 + jn;
      int col;
      if (colmode == 0) col = (j < nvalid) ? col_off + j : -1;
      else if (colmode == 2) {
        if (j < 1280) { const int P = j & 255; col = (j & ~255) + ((P >> 5) & 3) * 64 + 32 * (P >> 7) + (P & 31); }
        else col = j;
      } else {
        const int P = j & 255, bj = P >> 7, wcc = (P >> 5) & 3, r5 = P & 31;
        if (j < 1024) col = 2560 + ((j >> 8) * 2 + (wcc >> 1)) * 128 + 32 * (wcc & 1) + r5 + 64 * bj;
        else if (wcc < 2) col = 3592 + 32 * (wcc & 1) + r5 + 64 * bj;
        else if (wcc == 2 && bj == 0 && r5 < 8) col = 3584 + r5;
        else col = -1;
      }
#pragma unroll
      for (int i = 0; i < 8; ++i) {
        const int kr = i * 8 + (tid >> 6);
        float v = 0.f;
        if (col >= 0) v = src[(size_t)(k0 + kr) * ld_src + col];
        if (smode == 1) v *= (1.f - mu[k0 + kr]);
        else if (smode == 2) v *= mu[k0 + kr];
        tl[kr * 65 + jn] = v;
      }
    }
    __syncthreads();
    {
      const int kr = tid & 63;
#pragma unroll
      for (int i = 0; i < 8; ++i) {
        const int jn = i * 8 + (tid >> 6);
        float v = tl[kr * 65 + jn];
        u16 hi = fmt ? f2h(v) : f2bf(v);
        size_t o = (size_t)(j0 + jn) * ldd + dst_col0 + k0 + kr;
        dst[o] = hi;
        if (dst_lo) dst_lo[o] = f2bf(v - bf2f(hi));
      }
    }
    __syncthreads();
  }
}

__device__ __forceinline__ void prep_phase(const PAcc& p, char* lds) {
  const int tid = tid_();
  u16* WT = (u16*)(p.pp->ws + WS_WT);
  float* fl = (float*)lds;
  if (blockIdx.x < 192) {
    float* cact = fl;
    float* red = fl + 16384;
    const float* c = p.pp->in[1];
    for (int i = tid; i < 16384; i += NTHR) { int b = i >> 10, k = i & 1023; cact[k * 16 + b] = silu_(c[i]); }
    __syncthreads();
    for (int item = blockIdx.x; item < 192; item += gridDim.x) {
      const int l = item / 48, n0 = (item % 48) * 64;
      const int col = tid & 63, kq = tid >> 6;
      float acc[16];
#pragma unroll
      for (int b = 0; b < 16; ++b) acc[b] = 0.f;
      const float* w = p.pp->in[3] + (size_t)l * 1024 * 3072 + n0 + col;
#pragma unroll 16
      for (int k = kq * 128; k < kq * 128 + 128; ++k) {
        float wv = w[(size_t)k * 3072];
        const float4* cp = (const float4*)(cact + k * 16);
        float4 c0 = cp[0], c1 = cp[1], c2 = cp[2], c3 = cp[3];
        acc[0] += c0.x * wv; acc[1] += c0.y * wv; acc[2] += c0.z * wv; acc[3] += c0.w * wv;
        acc[4] += c1.x * wv; acc[5] += c1.y * wv; acc[6] += c1.z * wv; acc[7] += c1.w * wv;
        acc[8] += c2.x * wv; acc[9] += c2.y * wv; acc[10] += c2.z * wv; acc[11] += c2.w * wv;
        acc[12] += c3.x * wv; acc[13] += c3.y * wv; acc[14] += c3.z * wv; acc[15] += c3.w * wv;
      }
#pragma unroll
      for (int b = 0; b < 16; ++b) red[(kq * 16 + b) * 64 + col] = acc[b];
      __syncthreads();
      for (int o = tid; o < 1024; o += NTHR) {
        int b = o >> 6, cc = o & 63;
        float s = 0.f;
#pragma unroll
        for (int q = 0; q < 8; ++q) s += red[(q * 16 + b) * 64 + cc];
        ((float*)(p.pp->ws + WS_MOD))[((size_t)l * 16 + b) * 3072 + n0 + cc] = s + p.pp->in[4][l * 3072 + n0 + cc];
      }
      __syncthreads();
    }
  }
  __syncthreads();
  {
    const float f128 = p.pp->invf128[tid & 63], f64 = p.pp->invf64[tid & 31];
    float2* r128 = (float2*)(p.pp->ws + WS_ROPE128);
    float2* r64 = (float2*)(p.pp->ws + WS_ROPE64);
    for (int idx = blockIdx.x * NTHR + tid; idx < 2048 * 64; idx += gridDim.x * NTHR) {
      int pos = idx >> 6;
      float ang = (float)pos * f128;
      float c_, s_; sincos_d((double)ang, c_, s_);
      r128[idx] = make_float2(c_, s_);
    }
    for (int idx = blockIdx.x * NTHR + tid; idx < 2048 * 32; idx += gridDim.x * NTHR) {
      int pos = idx >> 5;
      float ang = (float)pos * f64;
      float c_, s_; sincos_d((double)ang, c_, s_);
      r64[idx] = make_float2(c_, s_);
    }
  }
  float* tl = fl;
  tconv_job(p.pp->in[5], 3720, 1024, 2560, 2, 0, 2560, WT + W_DSA_MAIN, nullptr, 1024, 0, nullptr, 0, tl, 1);
  tconv_job(p.pp->in[5], 3720, 1024, 1280, 3, 0, 0, WT + W_DSA_IDX_HI, nullptr, 1024, 0, nullptr, 0, tl, 1);
  tconv_job(p.pp->in[8], 1024, 1024, 1024, 0, 0, 1024, WT + W_DSA_OUT, nullptr, 1024, 0, nullptr, 0, tl);
  tconv_job(p.pp->in[9], 2048, 1024, 2048, 0, 0, 2048, WT + W_LRU_IN, nullptr, 1024, 0, nullptr, 0, tl);
  tconv_job(p.pp->in[17], 1024, 1024, 1024, 0, 0, 1024, WT + W_LRU_OUT, nullptr, 1024, 0, nullptr, 0, tl);
  for (int n = 0; n < 4; ++n) {
    tconv_job(p.pp->in[19] + (size_t)n * 1024 * 1024, 1024, 1024, 1024, 0, 0, 1024, WT + W_RWKV_IN + (size_t)n * 1024 * 2048, nullptr, 2048, 0, p.pp->in[18] + n * 1024, 1, tl);
    tconv_job(p.pp->in[19] + (size_t)n * 1024 * 1024, 1024, 1024, 1024, 0, 0, 1024, WT + W_RWKV_IN + (size_t)n * 1024 * 2048, nullptr, 2048, 1024, p.pp->in[18] + n * 1024, 2, tl);
  }
  tconv_job(p.pp->in[21], 64, 1024, 64, 0, 0, 64, WT + W_RWKV_L1, nullptr, 2048, 0, p.pp->in[18] + 4 * 1024, 1, tl);
  tconv_job(p.pp->in[21], 64, 1024, 64, 0, 0, 64, WT + W_RWKV_L1, nullptr, 2048, 1024, p.pp->in[18] + 4 * 1024, 2, tl);
  tconv_job(p.pp->in[24], 64, 1024, 64, 0, 0, 64, WT + W_RWKV_L1 + 64 * 2048, nullptr, 2048, 0, p.pp->in[18] + 5 * 1024, 1, tl);
  tconv_job(p.pp->in[24], 64, 1024, 64, 0, 0, 64, WT + W_RWKV_L1 + 64 * 2048, nullptr, 2048, 1024, p.pp->in[18] + 5 * 1024, 2, tl);
  tconv_job(p.pp->in[22], 1024, 64, 1024, 0, 0, 1024, WT + W_RWKV_W2, nullptr, 64, 0, nullptr, 0, tl);
  tconv_job(p.pp->in[25], 1024, 64, 1024, 0, 0, 1024, WT + W_RWKV_A2, nullptr, 64, 0, nullptr, 0, tl);
  tconv_job(p.pp->in[31], 1024, 1024, 1024, 0, 0, 1024, WT + W_RWKV_OUT, nullptr, 1024, 0, nullptr, 0, tl);
  tconv_job(p.pp->in[32], 3088, 1024, 3328, 0, 0, 3088, WT + W_GLA_IN, nullptr, 1024, 0, nullptr, 0, tl);
  tconv_job(p.pp->in[36], 1024, 1024, 1024, 0, 0, 1024, WT + W_GLA_OUT, nullptr, 1024, 0, nullptr, 0, tl);
  for (int idx = blockIdx.x * NTHR + tid; idx < 16 * 128 * 64; idx += gridDim.x * NTHR) {
    int n = idx >> 13, pp = (idx >> 6) & 127, k = idx & 63;
    int wc = pp >> 6, jn = (pp >> 4) & 3, fr = pp & 15;
    int type = jn & 1, d = wc * 32 + (jn >> 1) * 16 + fr;
    const float* src = type ? p.pp->in[14] : p.pp->in[12];
    WT[W_LRU_GATE + idx] = f2bf(src[n * 4096 + k * 64 + d]);
  }
}

template <bool SHIFT, bool F16 = false, bool IN16 = false>
__device__ __forceinline__ void norm_phase(const PAcc& p, const void* __restrict__ xin, int layer, u16* __restrict__ Hhi, u16* __restrict__ Hlo) {
  const int lane = tid_() & 63;
  const int gw = blockIdx.x * (NTHR / 64) + (tid_() >> 6);
  const int nw = gridDim.x * (NTHR / 64);
  const float* gain = p.pp->in[2] + layer * 1024;
  const float* mod = (const float*)(p.pp->ws + WS_MOD) + (size_t)layer * 16 * 3072;
  for (int row = gw; row < T_; row += nw) {
    float4 v[4];
    float ss = 0.f;
    if (IN16) {
      const uint2* xr = (const uint2*)((const u16*)xin + (size_t)row * 1024);
#pragma unroll
      for (int i = 0; i < 4; ++i) { const uint2 t = xr[i * 64 + lane]; v[i] = make_float4(bflo(t.x), bfhi(t.x), bflo(t.y), bfhi(t.y)); }
    } else {
      const float4* xr = (const float4*)((const float*)xin + (size_t)row * 1024);
#pragma unroll
      for (int i = 0; i < 4; ++i) v[i] = xr[i * 64 + lane];
    }
#pragma unroll
    for (int i = 0; i < 4; ++i) ss += v[i].x * v[i].x + v[i].y * v[i].y + v[i].z * v[i].z + v[i].w * v[i].w;
#pragma unroll
    for (int m = 32; m >= 1; m >>= 1) ss += __shfl_xor(ss, m);
    const float rstd = rsqrtf(ss * (1.f / 1024.f) + 1e-6f);
    const float* mb = mod + (size_t)(row >> 11) * 3072;
#pragma unroll
    for (int i = 0; i < 4; ++i) {
      const int c = i * 256 + lane * 4;
      float4 g = *(const float4*)(gain + c);
      float4 sh = *(const float4*)(mb + c);
      float4 sc = *(const float4*)(mb + 1024 + c);
      float y0 = v[i].x * rstd * g.x * (1.f + sc.x) + sh.x;
      float y1 = v[i].y * rstd * g.y * (1.f + sc.y) + sh.y;
      float y2 = v[i].z * rstd * g.z * (1.f + sc.z) + sh.z;
      float y3 = v[i].w * rstd * g.w * (1.f + sc.w) + sh.w;
      uint2 o;
      if (F16) { o.x = packh2(y0, y1); o.y = packh2(y2, y3); }
      else { o.x = pack2(y0, y1); o.y = pack2(y2, y3); }
      if (SHIFT) {
        *(uint2*)(Hhi + (size_t)row * 2048 + c) = o;
        if (((row + 1) & 2047) != 0) *(uint2*)(Hhi + (size_t)(row + 1) * 2048 + 1024 + c) = o;
        if ((row & 2047) == 0) *(uint2*)(Hhi + (size_t)row * 2048 + 1024 + c) = make_uint2(0u, 0u);
      } else {
        *(uint2*)(Hhi + (size_t)row * 1024 + c) = o;
      }
      if (!SHIFT && Hlo) {
        uint2 l;
        l.x = packh2(y0 - hlo(o.x), y1 - hhi(o.x));
        l.y = packh2(y2 - hlo(o.y), y3 - hhi(o.y));
        *(uint2*)(Hlo + (size_t)row * 1024 + c) = l;
      }
    }
  }
}

enum { EPI_PLAIN = 0, EPI_DSA_MAIN, EPI_DSA_IDX, EPI_RESID, EPI_RWKV_L1, EPI_RWKV_W, EPI_RWKV_A };
struct EpiP {
  u16* o16; u16* o16b; u16* o16c; u16* o16d; float* of; const float* f0; const float* f1; const float* f2; const float* f3;
  int ldc; int nvalid;
};
constexpr int LROW = 40;

template <int EPI>
__device__ __forceinline__ void gemm_epilogue(const EpiP& e, const PAcc& p, f32x4 (&acc)[4][4], int rowbase, int colbase, int nt, int wc, int fr, int fq) {
  if (EPI == EPI_PLAIN) {
#pragma unroll
    for (int i = 0; i < 4; ++i)
#pragma unroll
      for (int j = 0; j < 4; ++j) {
        const int col = colbase + j * 16 + fr;
        if (col < e.nvalid) {
#pragma unroll
          for (int r = 0; r < 4; ++r) e.o16[(size_t)(rowbase + i * 16 + fq * 4 + r) * e.ldc + col] = f2bf(acc[i][j][r]);
        }
      }
  } else if (EPI == EPI_DSA_MAIN) {
    if (nt < 10) {
      const float* gain = (nt < 8) ? e.f0 : e.f1;
      const float g0 = gain[fr], g1 = gain[16 + fr], g2 = gain[32 + fr], g3 = gain[48 + fr];
      const float2* rope = (const float2*)(p.pp->ws + WS_ROPE64);
#pragma unroll
      for (int i = 0; i < 4; ++i)
#pragma unroll
        for (int r = 0; r < 4; ++r) {
          float v0 = acc[i][0][r], v1 = acc[i][1][r], v2 = acc[i][2][r], v3 = acc[i][3][r];
          float ss = v0 * v0 + v1 * v1 + v2 * v2 + v3 * v3;
          ss += __shfl_xor(ss, 1); ss += __shfl_xor(ss, 2); ss += __shfl_xor(ss, 4); ss += __shfl_xor(ss, 8);
          const float rstd = rsqrtf(ss * (1.f / 64.f) + 1e-6f);
          v0 *= rstd * g0; v1 *= rstd * g1; v2 *= rstd * g2; v3 *= rstd * g3;
          const int row = rowbase + i * 16 + fq * 4 + r;
          const int pos = row & 2047;
          const float2 ca = rope[pos * 32 + fr], cb = rope[pos * 32 + 16 + fr];
          const float o0 = v0 * ca.x - v2 * ca.y, o2 = v2 * ca.x + v0 * ca.y;
          const float o1 = v1 * cb.x - v3 * cb.y, o3 = v3 * cb.x + v1 * cb.y;
          u16* d = e.o16 + (size_t)row * 2560 + colbase + fr;
          d[0] = f2bf(o0); d[16] = f2bf(o1); d[32] = f2bf(o2); d[48] = f2bf(o3);
        }
    } else {
#pragma unroll
      for (int i = 0; i < 4; ++i)
#pragma unroll
        for (int j = 0; j < 4; ++j)
#pragma unroll
          for (int r = 0; r < 4; ++r) e.o16[(size_t)(rowbase + i * 16 + fq * 4 + r) * 2560 + colbase + j * 16 + fr] = f2bf(acc[i][j][r]);
    }
  } else if (EPI == EPI_DSA_IDX) {
    if (nt < 9) {
      const float2* rope = (const float2*)(p.pp->ws + WS_ROPE128);
#pragma unroll
      for (int i = 0; i < 4; ++i)
#pragma unroll
        for (int r = 0; r < 4; ++r) {
          const int row = rowbase + i * 16 + fq * 4 + r;
          const int pos = row & 2047;
#pragma unroll
          for (int jj = 0; jj < 2; ++jj) {
            const int ii = wc * 32 + jj * 16 + fr;
            const float2 cs = rope[pos * 64 + ii];
            const float x1 = acc[i][jj][r], x2 = acc[i][jj + 2][r];
            const float o1 = x1 * cs.x - x2 * cs.y, o2 = x2 * cs.x + x1 * cs.y;
            const u16 h1 = f2bf(o1), h2 = f2bf(o2);
            const u16 l1 = f2bf(o1 - bf2f(h1)), l2 = f2bf(o2 - bf2f(h2));
            if (nt < 8) {
              size_t o = (size_t)row * 1024 + nt * 128 + ii;
              e.o16[o] = h1; e.o16[o + 64] = h2; e.o16b[o] = l1; e.o16b[o + 64] = l2;
            } else {
              size_t o = (size_t)row * 128 + ii;
              e.o16c[o] = h1; e.o16c[o + 64] = h2; e.o16d[o] = l1; e.o16d[o + 64] = l2;
            }
          }
        }
    } else {
      if (wc == 0 && fr < 8) {
#pragma unroll
        for (int i = 0; i < 4; ++i)
#pragma unroll
          for (int r = 0; r < 4; ++r) e.of[(size_t)(rowbase + i * 16 + fq * 4 + r) * 8 + fr] = acc[i][0][r] * 0.03125f;
      }
    }
  } else if (EPI == EPI_RESID) {
#pragma unroll
    for (int i = 0; i < 4; ++i)
#pragma unroll
      for (int j = 0; j < 4; ++j) {
        const int col = colbase + j * 16 + fr;
#pragma unroll
        for (int r = 0; r < 4; ++r) {
          const int row = rowbase + i * 16 + fq * 4 + r;
          const float gate = e.f1[(size_t)(row >> 11) * 3072 + 2048 + col];
          const size_t o = (size_t)row * 1024 + col;
          e.of[o] = e.f0[o] + gate * acc[i][j][r];
        }
      }
  } else if (EPI == EPI_RWKV_L1) {
#pragma unroll
    for (int i = 0; i < 4; ++i)
#pragma unroll
      for (int j = 0; j < 4; ++j) {
        const int col = colbase + j * 16 + fr;
#pragma unroll
        for (int r = 0; r < 4; ++r) {
          float v = acc[i][j][r];
          if (col < 64) v = tanhf(v);
          e.o16[(size_t)(rowbase + i * 16 + fq * 4 + r) * 128 + col] = f2bf(v);
        }
      }
  } else if (EPI == EPI_RWKV_W) {
#pragma unroll
    for (int i = 0; i < 4; ++i)
#pragma unroll
      for (int j = 0; j < 4; ++j) {
        const int col = colbase + j * 16 + fr;
        const float w0 = e.f0[col];
#pragma unroll
        for (int r = 0; r < 4; ++r) {
          const float w = w0 + acc[i][j][r];
          e.of[(size_t)(rowbase + i * 16 + fq * 4 + r) * 1024 + col] = sigmoid_(w) * 0.60653065971f;
        }
      }
  } else if (EPI == EPI_RWKV_A) {
#pragma unroll
    for (int i = 0; i < 4; ++i)
#pragma unroll
      for (int j = 0; j < 4; ++j) {
        const int col = colbase + j * 16 + fr;
        const float a0 = e.f0[col];
#pragma unroll
        for (int r = 0; r < 4; ++r)
          e.o16[(size_t)(rowbase + i * 16 + fq * 4 + r) * 1024 + col] = f2bf(sigmoid_(a0 + acc[i][j][r]));
      }
  }
}

template <int EPI>
__device__ __forceinline__ void gemm_phase(const PAcc& p, const u16* A0, const u16* A1, const u16* A2, const u16* B0, const u16* B1, const u16* B2,
                           int lda, int ldb, int kseg, int nseg, int shiftmask, int ntn, const EpiP& e, char* ldsc) {
  const int tid = tid_(), lane = tid & 63, wave = tid >> 6;
  const int wr = wave >> 1, wc = wave & 1, fr = lane & 15, fq = lane >> 4;
  u16* As = (u16*)ldsc;
  u16* Bs = As + 2 * 256 * LROW;
  const int kps = kseg >> 5;
  const int nk = nseg * kps;
  const int ntiles = 128 * ntn;
  const int lrow = tid >> 2, lkc = (tid & 3) * 8;
  for (int tile = blockIdx.x; tile < ntiles; tile += gridDim.x) {
    const int mt = tile / ntn, nt = tile - mt * ntn;
    const int m0 = mt * 256, n0 = nt * 128;
    f32x4 acc[4][4];
#pragma unroll
    for (int i = 0; i < 4; ++i)
#pragma unroll
      for (int j = 0; j < 4; ++j) acc[i][j] = (f32x4){0.f, 0.f, 0.f, 0.f};
    uint4 ra0, ra1, rb;
#define GLOAD(ks_)                                                                           \
  {                                                                                          \
    const int s_ = (ks_) / kps;                                                              \
    const int kk_ = ((ks_) - s_ * kps) << 5;                                                 \
    const u16* Ap_ = s_ == 0 ? A0 : (s_ == 1 ? A1 : A2);                                     \
    const u16* Bp_ = s_ == 0 ? B0 : (s_ == 1 ? B1 : B2);                                     \
    const int sh_ = (shiftmask >> s_) & 1;                                                   \
    const int g0_ = m0 + lrow, g1_ = m0 + 128 + lrow;                                        \
    ra0 = (sh_ && (g0_ & 2047) == 0) ? make_uint4(0, 0, 0, 0) : *(const uint4*)(Ap_ + (size_t)(g0_ - sh_) * lda + kk_ + lkc); \
    ra1 = (sh_ && (g1_ & 2047) == 0) ? make_uint4(0, 0, 0, 0) : *(const uint4*)(Ap_ + (size_t)(g1_ - sh_) * lda + kk_ + lkc); \
    rb = *(const uint4*)(Bp_ + (size_t)(n0 + lrow) * ldb + kk_ + lkc);                       \
  }
#define LSTORE(buf_)                                                                         \
  {                                                                                          \
    *(uint4*)(As + ((buf_) * 256 + lrow) * LROW + lkc) = ra0;                                \
    *(uint4*)(As + ((buf_) * 256 + 128 + lrow) * LROW + lkc) = ra1;                          \
    *(uint4*)(Bs + ((buf_) * 128 + lrow) * LROW + lkc) = rb;                                 \
  }
    GLOAD(0);
    LSTORE(0);
    __syncthreads();
    for (int ks = 0; ks < nk; ++ks) {
      const int buf = ks & 1;
      if (ks + 1 < nk) GLOAD(ks + 1);
      bf16x8 af[4], bfr[4];
#pragma unroll
      for (int i = 0; i < 4; ++i) af[i] = *(const bf16x8*)(As + (buf * 256 + wr * 64 + i * 16 + fr) * LROW + fq * 8);
#pragma unroll
      for (int j = 0; j < 4; ++j) bfr[j] = *(const bf16x8*)(Bs + (buf * 128 + wc * 64 + j * 16 + fr) * LROW + fq * 8);
#pragma unroll
      for (int i = 0; i < 4; ++i)
#pragma unroll
        for (int j = 0; j < 4; ++j) acc[i][j] = mfma16(af[i], bfr[j], acc[i][j]);
      if (ks + 1 < nk) LSTORE(buf ^ 1);
      __syncthreads();
    }
#undef GLOAD
#undef LSTORE
    gemm_epilogue<EPI>(e, p, acc, m0 + wr * 64, n0 + wc * 64, nt, wc, fr, fq);
  }
}


namespace pg8 {
#define PG8_LAS __attribute__((address_space(3)))
typedef unsigned u32x4 __attribute__((ext_vector_type(4)));
constexpr int BM = 256, BK = 64, HALF = 128, HTB = HALF * BK * 2, NXCD = 8, WGM = 8;
__device__ __forceinline__ int lds_byte(int r, int c) { const int st = (r >> 4) * 2 + (c >> 5), rr = r & 15, cc = c & 31, ob = rr * 64 + cc * 2; return st * 1024 + (ob ^ (((ob >> 9) & 1) << 5)); }
__device__ __forceinline__ void stage_rc(int b, int& R, int& C) { const int st = b / 1024, sb = b % 1024, swz = sb ^ (((sb >> 9) & 1) << 5); R = (st >> 1) * 16 + swz / 64; C = (st & 1) * 32 + (swz % 64) / 2; }
__device__ __forceinline__ int perm32(int rho) { const int n = rho >> 4, i = rho & 15; return 8 * (i >> 2) + 4 * n + (i & 3); }
struct Unit { int pm, pn; };
struct GemmD { const u16 *A0, *A1, *A2, *B0, *B1, *B2; int lda, ldb, lgnts, nseg, M, N; };
struct StaticOrder {
  int nM, nN, nwg, G, c;
  __device__ void init(int M, int N, int G_, int c_) { nM = M / BM; nN = N / BM; nwg = nM * nN; G = G_; c = c_; }
  __device__ bool next(int i, Unit& u) const {
    const long L = (long)i * G + c; if (L >= nwg) return false;
    int wgid = (int)L; { const int q = nwg / NXCD, r = nwg % NXCD, xcd = wgid % NXCD, off = wgid / NXCD; wgid = (xcd < r ? xcd * (q + 1) : r * (q + 1) + (xcd - r) * q) + off; }
    const int nig = WGM * nN, gid = wgid / nig, fm = gid * WGM, gsz = (nM - fm) < WGM ? (nM - fm) : WGM;
    u.pm = fm + ((wgid % nig) % gsz); u.pn = (wgid % nig) / gsz; return true;
  }
};
__device__ __forceinline__ unsigned cvt_pk_bf16(float lo, float hi) { unsigned r; asm volatile("v_cvt_pk_bf16_f32 %0, %1, %2" : "=v"(r) : "v"(lo), "v"(hi)); return r; }

struct EpiPlain {
  static constexpr bool PERM = true;
  u16* O; int ldc; int nvalid;
  __device__ __forceinline__ void operator()(const f32x4 (&acc)[2][2][4][2], const Unit& u, int wr, int wc, int fr, int fq) const {
    asm volatile("" : "+v"(fr), "+v"(fq));
    const int row0 = u.pm * BM + wr * 64 + fr, col0 = u.pn * BM + wc * 32 + 8 * fq;
#pragma unroll
    for (int ai = 0; ai < 2; ++ai)
#pragma unroll
      for (int m = 0; m < 4; ++m) {
        u16* rowp = O + (size_t)(row0 + ai * HALF + m * 16) * ldc;
#pragma unroll
        for (int bj = 0; bj < 2; ++bj) {
          const int col = col0 + bj * HALF;
          if (col < nvalid) {
            const f32x4 v0 = acc[ai][bj][m][0], v1 = acc[ai][bj][m][1];
            u32x4 w; w.x = cvt_pk_bf16(v0[0], v0[1]); w.y = cvt_pk_bf16(v0[2], v0[3]); w.z = cvt_pk_bf16(v1[0], v1[1]); w.w = cvt_pk_bf16(v1[2], v1[3]);
            *(u32x4*)(rowp + col) = w;
          }
        }
      }
  }
};
template <bool IN16, bool OUT16>
struct EpiResid {
  static constexpr bool PERM = true;
  void* out; const void* xin; const float* mod;
  __device__ __forceinline__ void operator()(const f32x4 (&acc)[2][2][4][2], const Unit& u, int wr, int wc, int fr, int fq) const {
    asm volatile("" : "+v"(fr), "+v"(fq));
    const int row0 = u.pm * BM + wr * 64 + fr, col0 = u.pn * BM + wc * 32 + 8 * fq;
#pragma unroll
    for (int ai = 0; ai < 2; ++ai)
#pragma unroll
      for (int m = 0; m < 4; ++m) {
        const int row = row0 + ai * HALF + m * 16;
        const float* gp = mod + (size_t)(row >> 11) * 3072 + 2048;
#pragma unroll
        for (int bj = 0; bj < 2; ++bj) {
          const int col = col0 + bj * HALF;
          const size_t o = (size_t)row * 1024 + col;
          const f32x4 g0 = *(const f32x4*)(gp + col), g1 = *(const f32x4*)(gp + col + 4);
          f32x4 x0, x1;
          if (IN16) {
            const u32x4 xv = *(const u32x4*)((const u16*)xin + o);
            x0 = (f32x4){bflo(xv.x), bfhi(xv.x), bflo(xv.y), bfhi(xv.y)};
            x1 = (f32x4){bflo(xv.z), bfhi(xv.z), bflo(xv.w), bfhi(xv.w)};
          } else {
            x0 = *(const f32x4*)((const float*)xin + o); x1 = *(const f32x4*)((const float*)xin + o + 4);
          }
          const f32x4 y0 = x0 + g0 * acc[ai][bj][m][0], y1 = x1 + g1 * acc[ai][bj][m][1];
          if (OUT16) {
            u32x4 w; w.x = cvt_pk_bf16(y0[0], y0[1]); w.y = cvt_pk_bf16(y0[2], y0[3]); w.z = cvt_pk_bf16(y1[0], y1[1]); w.w = cvt_pk_bf16(y1[2], y1[3]);
            *(u32x4*)((u16*)out + o) = w;
          } else {
            *(f32x4*)((float*)out + o) = y0; *(f32x4*)((float*)out + o + 4) = y1;
          }
        }
      }
  }
};
struct EpiDsaMain {
  static constexpr bool PERM = true;
  u16* O; const float* qg; const float* kg; const float2* rope; u16* VT;
  __device__ __forceinline__ void operator()(const f32x4 (&acc)[2][2][4][2], const Unit& u, int wr, int wc, int fr, int fq) const {
    asm volatile("" : "+v"(fr), "+v"(fq));
    const int row0 = u.pm * BM + wr * 64 + fr;
    if (u.pn <= 4) {
      const float* gain = (u.pn < 4) ? qg : kg;
      const int cb = u.pn * 256 + wc * 64 + 8 * fq;
#pragma unroll
      for (int ai = 0; ai < 2; ++ai)
#pragma unroll
        for (int m = 0; m < 4; ++m) {
          const int row = row0 + ai * HALF + m * 16;
          float ss = 0.f;
#pragma unroll
          for (int n = 0; n < 2; ++n)
#pragma unroll
            for (int j = 0; j < 4; ++j) { const float x = acc[ai][0][m][n][j], y = acc[ai][1][m][n][j]; ss += x * x + y * y; }
          ss += __shfl_xor(ss, 16); ss += __shfl_xor(ss, 32);
          const float rstd = rsqrtf(ss * (1.f / 64.f) + 1e-6f);
          const float2* rp = rope + (row & 2047) * 32 + 8 * fq;
          u16* d = O + (size_t)row * 2560 + cb;
#pragma unroll
          for (int n = 0; n < 2; ++n) {
            float ol[4], oh[4];
#pragma unroll
            for (int j = 0; j < 4; ++j) {
              const int e = 4 * n + j;
              const float2 cs = rp[e];
              const float xn = acc[ai][0][m][n][j] * rstd * gain[8 * fq + e], yn = acc[ai][1][m][n][j] * rstd * gain[32 + 8 * fq + e];
              ol[j] = xn * cs.x - yn * cs.y; oh[j] = yn * cs.x + xn * cs.y;
            }
            uint2 w; w.x = cvt_pk_bf16(ol[0], ol[1]); w.y = cvt_pk_bf16(ol[2], ol[3]);
            *(uint2*)(d + 4 * n) = w;
            w.x = cvt_pk_bf16(oh[0], oh[1]); w.y = cvt_pk_bf16(oh[2], oh[3]);
            *(uint2*)(d + 32 + 4 * n) = w;
          }
        }
    } else if (u.pn == 5) {
#pragma unroll
      for (int ai = 0; ai < 2; ++ai)
#pragma unroll
        for (int m = 0; m < 4; ++m) {
          const int row = row0 + ai * HALF + m * 16;
          u16* vb = VT + (size_t)(row >> 11) * 256 * 2048 + (row & 2047);
#pragma unroll
          for (int bj = 0; bj < 2; ++bj)
#pragma unroll
            for (int n = 0; n < 2; ++n)
#pragma unroll
              for (int j = 0; j < 4; ++j) vb[(size_t)(128 * bj + 32 * wc + 8 * fq + 4 * n + j) * 2048] = f2bf(acc[ai][bj][m][n][j]);
        }
    } else {
      const int col0 = u.pn * BM + wc * 32 + 8 * fq;
#pragma unroll
      for (int ai = 0; ai < 2; ++ai)
#pragma unroll
        for (int m = 0; m < 4; ++m) {
          u16* rowp = O + (size_t)(row0 + ai * HALF + m * 16) * 2560 + col0;
#pragma unroll
          for (int bj = 0; bj < 2; ++bj) {
            const f32x4 v0 = acc[ai][bj][m][0], v1 = acc[ai][bj][m][1];
            u32x4 w; w.x = cvt_pk_bf16(v0[0], v0[1]); w.y = cvt_pk_bf16(v0[2], v0[3]); w.z = cvt_pk_bf16(v1[0], v1[1]); w.w = cvt_pk_bf16(v1[2], v1[3]);
            *(u32x4*)(rowp + bj * HALF) = w;
          }
        }
    }
  }
};
struct EpiDsaIdx {
  static constexpr bool PERM = true;
  u16 *qh, *ql, *kh, *kl; float* wi; const float2* rope;
  __device__ __forceinline__ void operator()(const f32x4 (&acc)[2][2][4][2], const Unit& u, int wr, int wc, int fr, int fq) const {
    asm volatile("" : "+v"(fr), "+v"(fq));
    const int row0 = u.pm * BM + wr * 64 + fr;
    if (u.pn < 4 || wc < 2) {
      const int dl = 32 * (wc & 1) + 8 * fq;
      u16* dh; size_t ld; int cb;
      if (u.pn < 4) { dh = qh; ld = 1024; cb = (u.pn * 2 + (wc >> 1)) * 128 + dl; }
      else { dh = kh; ld = 128; cb = dl; }
#pragma unroll
      for (int ai = 0; ai < 2; ++ai)
#pragma unroll
        for (int m = 0; m < 4; ++m) {
          const int row = row0 + ai * HALF + m * 16;
          const float2* rp = rope + (row & 2047) * 64 + dl;
          const size_t o = (size_t)row * ld + cb;
#pragma unroll
          for (int n = 0; n < 2; ++n) {
            float o1[4], o2[4];
#pragma unroll
            for (int j = 0; j < 4; ++j) {
              const float2 cs = rp[4 * n + j];
              const float x = acc[ai][0][m][n][j], y = acc[ai][1][m][n][j];
              o1[j] = x * cs.x - y * cs.y; o2[j] = y * cs.x + x * cs.y;
            }
            uint2 h1, h2;
            h1.x = packh2(o1[0], o1[1]); h1.y = packh2(o1[2], o1[3]);
            h2.x = packh2(o2[0], o2[1]); h2.y = packh2(o2[2], o2[3]);
            *(uint2*)(dh + o + 4 * n) = h1; *(uint2*)(dh + o + 64 + 4 * n) = h2;
          }
        }
    } else if (wc == 2 && fq == 0) {
#pragma unroll
      for (int ai = 0; ai < 2; ++ai)
#pragma unroll
        for (int m = 0; m < 4; ++m) {
          const int row = row0 + ai * HALF + m * 16;
          *(f32x4*)(wi + (size_t)row * 8) = acc[ai][0][m][0] * 0.03125f;
          *(f32x4*)(wi + (size_t)row * 8 + 4) = acc[ai][0][m][1] * 0.03125f;
        }
    }
  }
};

template <class Epi, bool F16>
__device__ __forceinline__ void gemm_phase(PG8_LAS unsigned char* lds, const GemmD g, const StaticOrder& S, const Epi& E) {
  const int tid = tid_(), wid = __builtin_amdgcn_readfirstlane(tid >> 6), lane = tid & 63, wr = wid >> 2, wc = wid & 3, fr = lane & 15, fq = lane >> 4;
  const int lg = g.lgnts, nts = 1 << lg, nt = nts * g.nseg;
  unsigned voffA[2], voffB[2];
#pragma unroll
  for (int i = 0; i < 2; ++i) { int R, C; stage_rc(tid * 16 + i * 8192, R, C); const int Rb = Epi::PERM ? ((R & ~31) + perm32(R & 31)) : R;
    voffA[i] = (unsigned)(R * g.lda + C) * 2u; voffB[i] = (unsigned)(Rb * g.ldb + C) * 2u; }
  const size_t kstep = (size_t)(BK * 2);
  const size_t hstepA = (size_t)HALF * g.lda * 2, hstepB = (size_t)HALF * g.ldb * 2;
  const size_t tstepA = 2 * hstepA, tstepB = 2 * hstepB;
  const unsigned ldsw = (unsigned)wid * 1024u;
  const int aoff = lds_byte(wr * 64 + fr, fq * 8), boff = lds_byte(wc * 32 + fr, fq * 8);
#define PG8_APTR(pm_, t_) ((const char*)((((t_) >> lg) == 0) ? g.A0 : ((((t_) >> lg) == 1) ? g.A1 : g.A2)) + (size_t)(pm_) * tstepA + (size_t)((t_) & (nts - 1)) * kstep)
#define PG8_BPTR(pn_, t_) ((const char*)((((t_) >> lg) == 0) ? g.B0 : ((((t_) >> lg) == 1) ? g.B1 : g.B2)) + (size_t)(pn_) * tstepB + (size_t)((t_) & (nts - 1)) * kstep)
#define PG8_SA(b, h) (((b) * 2 + (h)) * HTB)
#define PG8_SB(b, h) ((4 + (b) * 2 + (h)) * HTB)
#define PG8_STAGE(bufoff, gbase, voff) do { _Pragma("unroll") for (int _i = 0; _i < 2; ++_i) \
    __builtin_amdgcn_global_load_lds((const unsigned*)((const char*)(gbase) + (voff)[_i]), (PG8_LAS unsigned*)(lds + (bufoff) + ldsw + _i * 8192), 16, 0, 0); } while (0)
#define PG8_LDA(dst, b, h) do { _Pragma("unroll") for (int m = 0; m < 4; ++m) _Pragma("unroll") for (int k = 0; k < 2; ++k) dst[m][k] = *(const PG8_LAS bf16x8*)(lds + PG8_SA(b, h) + aoff + m * 2048 + k * 1024); } while (0)
#define PG8_LDB(dst, b, h) do { _Pragma("unroll") for (int n = 0; n < 2; ++n) _Pragma("unroll") for (int k = 0; k < 2; ++k) dst[n][k] = *(const PG8_LAS bf16x8*)(lds + PG8_SB(b, h) + boff + n * 2048 + k * 1024); } while (0)
#define PG8_MMA(ai, bj, At, Bt) do { __builtin_amdgcn_s_setprio(1); _Pragma("unroll") for (int m = 0; m < 4; ++m) _Pragma("unroll") for (int n = 0; n < 2; ++n) _Pragma("unroll") for (int k = 0; k < 2; ++k) \
    acc[ai][bj][m][n] = F16 ? mfma16h(Bt[n][k], At[m][k], acc[ai][bj][m][n]) : __builtin_amdgcn_mfma_f32_16x16x32_bf16(Bt[n][k], At[m][k], acc[ai][bj][m][n], 0, 0, 0); __builtin_amdgcn_s_setprio(0); } while (0)
#define PG8_WAIT_V(n) asm volatile("s_waitcnt vmcnt(" #n ")" ::: "memory")
#define PG8_WAIT_L(n) asm volatile("s_waitcnt lgkmcnt(" #n ")" ::: "memory")
#define PG8_BAR __builtin_amdgcn_s_barrier()
#define PG8_SCHED __builtin_amdgcn_sched_barrier(0)
  Unit cur, nxt; int ui = 0;
  if (!S.next(0, cur)) return;
  f32x4 acc[2][2][4][2];
#pragma unroll
  for (int a = 0; a < 2; ++a)
#pragma unroll
    for (int b = 0; b < 2; ++b)
#pragma unroll
      for (int m = 0; m < 4; ++m)
#pragma unroll
        for (int n = 0; n < 2; ++n) acc[a][b][m][n] = (f32x4){0.f, 0.f, 0.f, 0.f};
  bf16x8 At[4][2], B0[2][2], B1[2][2];
  {
    const char* cA = PG8_APTR(cur.pm, 0); const char* cB = PG8_BPTR(cur.pn, 0);
    PG8_STAGE(PG8_SB(0, 0), cB, voffB); PG8_STAGE(PG8_SA(0, 0), cA, voffA); PG8_STAGE(PG8_SB(0, 1), cB + hstepB, voffB); PG8_STAGE(PG8_SA(0, 1), cA + hstepA, voffA);
    if (wr == 1) PG8_BAR;
    PG8_WAIT_V(4); PG8_BAR;
    PG8_STAGE(PG8_SB(1, 0), cB + kstep, voffB); PG8_STAGE(PG8_SA(1, 0), cA + kstep, voffA); PG8_STAGE(PG8_SB(1, 1), cB + hstepB + kstep, voffB);
    PG8_WAIT_V(6); PG8_BAR;
  }
  for (;;) {
    const bool has_next = S.next(ui + 1, nxt);
    const int npm = has_next ? nxt.pm : cur.pm, npn = has_next ? nxt.pn : cur.pn;
    for (int t = 0; t < nt; t += 2) {
      const bool last = (t == nt - 2);
      const char* a1 = PG8_APTR(cur.pm, t + 1);
      const char* a2 = last ? PG8_APTR(npm, 0) : PG8_APTR(cur.pm, t + 2);
      const char* b2 = last ? PG8_BPTR(npn, 0) : PG8_BPTR(cur.pn, t + 2);
      const char* a3 = a2 + kstep; const char* b3 = b2 + kstep;
      PG8_LDB(B0, 0, 0); PG8_SCHED; PG8_LDA(At, 0, 0); PG8_STAGE(PG8_SA(1, 1), a1 + hstepA, voffA);
      PG8_WAIT_L(8); PG8_BAR; PG8_WAIT_L(0); PG8_MMA(0, 0, At, B0); PG8_BAR; PG8_SCHED;
      PG8_LDB(B1, 0, 1); PG8_STAGE(PG8_SB(0, 0), b2, voffB);
      PG8_BAR; PG8_WAIT_L(0); PG8_MMA(0, 1, At, B1); PG8_BAR;
      PG8_LDA(At, 0, 1); PG8_STAGE(PG8_SA(0, 0), a2, voffA);
      PG8_BAR; PG8_WAIT_L(0); PG8_MMA(1, 0, At, B0); PG8_BAR; PG8_SCHED;
      PG8_STAGE(PG8_SB(0, 1), b2 + hstepB, voffB);
      PG8_WAIT_V(6); PG8_BAR; PG8_MMA(1, 1, At, B1); PG8_BAR;
      PG8_LDB(B0, 1, 0); PG8_SCHED; PG8_LDA(At, 1, 0); PG8_STAGE(PG8_SA(0, 1), a2 + hstepA, voffA);
      PG8_WAIT_L(8); PG8_BAR; PG8_WAIT_L(0); PG8_MMA(0, 0, At, B0); PG8_BAR; PG8_SCHED;
      PG8_LDB(B1, 1, 1); PG8_STAGE(PG8_SB(1, 0), b3, voffB);
      PG8_BAR; PG8_WAIT_L(0); PG8_MMA(0, 1, At, B1); PG8_BAR;
      PG8_LDA(At, 1, 1); PG8_STAGE(PG8_SA(1, 0), a3, voffA);
      PG8_BAR; PG8_WAIT_L(0); PG8_MMA(1, 0, At, B0); PG8_BAR; PG8_SCHED;
      PG8_STAGE(PG8_SB(1, 1), b3 + hstepB, voffB);
      PG8_WAIT_V(6); PG8_BAR; PG8_MMA(1, 1, At, B1); PG8_BAR;
    }
    E(acc, cur, wr, wc, fr, fq);
    if (!has_next) break;
#pragma unroll
    for (int a = 0; a < 2; ++a)
#pragma unroll
      for (int b = 0; b < 2; ++b)
#pragma unroll
        for (int m = 0; m < 4; ++m)
#pragma unroll
          for (int n = 0; n < 2; ++n) acc[a][b][m][n] = (f32x4){0.f, 0.f, 0.f, 0.f};
    cur = nxt; ++ui;
  }
  PG8_WAIT_V(0);
  if (wr == 0) PG8_BAR;
  PG8_BAR;
#undef PG8_APTR
#undef PG8_BPTR
#undef PG8_SA
#undef PG8_SB
#undef PG8_STAGE
#undef PG8_LDA
#undef PG8_LDB
#undef PG8_MMA
#undef PG8_WAIT_V
#undef PG8_WAIT_L
#undef PG8_BAR
#undef PG8_SCHED
}
template <class Epi, bool F16 = false>
__device__ __forceinline__ void run(char* lds, const u16* A0, const u16* A1, const u16* A2, const u16* B0, const u16* B1, const u16* B2,
                                    int lda, int ldb, int lgnts, int nseg, int N, const Epi& E) {
  GemmD g; g.A0 = A0; g.A1 = A1; g.A2 = A2; g.B0 = B0; g.B1 = B1; g.B2 = B2; g.lda = lda; g.ldb = ldb; g.lgnts = lgnts; g.nseg = nseg; g.M = T_; g.N = N;
  StaticOrder S; S.init(T_, N, (int)gridDim.x, (int)blockIdx.x);
  gemm_phase<Epi, F16>((PG8_LAS unsigned char*)lds, g, S, E);
}
}


template <int NE>
__device__ __forceinline__ void topk_row(const float* __restrict__ srow, int qpos, int lane, unsigned* __restrict__ mrow) {
  unsigned uk[NE];
#pragma unroll
  for (int e = 0; e < NE; ++e) {
    const int key = e * 64 + lane;
    const float v = srow[key];
    unsigned uu = __float_as_uint(v);
    uu = (uu & 0x80000000u) ? ~uu : (uu | 0x80000000u);
    uk[e] = (key <= qpos) ? uu : 0u;
  }
  unsigned prefix = 0u;
  for (int bit = 31; bit >= 0; --bit) {
    const unsigned cand = prefix | (1u << bit);
    int cnt = 0;
#pragma unroll
    for (int e = 0; e < NE; ++e) cnt += __popcll(__ballot(uk[e] >= cand));
    if (cnt >= 256) { prefix = cand; if (cnt == 256) break; }
  }
  int cgt = 0;
#pragma unroll
  for (int e = 0; e < NE; ++e) cgt += __popcll(__ballot(uk[e] > prefix));
  const int need = 256 - cgt;
  int eqused = 0;
  const unsigned long long lt = (1ull << lane) - 1ull;
#pragma unroll
  for (int e = 0; e < NE; ++e) {
    const bool gt = uk[e] > prefix, eq = uk[e] == prefix;
    const unsigned long long meq = __ballot(eq);
    const bool take = gt || (eq && (eqused + __popcll(meq & lt)) < need);
    const unsigned long long ms = __ballot(take);
    if (lane == 0) { mrow[2 * e] = (unsigned)ms; mrow[2 * e + 1] = (unsigned)(ms >> 32); }
    eqused += __popcll(meq);
  }
}

__device__ __forceinline__ void dsa_unit_phase(const PAcc& p, char* lds, bool st) {
  u16* qihi = (u16*)lds;
  unsigned* MASK = (unsigned*)lds;
  const u16* VT = (const u16*)(p.pp->ws + DSA_VT);
  float* wis = (float*)(lds + 73728);
  u16* QKVG = (u16*)(p.pp->ws + DSA_QKVG);
  const u16* QIH = (const u16*)(p.pp->ws + DSA_QIHI);
  const u16* KIH = (const u16*)(p.pp->ws + DSA_KIHI);
  const float* WI = (const float*)(p.pp->ws + DSA_WI);
  float* scr = (float*)(p.pp->ws + DSA_SCR) + (size_t)blockIdx.x * 16 * 2048;

  const bool xmap = (gridDim.x == 256);
  for (int u = blockIdx.x; u < 2048; u += gridDim.x) {
    const int tid = tid_(), lane = tid & 63, wave = tid >> 6, fr = lane & 15, fq = lane >> 4;
    int qt, b;
    if (xmap) { const int v = (blockIdx.x >> 3) + 32 * (u >> 8); b = 2 * (blockIdx.x & 7) + (v & 1); qt = 127 - (v >> 1); }
    else { qt = 127 - (u >> 4); b = u & 15; }
    const int q0 = qt * 16;
    const size_t tok0 = (size_t)b * 2048 + q0;
    const bool full = (q0 < 256);
    if (!full) {
#pragma unroll
      for (int i = 0; i < 4; ++i) {
        const int c = tid + i * NTHR;
        const int row = c >> 7, ch = c & 127;
        *(uint4*)(qihi + row * 1032 + ch * 8) = *(const uint4*)(QIH + (tok0 + row) * 1024 + ch * 8);
      }
      if (tid < 128) wis[tid] = WI[tok0 * 8 + tid];
      __syncthreads();
      const int nkeys = q0 + 16;
      const int nch = (nkeys + 31) >> 5;
      for (int rep_ = 0; rep_ < ((DUP == 6) ? 2 : 1); ++rep_)
      for (int c = wave; c < nch; c += 8) {
        const int kbase = c * 32;
        bf16x8 khi[2][4];
#pragma unroll
        for (int mt = 0; mt < 2; ++mt)
#pragma unroll
          for (int ks = 0; ks < 4; ++ks) {
            const size_t o = ((size_t)b * 2048 + kbase + mt * 16 + fr) * 128 + ks * 32 + fq * 8;
            khi[mt][ks] = *(const bf16x8*)(KIH + o);
          }
        f32x4 sc[2];
        sc[0] = (f32x4){0.f, 0.f, 0.f, 0.f}; sc[1] = sc[0];
#pragma unroll 1
        for (int h = 0; h < 8; ++h) {
          const float wv = wis[fr * 8 + h];
          f32x4 lg[2];
          lg[0] = (f32x4){0.f, 0.f, 0.f, 0.f}; lg[1] = lg[0];
#pragma unroll
          for (int ks = 0; ks < 4; ++ks) {
            const bf16x8 bh = *(const bf16x8*)(qihi + fr * 1032 + h * 128 + ks * 32 + fq * 8);
#pragma unroll
            for (int mt = 0; mt < 2; ++mt) {
              lg[mt] = mfma16h(khi[mt][ks], bh, lg[mt]);
            }
          }
#pragma unroll
          for (int mt = 0; mt < 2; ++mt)
#pragma unroll
            for (int r = 0; r < 4; ++r) sc[mt][r] += wv * fmaxf(lg[mt][r], 0.f);
        }
#pragma unroll
        for (int mt = 0; mt < 2; ++mt) *(f32x4*)(scr + fr * 2048 + kbase + mt * 16 + fq * 4) = sc[mt];
      }
    }
    __syncthreads();
    u16* QF = (u16*)(lds + 81920);
#pragma unroll
    for (int i = 0; i < 4; ++i) {
      const int c = tid + i * NTHR;
      const int row = c >> 7, ch = c & 127;
      *(uint4*)(QF + row * 1032 + ch * 8) = *(const uint4*)(QKVG + (tok0 + row) * 2560 + ch * 8);
    }
#pragma unroll 1
    for (int qi2 = 0; qi2 < ((DUP == 7) ? 4 : 2); ++qi2) {
      const int qq = wave * 2 + (qi2 & 1);
      const int qpos = q0 + qq;
      if (!full) {
        const int ng = ((q0 + 15) >> 8) + 1;
        const float* sr = scr + qq * 2048; unsigned* mr = MASK + qq * 64;
        switch (ng) {
          case 2: topk_row<8>(sr, qpos, lane, mr); break;
          case 3: topk_row<12>(sr, qpos, lane, mr); break;
          case 4: topk_row<16>(sr, qpos, lane, mr); break;
          case 5: topk_row<20>(sr, qpos, lane, mr); break;
          case 6: topk_row<24>(sr, qpos, lane, mr); break;
          case 7: topk_row<28>(sr, qpos, lane, mr); break;
          default: topk_row<32>(sr, qpos, lane, mr); break;
        }
      } else {
#pragma unroll
        for (int e = 0; e < 32; ++e) {
          const unsigned long long ms = __ballot((e * 64 + lane) <= qpos);
          if (lane == 0) { MASK[qq * 64 + 2 * e] = (unsigned)ms; MASK[qq * 64 + 2 * e + 1] = (unsigned)(ms >> 32); }
        }
      }
    }
    __syncthreads();
    {
      int fr_a = fr, fq_a = fq, lane_a = lane;
      asm volatile("" : "+v"(fr_a), "+v"(fq_a), "+v"(lane_a));
#define fr fr_a
#define fq fq_a
#define lane lane_a
      const int g = wave >> 1, half = wave & 1;
      float mq = fabsf(p.pp->in[6][lane]), mk = fabsf(p.pp->in[7][lane]);
#pragma unroll
      for (int mm = 32; mm >= 1; mm >>= 1) { mq = fmaxf(mq, __shfl_xor(mq, mm)); mk = fmaxf(mk, __shfl_xor(mk, mm)); }
      const float shift = 8.f * mq * mk; const float nshift2 = -shift * 1.44269504089f;
      const u16* qfp = QF + fr * 1032 + g * 256 + fq * 8;
      f32x4 o[4][4];
#pragma unroll
      for (int rr = 0; rr < 4; ++rr)
#pragma unroll
        for (int mt = 0; mt < 4; ++mt) o[rr][mt] = (f32x4){0.f, 0.f, 0.f, 0.f};
      float lsum[4] = {0.f, 0.f, 0.f, 0.f};
      const u16* Kb = QKVG + (size_t)b * 2048 * 2560 + 1024 + g * 64 + fq * 8 + (size_t)(8 * (fr >> 2) + (fr & 3)) * 2560;
      const u16* Vb = VT + (size_t)(b * 256 + g * 64 + fr) * 2048 + 8 * fq;
      const int nb = (q0 + 16 + 31) >> 5;
      bf16x8 kf[2][2], vf[4];
      {
        const int k0 = (half < nb ? half : 0) * 32;
#pragma unroll
        for (int s2 = 0; s2 < 2; ++s2)
#pragma unroll
          for (int ks = 0; ks < 2; ++ks) kf[s2][ks] = *(const bf16x8*)(Kb + (size_t)(k0 + 4 * s2) * 2560 + ks * 32);
#pragma unroll
        for (int mt = 0; mt < 4; ++mt) vf[mt] = *(const bf16x8*)(Vb + (size_t)mt * 16 * 2048 + k0);
      }
#pragma unroll 1
      for (int blk = half; blk < nb; blk += 2) {
        bf16x8 kn[2][2], vn[4];
        const int nx = (blk + 2 < nb) ? (blk + 2) * 32 : blk * 32;
#pragma unroll
        for (int s2 = 0; s2 < 2; ++s2)
#pragma unroll
          for (int ks = 0; ks < 2; ++ks) kn[s2][ks] = *(const bf16x8*)(Kb + (size_t)(nx + 4 * s2) * 2560 + ks * 32);
#pragma unroll
        for (int mt = 0; mt < 4; ++mt) vn[mt] = *(const bf16x8*)(Vb + (size_t)mt * 16 * 2048 + nx);
        const unsigned mw = MASK[fr * 64 + blk] >> (8 * fq);
        f32x4 mf[2];
#pragma unroll
        for (int s2 = 0; s2 < 2; ++s2)
#pragma unroll
          for (int r = 0; r < 4; ++r) mf[s2][r] = (float)((mw >> (4 * s2 + r)) & 1u);
#pragma unroll
        for (int rr = 0; rr < 4; ++rr) {
          float pv[8];
          f32x4 pq[2];
#pragma unroll
          for (int s2 = 0; s2 < 2; ++s2) {
            f32x4 stv = (f32x4){0.f, 0.f, 0.f, 0.f};
            stv = mfma16(kf[s2][0], *(const bf16x8*)(qfp + rr * 64), stv);
            stv = mfma16(kf[s2][1], *(const bf16x8*)(qfp + rr * 64 + 32), stv);
            stv = stv * (0.125f * 1.44269504089f) + nshift2;
#pragma unroll
            for (int r = 0; r < 4; ++r) stv[r] = __builtin_amdgcn_exp2f(stv[r]);
            pq[s2] = stv * mf[s2];
          }
          {
            const f32x4 sm_ = pq[0] + pq[1];
            lsum[rr] += (sm_[0] + sm_[1]) + (sm_[2] + sm_[3]);
          }
#pragma unroll
          for (int r = 0; r < 4; ++r) { pv[r] = pq[0][r]; pv[4 + r] = pq[1][r]; }
          union { bf16x8 v; unsigned w[4]; } pk;
          pk.w[0] = pg8::cvt_pk_bf16(pv[0], pv[1]); pk.w[1] = pg8::cvt_pk_bf16(pv[2], pv[3]);
          pk.w[2] = pg8::cvt_pk_bf16(pv[4], pv[5]); pk.w[3] = pg8::cvt_pk_bf16(pv[6], pv[7]);
#pragma unroll
          for (int mt = 0; mt < 4; ++mt) o[rr][mt] = mfma16(vf[mt], pk.v, o[rr][mt]);
        }
#pragma unroll
        for (int s2 = 0; s2 < 2; ++s2)
#pragma unroll
          for (int ks = 0; ks < 2; ++ks) kf[s2][ks] = kn[s2][ks];
#pragma unroll
        for (int mt = 0; mt < 4; ++mt) vf[mt] = vn[mt];
      }
      float* CB = (float*)(lds + 8192) + (size_t)g * 68 * 64 + lane;
      if (half == 1) {
#pragma unroll
        for (int rr = 0; rr < 4; ++rr) {
#pragma unroll
          for (int mt = 0; mt < 4; ++mt)
#pragma unroll
            for (int r = 0; r < 4; ++r) CB[((rr * 4 + mt) * 4 + r) * 64] = o[rr][mt][r];
          CB[(64 + rr) * 64] = lsum[rr];
        }
      }
      __syncthreads();
      if (half == 0) {
#pragma unroll
        for (int rr = 0; rr < 4; ++rr) {
          float l = lsum[rr] + CB[(64 + rr) * 64];
          l += __shfl_xor(l, 16); l += __shfl_xor(l, 32);
          const float inv = 1.f / l;
          const int h = g * 4 + rr;
#pragma unroll
          for (int mt = 0; mt < 4; ++mt) {
            u16* op = QKVG + (tok0 + fr) * 2560 + h * 64 + mt * 16 + fq * 4;
            const uint2 gg = *(const uint2*)(op + 1536);
            const float v0 = o[rr][mt][0] + CB[((rr * 4 + mt) * 4 + 0) * 64], v1 = o[rr][mt][1] + CB[((rr * 4 + mt) * 4 + 1) * 64];
            const float v2 = o[rr][mt][2] + CB[((rr * 4 + mt) * 4 + 2) * 64], v3 = o[rr][mt][3] + CB[((rr * 4 + mt) * 4 + 3) * 64];
            uint2 w;
            w.x = pg8::cvt_pk_bf16(v0 * inv * silu_(bflo(gg.x)), v1 * inv * silu_(bfhi(gg.x)));
            w.y = pg8::cvt_pk_bf16(v2 * inv * silu_(bflo(gg.y)), v3 * inv * silu_(bfhi(gg.y)));
            if (st) *(uint2*)op = w;
          }
        }
      }
#undef fr
#undef fq
#undef lane
    }
    __syncthreads();
  }
}

__device__ __forceinline__ void lru_gate_phase(const PAcc& p, char* lds) {
  const int tid = tid_(), lane = tid & 63, wave = tid >> 6;
  const int wr = wave >> 1, wc = wave & 1, fr = lane & 15, fq = lane >> 4;
  float* UC = (float*)lds;
  u16* Al = (u16*)(lds + 256 * 65 * 4);
  u16* Bl = Al + 256 * 72;
  const u16* UG = (const u16*)(p.pp->ws + LRU_UG);
  const u16* WG = (const u16*)(p.pp->ws + WS_WT) + W_LRU_GATE;
  float* LA = (float*)(p.pp->ws + LRU_A);
  float* LB = (float*)(p.pp->ws + LRU_B);
  for (int unit = blockIdx.x; unit < 2048; unit += gridDim.x) {
    const int n = unit & 15, mt = unit >> 4;
    const int m0 = mt * 256;
    {
      const int c = tid & 63, rg = tid >> 6;
      const int ch = n * 64 + c;
      const float w0 = p.pp->in[10][ch], w1 = p.pp->in[10][1024 + ch], w2 = p.pp->in[10][2048 + ch], w3 = p.pp->in[10][3072 + ch];
      const float cb = p.pp->in[11][ch];
      const int r0 = rg * 32;
      const int g0 = m0 + r0;
      float u3 = ((g0 & 2047) >= 3) ? bf2f(UG[(size_t)(g0 - 3) * 2048 + ch]) : 0.f;
      float u2 = ((g0 & 2047) >= 2) ? bf2f(UG[(size_t)(g0 - 2) * 2048 + ch]) : 0.f;
      float u1 = ((g0 & 2047) >= 1) ? bf2f(UG[(size_t)(g0 - 1) * 2048 + ch]) : 0.f;
#pragma unroll 8
      for (int r = 0; r < 32; ++r) {
        const float u0 = bf2f(UG[(size_t)(g0 + r) * 2048 + ch]);
        const float v = w0 * u3 + w1 * u2 + w2 * u1 + w3 * u0 + cb;
        UC[(r0 + r) * 65 + c] = v;
        Al[(r0 + r) * 72 + c] = f2bf(v);
        u3 = u2; u2 = u1; u1 = u0;
      }
#pragma unroll
      for (int i = 0; i < 2; ++i) {
        const int cidx = tid + i * NTHR;
        const int row = cidx >> 3, kc = (cidx & 7) * 8;
        *(uint4*)(Bl + row * 72 + kc) = *(const uint4*)(WG + (size_t)n * 8192 + row * 64 + kc);
      }
    }
    __syncthreads();
    f32x4 acc[4][4];
#pragma unroll
    for (int i = 0; i < 4; ++i)
#pragma unroll
      for (int j = 0; j < 4; ++j) acc[i][j] = (f32x4){0.f, 0.f, 0.f, 0.f};
#pragma unroll
    for (int ks = 0; ks < 2; ++ks) {
      bf16x8 af[4], bfr[4];
#pragma unroll
      for (int i = 0; i < 4; ++i) af[i] = *(const bf16x8*)(Al + (wr * 64 + i * 16 + fr) * 72 + ks * 32 + fq * 8);
#pragma unroll
      for (int j = 0; j < 4; ++j) bfr[j] = *(const bf16x8*)(Bl + (wc * 64 + j * 16 + fr) * 72 + ks * 32 + fq * 8);
#pragma unroll
      for (int i = 0; i < 4; ++i)
#pragma unroll
        for (int j = 0; j < 4; ++j) acc[i][j] = mfma16(af[i], bfr[j], acc[i][j]);
    }
#pragma unroll
    for (int jj = 0; jj < 2; ++jj) {
      const int d = wc * 32 + jj * 16 + fr;
      const int ch = n * 64 + d;
      const float ba = p.pp->in[13][ch], bx = p.pp->in[15][ch];
      const float spl = softplus_(-p.pp->in[16][ch]);
#pragma unroll
      for (int i = 0; i < 4; ++i)
#pragma unroll
        for (int r = 0; r < 4; ++r) {
          const int row = wr * 64 + i * 16 + fq * 4 + r;
          const float rr = sigmoid_(acc[i][jj * 2][r] + ba);
          const float ig = sigmoid_(acc[i][jj * 2 + 1][r] + bx);
          const float log_a = -8.f * rr * spl;
          const float a = __expf(log_a);
          const float bb = sqrtf(fmaxf(-expm1f(2.f * log_a), 0.f)) * (ig * UC[row * 65 + d]);
          const size_t o = (size_t)(m0 + row) * 1024 + ch;
          LA[o] = a; LB[o] = bb;
        }
    }
    __syncthreads();
  }
}


__device__ __forceinline__ void lru_fused_phase(const PAcc& p, char* lds) {
  const int tid = tid_(), lane = tid & 63, wave = tid >> 6;
  const int wr = wave >> 1, wc = wave & 1, fr = lane & 15, fq = lane >> 4;
  float* UB = (float*)lds;
  float* AA = UB + 128 * 65;
  u16* Al = (u16*)(AA + 128 * 65);
  u16* Bl = Al + 128 * 72;
  float* sA = (float*)(Bl + 128 * 72);
  float* sB = sA + 512;
  float* Hc = sB + 512;
  const u16* UG = (const u16*)(p.pp->ws + LRU_UG);
  const u16* WG = (const u16*)(p.pp->ws + WS_WT) + W_LRU_GATE;
  u16* OG = (u16*)(p.pp->ws + WS_H);
  const int c = tid & 63, rg = tid >> 6;
  for (int unit = blockIdx.x; unit < 256; unit += gridDim.x) {
    const int b = unit >> 4, n = unit & 15;
    const int ch = n * 64 + c;
    const float w0 = p.pp->in[10][ch], w1 = p.pp->in[10][1024 + ch], w2 = p.pp->in[10][2048 + ch], w3 = p.pp->in[10][3072 + ch];
    const float cb = p.pp->in[11][ch];
#pragma unroll
    for (int i = 0; i < 2; ++i) {
      const int cidx = tid + i * NTHR;
      const int row = cidx >> 3, kc = (cidx & 7) * 8;
      *(uint4*)(Bl + row * 72 + kc) = *(const uint4*)(WG + (size_t)n * 8192 + row * 64 + kc);
    }
    if (tid < 64) Hc[tid] = 0.f;
    float ba[2], bx[2], spl[2];
#pragma unroll
    for (int jj = 0; jj < 2; ++jj) {
      const int dch = n * 64 + wc * 32 + jj * 16 + fr;
      ba[jj] = p.pp->in[13][dch]; bx[jj] = p.pp->in[15][dch]; spl[jj] = softplus_(-p.pp->in[16][dch]);
    }
    u16 un[19], gn[16];
#define LRU_LOAD(mt_)                                                                      \
    { const size_t g0_ = (size_t)b * 2048 + (mt_) * 128 + rg * 16;                         \
      const int pos0_ = (mt_) * 128 + rg * 16;                                             \
      _Pragma("unroll") for (int r = 0; r < 3; ++r) un[r] = (pos0_ >= 3 - r) ? UG[(g0_ - 3 + r) * 2048 + ch] : (u16)0; \
      _Pragma("unroll") for (int r = 0; r < 16; ++r) { un[3 + r] = UG[(g0_ + r) * 2048 + ch]; gn[r] = UG[(g0_ + r) * 2048 + 1024 + ch]; } }
    LRU_LOAD(0);
#pragma unroll 1
    for (int mt = 0; mt < 16; ++mt) {
      const size_t m0 = (size_t)b * 2048 + mt * 128;
      const size_t g0 = m0 + rg * 16;
      u16 gg[16];
#pragma unroll
      for (int r = 0; r < 16; ++r) gg[r] = gn[r];
      {
        float u3 = bf2f(un[0]), u2 = bf2f(un[1]), u1 = bf2f(un[2]);
#pragma unroll
        for (int r = 0; r < 16; ++r) {
          const float u0 = bf2f(un[3 + r]);
          const float v = w0 * u3 + w1 * u2 + w2 * u1 + w3 * u0 + cb;
          UB[(rg * 16 + r) * 65 + c] = v;
          Al[(rg * 16 + r) * 72 + c] = f2bf(v);
          u3 = u2; u2 = u1; u1 = u0;
        }
      }
      if (mt + 1 < 16) LRU_LOAD(mt + 1);
      __syncthreads();
      f32x4 acc[2][4];
#pragma unroll
      for (int i = 0; i < 2; ++i)
#pragma unroll
        for (int j = 0; j < 4; ++j) acc[i][j] = (f32x4){0.f, 0.f, 0.f, 0.f};
#pragma unroll
      for (int ks = 0; ks < 2; ++ks) {
        bf16x8 af[2], bfr[4];
#pragma unroll
        for (int i = 0; i < 2; ++i) af[i] = *(const bf16x8*)(Al + (wr * 32 + i * 16 + fr) * 72 + ks * 32 + fq * 8);
#pragma unroll
        for (int j = 0; j < 4; ++j) bfr[j] = *(const bf16x8*)(Bl + (wc * 64 + j * 16 + fr) * 72 + ks * 32 + fq * 8);
#pragma unroll
        for (int i = 0; i < 2; ++i)
#pragma unroll
          for (int j = 0; j < 4; ++j) acc[i][j] = mfma16(af[i], bfr[j], acc[i][j]);
      }
#pragma unroll
      for (int jj = 0; jj < 2; ++jj) {
        const int d = wc * 32 + jj * 16 + fr;
#pragma unroll
        for (int i = 0; i < 2; ++i)
#pragma unroll
          for (int r = 0; r < 4; ++r) {
            const int row = wr * 32 + i * 16 + fq * 4 + r;
            const float rr = sigmoid_(acc[i][jj * 2][r] + ba[jj]);
            const float ig = sigmoid_(acc[i][jj * 2 + 1][r] + bx[jj]);
            const float log_a = -8.f * rr * spl[jj];
            const float av = __expf(log_a);
            AA[row * 65 + d] = av;
            UB[row * 65 + d] = sqrtf(fmaxf((1.f - av) * (1.f + av), 0.f)) * (ig * UB[row * 65 + d]);
          }
      }
      __syncthreads();
      {
        float Aa = 1.f, Bb = 0.f;
#pragma unroll
        for (int r = 0; r < 16; ++r) {
          const float a = AA[(rg * 16 + r) * 65 + c], bb = UB[(rg * 16 + r) * 65 + c];
          Bb = a * Bb + bb; Aa *= a;
        }
        sA[rg * 64 + c] = Aa; sB[rg * 64 + c] = Bb;
        __syncthreads();
        float h = Hc[c];
        for (int v = 0; v < rg; ++v) h = sA[v * 64 + c] * h + sB[v * 64 + c];
#pragma unroll
        for (int r = 0; r < 16; ++r) {
          const float a = AA[(rg * 16 + r) * 65 + c], bb = UB[(rg * 16 + r) * 65 + c];
          h = a * h + bb;
          OG[(g0 + r) * 1024 + ch] = f2bf(h * silu_(bf2f(gg[r])));
        }
        __syncthreads();
        if (rg == 7) Hc[c] = h;
      }
    }
    __syncthreads();
  }
}

#undef LRU_LOAD
__device__ __forceinline__ void lru_scan_phase(const PAcc& p, char* lds) {
  const int tid = tid_(), c = tid & 63, tc = tid >> 6;
  float* sA = (float*)lds;
  float* sB = sA + 512;
  const float* LA = (const float*)(p.pp->ws + LRU_A);
  const float* LB = (const float*)(p.pp->ws + LRU_B);
  const u16* UG = (const u16*)(p.pp->ws + LRU_UG);
  u16* OG = (u16*)(p.pp->ws + WS_H);
  for (int item = blockIdx.x; item < 256; item += gridDim.x) {
    const int b = item >> 4, ch = (item & 15) * 64 + c;
    const size_t row0 = (size_t)b * 2048 + tc * 256;
    float Aa = 1.f, Bb = 0.f;
#pragma unroll 8
    for (int t = 0; t < 256; ++t) {
      const float a = LA[(row0 + t) * 1024 + ch], bb = LB[(row0 + t) * 1024 + ch];
      Bb = a * Bb + bb; Aa *= a;
    }
    sA[tc * 64 + c] = Aa; sB[tc * 64 + c] = Bb;
    __syncthreads();
    float h = 0.f;
    for (int v = 0; v < tc; ++v) h = sA[v * 64 + c] * h + sB[v * 64 + c];
#pragma unroll 8
    for (int t = 0; t < 256; ++t) {
      const float a = LA[(row0 + t) * 1024 + ch], bb = LB[(row0 + t) * 1024 + ch];
      h = a * h + bb;
      const float g = bf2f(UG[(row0 + t) * 2048 + 1024 + ch]);
      OG[(row0 + t) * 1024 + ch] = f2bf(h * silu_(g));
    }
    __syncthreads();
  }
}

__device__ __forceinline__ void rwkv_rec_phase(const PAcc& p, char* lds, bool st) {
  const int tid = tid_(), lane = tid & 63, wave = tid >> 6;
  float* Wd = (float*)lds;
  float* NKK = Wd + 1024;
  float* KKA = NKK + 1024;
  float* KM = KKA + 1024;
  float* Rr = KM + 1024;
  float* Vv = Rr + 1024;
  float* Yy = Vv + 1024;
  float* RKs = Yy + 1024;
  u16* RKVG = (u16*)(p.pp->ws + RW_RKVG);
  const float* EW = (const float*)(p.pp->ws + RW_EW);
  const u16* AB = (const u16*)(p.pp->ws + RW_A);
  const int tl = tid >> 5, jp = tid & 31;
  const int il = lane >> 3, js = lane & 7;
  for (int item = blockIdx.x; item < 256; item += gridDim.x) {
    const int b = item >> 4, h = item & 15;
    const int hc = h * 64 + 2 * jp;
    const float kk0 = p.pp->in[26][hc], kk1 = p.pp->in[26][hc + 1];
    const float ka0 = p.pp->in[27][hc], ka1 = p.pp->in[27][hc + 1];
    const float rk0 = p.pp->in[28][hc], rk1 = p.pp->in[28][hc + 1];
    const float lw0 = p.pp->in[29][hc], lw1 = p.pp->in[29][hc + 1];
    const float lb0 = p.pp->in[30][hc], lb1 = p.pp->in[30][hc + 1];
    f32x4 SA = (f32x4){0.f, 0.f, 0.f, 0.f}, SB = SA;
    const int irow = wave * 8 + il;
    unsigned r2, k2, v2, a2, g2n, g2; float2 e2;
    {
      const size_t row = (size_t)b * 2048 + tl;
      r2 = *(const unsigned*)(RKVG + row * 4096 + hc);
      k2 = *(const unsigned*)(RKVG + row * 4096 + 1024 + hc);
      v2 = *(const unsigned*)(RKVG + row * 4096 + 2048 + hc);
      g2n = *(const unsigned*)(RKVG + row * 4096 + 3072 + hc);
      a2 = *(const unsigned*)(AB + row * 1024 + hc);
      e2 = *(const float2*)(EW + row * 1024 + hc);
    }
    for (int t0 = 0; t0 < 2048; t0 += 16) {
      g2 = g2n;
      {
        const float r0 = bflo(r2), r1 = bfhi(r2), k0 = bflo(k2), k1 = bfhi(k2), v0 = bflo(v2), v1 = bfhi(v2);
        const float a0 = bflo(a2), a1 = bfhi(a2);
        float q0 = k0 * kk0, q1 = k1 * kk1;
        float ss = q0 * q0 + q1 * q1;
        ss = red32(ss);
        const float inv = rsqrtf(fmaxf(ss, 1e-24f));
        q0 *= inv; q1 *= inv;
        const float km0 = k0 * (1.f + (a0 - 1.f) * ka0), km1 = k1 * (1.f + (a1 - 1.f) * ka1);
        float bon = r0 * km0 * rk0 + r1 * km1 * rk1;
        bon = red32(bon);
        const int o = tl * 64 + 2 * jp;
        *(float2*)(Wd + o) = make_float2(__expf(-e2.x), __expf(-e2.y));
        *(float2*)(NKK + o) = make_float2(-q0, -q1);
        *(float2*)(KKA + o) = make_float2(q0 * a0, q1 * a1);
        *(float2*)(KM + o) = make_float2(km0, km1);
        *(float2*)(Rr + o) = make_float2(r0, r1);
        *(float2*)(Vv + o) = make_float2(v0, v1);
        if (jp == 0) RKs[tl] = bon;
      }
      __syncthreads();
      if (t0 + 16 < 2048) {
        const size_t row = (size_t)b * 2048 + t0 + 16 + tl;
        r2 = *(const unsigned*)(RKVG + row * 4096 + hc);
        k2 = *(const unsigned*)(RKVG + row * 4096 + 1024 + hc);
        v2 = *(const unsigned*)(RKVG + row * 4096 + 2048 + hc);
        g2n = *(const unsigned*)(RKVG + row * 4096 + 3072 + hc);
        a2 = *(const unsigned*)(AB + row * 1024 + hc);
        e2 = *(const float2*)(EW + row * 1024 + hc);
      }
#define RW_RD(W, N, C, M, R, V, t_)                                                        \
      { const int o_ = (t_) * 64 + js * 8;                                                   \
        W[0] = *(const f32x4*)(Wd + o_); W[1] = *(const f32x4*)(Wd + o_ + 4);                \
        N[0] = *(const f32x4*)(NKK + o_); N[1] = *(const f32x4*)(NKK + o_ + 4);              \
        C[0] = *(const f32x4*)(KKA + o_); C[1] = *(const f32x4*)(KKA + o_ + 4);              \
        M[0] = *(const f32x4*)(KM + o_); M[1] = *(const f32x4*)(KM + o_ + 4);                \
        R[0] = *(const f32x4*)(Rr + o_); R[1] = *(const f32x4*)(Rr + o_ + 4);                \
        V = Vv[(t_) * 64 + irow]; }
#define RW_CP(W, N, C, M, R, V, yout)                                                      \
      { const f32x4 p0_ = SA * N[0], p1_ = SB * N[1];                                        \
        float sa_ = ((p0_[0] + p0_[1]) + (p0_[2] + p0_[3])) + ((p1_[0] + p1_[1]) + (p1_[2] + p1_[3])); \
        sa_ = red8(sa_);                                                                     \
        SA = SA * W[0] + (C[0] * sa_ + M[0] * V);                                            \
        SB = SB * W[1] + (C[1] * sa_ + M[1] * V);                                            \
        const f32x4 y0_ = SA * R[0], y1_ = SB * R[1];                                        \
        float y_ = ((y0_[0] + y0_[1]) + (y0_[2] + y0_[3])) + ((y1_[0] + y1_[1]) + (y1_[2] + y1_[3])); \
        yout = red8(y_); }
      {
        f32x4 aW[2], aN[2], aC[2], aM[2], aR[2], bW[2], bN[2], bC[2], bM[2], bR[2];
        float aV, bV;
        RW_RD(aW, aN, aC, aM, aR, aV, 0);
        RW_RD(bW, bN, bC, bM, bR, bV, 1);
#pragma unroll
        for (int t = 0; t < 16; t += 2) {
          float ya, yb;
          RW_CP(aW, aN, aC, aM, aR, aV, ya);
          if (t + 2 < 16) RW_RD(aW, aN, aC, aM, aR, aV, t + 2);
          RW_CP(bW, bN, bC, bM, bR, bV, yb);
          if (t + 3 < 16) RW_RD(bW, bN, bC, bM, bR, bV, t + 3);
          if (js == 0) { Yy[t * 64 + irow] = ya; Yy[(t + 1) * 64 + irow] = yb; }
        }
      }
#undef RW_RD
#undef RW_CP
      __syncthreads();
      {
        const int o = tl * 64 + 2 * jp;
        const float2 y = *(const float2*)(Yy + o);
        float sm = y.x + y.y;
        sm = red32(sm);
        const float mean = sm * (1.f / 64.f);
        const float d0 = y.x - mean, d1 = y.y - mean;
        float vs = d0 * d0 + d1 * d1;
        vs = red32(vs);
        const float rstd = rsqrtf(vs * (1.f / 64.f) + 64e-5f);
        const float2 vv = *(const float2*)(Vv + o);
        const float bon = RKs[tl];
        const size_t row = (size_t)b * 2048 + t0 + tl;
        const float o0 = (d0 * rstd * lw0 + lb0 + bon * vv.x) * silu_(bflo(g2));
        const float o1 = (d1 * rstd * lw1 + lb1 + bon * vv.y) * silu_(bfhi(g2));
        if (st) *(unsigned*)(RKVG + row * 4096 + hc) = pack2(o0, o1);
      }
      __syncthreads();
    }
  }
}

__device__ __forceinline__ f32x4 wave_mma(const u16* A, int lda, const u16* B, int ldb, int K, f32x4 acc, int fr, int fq) {
  for (int k = 0; k < K; k += 32) {
    const bf16x8 a = *(const bf16x8*)(A + fr * lda + k + fq * 8);
    const bf16x8 b = *(const bf16x8*)(B + fr * ldb + k + fq * 8);
    acc = mfma16(a, b, acc);
  }
  return acc;
}

__device__ __forceinline__ void gla_pre_phase(const PAcc& p, char* lds) {
  const int tid = tid_(), lane = tid & 63, wave = tid >> 6, fr = lane & 15, fq = lane >> 4;
  float* AL = (float*)lds;
  float* TOT = AL + 1024;
  u16* QD = (u16*)(TOT + 512);
  u16* KI = QD + 64 * 136;
  const u16* P = (const u16*)(p.pp->ws + GL_P);
  u16* QDg = (u16*)(p.pp->ws + GL_QD);
  u16* KETg = (u16*)(p.pp->ws + GL_KET);
  u16* ATTg = (u16*)((char*)p.pp->out + GL_ATT_OUT);
  u16* VTg = (u16*)(p.pp->ws + GL_VT);
  float* LASTg = (float*)((char*)p.pp->out + GL_LAST_OUT);
  const int d = tid & 127, tg = tid >> 7;
  for (int item = blockIdx.x; item < 2048; item += gridDim.x) {
    const int h = item & 3, bn = item >> 2;
    const size_t row0 = (size_t)bn * 64;
    float w2c[16];
#pragma unroll
    for (int r = 0; r < 16; ++r) w2c[r] = p.pp->in[33][r * 512 + h * 128 + d];
    const float ab = p.pp->in[34][h * 128 + d];
    for (int i = tid; i < 1024; i += NTHR) AL[i] = bf2f(P[(row0 + (i >> 4)) * 3088 + 3072 + (i & 15)]);
    {
      const int e = tid & 255, th = tid >> 8;
      u16 vv[32];
#pragma unroll
      for (int t = 0; t < 32; ++t) vv[t] = P[(row0 + th * 32 + t) * 3088 + 1024 + h * 256 + e];
      u16* dst = VTg + ((size_t)item * 256 + e) * 64 + th * 32;
#pragma unroll
      for (int q4 = 0; q4 < 4; ++q4) {
        uint4 s0;
        s0.x = vv[q4 * 8 + 0] | ((unsigned)vv[q4 * 8 + 1] << 16); s0.y = vv[q4 * 8 + 2] | ((unsigned)vv[q4 * 8 + 3] << 16);
        s0.z = vv[q4 * 8 + 4] | ((unsigned)vv[q4 * 8 + 5] << 16); s0.w = vv[q4 * 8 + 6] | ((unsigned)vv[q4 * 8 + 7] << 16);
        *(uint4*)(dst + q4 * 8) = s0;
      }
    }
    __syncthreads();
    float cum[16];
    {
      float run = 0.f;
#pragma unroll
      for (int t = 0; t < 16; ++t) {
        const float4* al = (const float4*)(AL + (tg * 16 + t) * 16);
        const float4 x0 = al[0], x1 = al[1], x2 = al[2], x3 = al[3];
        float z = ab + x0.x * w2c[0] + x0.y * w2c[1] + x0.z * w2c[2] + x0.w * w2c[3] + x1.x * w2c[4] + x1.y * w2c[5] + x1.z * w2c[6] + x1.w * w2c[7]
                + x2.x * w2c[8] + x2.y * w2c[9] + x2.z * w2c[10] + x2.w * w2c[11] + x3.x * w2c[12] + x3.y * w2c[13] + x3.z * w2c[14] + x3.w * w2c[15];
        run += -((-z > 20.f) ? -z : __logf(1.f + __expf(-z))) * (1.f / 16.f);
        cum[t] = run;
      }
      TOT[tg * 128 + d] = run;
    }
    __syncthreads();
    {
      float off = 0.f, last = 0.f;
#pragma unroll
      for (int g = 0; g < 4; ++g) { const float tv = TOT[g * 128 + d]; if (g < tg) off += tv; last += tv; }
      if (tg == 0) LASTg[(size_t)item * 128 + d] = last;
      const float elast = __expf(last);
      u16 ke[16];
#pragma unroll
      for (int t = 0; t < 16; ++t) {
        const float c = cum[t] + off;
        const int tok = tg * 16 + t;
        const float q = bf2f(P[(row0 + tok) * 3088 + h * 128 + d]);
        const float k = bf2f(P[(row0 + tok) * 3088 + 512 + h * 128 + d]);
        const float ec = __expf(c), einv = __builtin_amdgcn_rcpf(ec);
        const u16 qd = f2bf(q * 0.08838834764831845f * ec);
        QD[tok * 136 + d] = qd;
        QDg[(row0 + tok) * 512 + h * 128 + d] = qd;
        KI[tok * 136 + d] = f2bf(k * einv);
        ke[t] = f2bf(k * elast * einv);
      }
      uint4 s0, s1;
      s0.x = ke[0] | ((unsigned)ke[1] << 16); s0.y = ke[2] | ((unsigned)ke[3] << 16); s0.z = ke[4] | ((unsigned)ke[5] << 16); s0.w = ke[6] | ((unsigned)ke[7] << 16);
      s1.x = ke[8] | ((unsigned)ke[9] << 16); s1.y = ke[10] | ((unsigned)ke[11] << 16); s1.z = ke[12] | ((unsigned)ke[13] << 16); s1.w = ke[14] | ((unsigned)ke[15] << 16);
      u16* kd = KETg + ((size_t)item * 128 + d) * 64 + tg * 16;
      *(uint4*)kd = s0;
      *(uint4*)(kd + 8) = s1;
    }
    __syncthreads();
    {
      const int ti = wave >> 1;
#pragma unroll
      for (int x = 0; x < 2; ++x) {
        const int tj = (wave & 1) * 2 + x;
        f32x4 a = (f32x4){0.f, 0.f, 0.f, 0.f};
        if (tj <= ti) a = wave_mma(QD + ti * 16 * 136, 136, KI + tj * 16 * 136, 136, 128, a, fr, fq);
#pragma unroll
        for (int r = 0; r < 4; ++r) {
          const int i = ti * 16 + fq * 4 + r, j = tj * 16 + fr;
          ATTg[(size_t)item * 4096 + i * 64 + j] = f2bf((j <= i) ? a[r] : 0.f);
        }
      }
    }
    __syncthreads();
  }
}

__device__ __forceinline__ void gla_phase(const PAcc& p, char* lds) {
  const int tid = tid_(), lane = tid & 63, wave = tid >> 6, fr = lane & 15, fq = lane >> 4;
  float* LAST = (float*)lds;
  u16* QD = (u16*)(LAST + 128);
  u16* KET = QD + 64 * 136;
  u16* VT = KET + 128 * 72;
  u16* ATT = VT + 64 * 72;
  u16* ST = ATT + 64 * 72;
  const u16* QDg = (const u16*)(p.pp->ws + GL_QD);
  const u16* KETg = (const u16*)(p.pp->ws + GL_KET);
  const u16* ATTg = (const u16*)((const char*)p.pp->out + GL_ATT_OUT);
  const u16* VTg = (const u16*)(p.pp->ws + GL_VT);
  const float* LASTg = (const float*)((const char*)p.pp->out + GL_LAST_OUT);
  u16* O = (u16*)(p.pp->ws + GL_O);
  for (int item = blockIdx.x; item < 256; item += gridDim.x) {
    const int b = item >> 4, h = (item >> 2) & 3, es = item & 3;
    f32x4 sacc[4];
#pragma unroll
    for (int i = 0; i < 4; ++i) sacc[i] = (f32x4){0.f, 0.f, 0.f, 0.f};
    for (int i = tid; i < 64 * 136 / 2; i += NTHR) ((unsigned*)ST)[i] = 0u;
    uint4 rA, rQ0, rQ1, rK0, rK1, rV; float rL = 0.f;
#define GLA_LOAD(n_)                                                                                            \
    {                                                                                                           \
      const size_t it_ = ((size_t)(b * 32 + (n_))) * 4 + h;                                                     \
      rA = *(const uint4*)(ATTg + it_ * 4096 + tid * 8);                                                        \
      { const int c0_ = tid, c1_ = tid + NTHR;                                                                  \
        rQ0 = *(const uint4*)(QDg + ((size_t)(b * 32 + (n_)) * 64 + (c0_ >> 4)) * 512 + h * 128 + (c0_ & 15) * 8); \
        rQ1 = *(const uint4*)(QDg + ((size_t)(b * 32 + (n_)) * 64 + (c1_ >> 4)) * 512 + h * 128 + (c1_ & 15) * 8); \
        rK0 = *(const uint4*)(KETg + it_ * 8192 + c0_ * 8);                                                     \
        rK1 = *(const uint4*)(KETg + it_ * 8192 + c1_ * 8); }                                                   \
      rV = *(const uint4*)(VTg + (it_ * 256 + es * 64) * 64 + tid * 8);                                         \
      if (tid < 128) rL = LASTg[it_ * 128 + tid];                                                               \
    }
    GLA_LOAD(0);
    for (int n = 0; n < 32; ++n) {
      const size_t row0 = (size_t)b * 2048 + n * 64;
      *(uint4*)(ATT + (tid >> 3) * 72 + (tid & 7) * 8) = rA;
      *(uint4*)(QD + (tid >> 4) * 136 + (tid & 15) * 8) = rQ0;
      *(uint4*)(QD + ((tid + NTHR) >> 4) * 136 + (tid & 15) * 8) = rQ1;
      *(uint4*)(KET + (tid >> 3) * 72 + (tid & 7) * 8) = rK0;
      *(uint4*)(KET + ((tid + NTHR) >> 3) * 72 + (tid & 7) * 8) = rK1;
      *(uint4*)(VT + (tid >> 3) * 72 + (tid & 7) * 8) = rV;
      if (tid < 128) LAST[tid] = rL;
      __syncthreads();
      if (n + 1 < 32) GLA_LOAD(n + 1);
      {
        const int ti = wave >> 1;
#pragma unroll
        for (int x = 0; x < 2; ++x) {
          const int te = (wave & 1) * 2 + x;
          f32x4 a = (f32x4){0.f, 0.f, 0.f, 0.f};
          a = wave_mma(ATT + ti * 16 * 72, 72, VT + te * 16 * 72, 72, 64, a, fr, fq);
          a = wave_mma(QD + ti * 16 * 136, 136, ST + te * 16 * 136, 136, 128, a, fr, fq);
#pragma unroll
          for (int r = 0; r < 4; ++r)
            O[(row0 + ti * 16 + fq * 4 + r) * 1024 + h * 256 + es * 64 + te * 16 + fr] = f2bf(a[r]);
        }
        const int et = wave >> 1;
#pragma unroll
        for (int x = 0; x < 4; ++x) {
          const int dt = (wave & 1) * 4 + x;
          const float dec = __expf(LAST[dt * 16 + fr]);
          f32x4 a = sacc[x];
          a[0] *= dec; a[1] *= dec; a[2] *= dec; a[3] *= dec;
          sacc[x] = wave_mma(VT + et * 16 * 72, 72, KET + dt * 16 * 72, 72, 64, a, fr, fq);
        }
      }
      __syncthreads();
      {
        const int et = wave >> 1;
#pragma unroll
        for (int x = 0; x < 4; ++x) {
          const int dt = (wave & 1) * 4 + x;
#pragma unroll
          for (int r = 0; r < 4; ++r) ST[(et * 16 + fq * 4 + r) * 136 + dt * 16 + fr] = f2bf(sacc[x][r]);
        }
      }
      __syncthreads();
    }
  }
}
#undef GLA_LOAD
__device__ __forceinline__ void gla_norm_phase(const PAcc& p) {
  const int lane = tid_() & 63;
  const int gw = blockIdx.x * (NTHR / 64) + (tid_() >> 6);
  const int nw = gridDim.x * (NTHR / 64);
  const u16* O = (const u16*)(p.pp->ws + GL_O);
  const u16* P = (const u16*)(p.pp->ws + GL_P);
  u16* OG = (u16*)(p.pp->ws + WS_H);
  const float4 gn = *(const float4*)(p.pp->in[35] + lane * 4);
  for (int row = gw; row < T_; row += nw) {
#pragma unroll
    for (int h = 0; h < 4; ++h) {
      const uint2 ov = *(const uint2*)(O + (size_t)row * 1024 + h * 256 + lane * 4);
      float4 v; v.x = bflo(ov.x); v.y = bfhi(ov.x); v.z = bflo(ov.y); v.w = bfhi(ov.y);
      float ss = v.x * v.x + v.y * v.y + v.z * v.z + v.w * v.w;
#pragma unroll
      for (int m = 32; m >= 1; m >>= 1) ss += __shfl_xor(ss, m);
      const float rstd = rsqrtf(ss * (1.f / 256.f) + 1e-6f);
      const uint2 g = *(const uint2*)(P + (size_t)row * 3088 + 2048 + h * 256 + lane * 4);
      uint2 o;
      o.x = pack2(v.x * rstd * gn.x * silu_(bflo(g.x)), v.y * rstd * gn.y * silu_(bfhi(g.x)));
      o.y = pack2(v.z * rstd * gn.z * silu_(bflo(g.y)), v.w * rstd * gn.w * silu_(bfhi(g.y)));
      *(uint2*)(OG + (size_t)row * 1024 + h * 256 + lane * 4) = o;
    }
  }
}


#define XB_TMO      128
#define XB_XCNT(j)  (256  + 64 * (j))
#define XB_XSUB(j)  (1280 + 64 * (j))
#define XB_XGEN(j)  (2304 + 64 * (j))
#define XB_TOP      3328
#define XB_TOPGEN   3392
#define XCD_BAR_WORDS 3456
#define XB_SPIN_CAP (1u << 18)
#define XLAS __attribute__((address_space(3)))
__device__ __forceinline__ unsigned xb_ld(unsigned* p)              { return __hip_atomic_load(p, __ATOMIC_RELAXED, __HIP_MEMORY_SCOPE_AGENT); }
__device__ __forceinline__ unsigned xb_add(unsigned* p, unsigned v) { return __hip_atomic_fetch_add(p, v, __ATOMIC_RELAXED, __HIP_MEMORY_SCOPE_AGENT); }
__device__ __forceinline__ unsigned xb_xcc_id() { return (unsigned)__builtin_amdgcn_s_getreg((3 << 11) | 20) & 0xFu; }
#define XB_SPIN(cond, bar) do { unsigned _sp = 0; while (cond) { __builtin_amdgcn_s_sleep(1); \
    if ((++_sp & 255u) == 0u) { if (xb_ld(&(bar)[XB_TMO])) break; if (_sp > XB_SPIN_CAP) { atomicAdd(&(bar)[XB_TMO], 1u); break; } } } } while (0)
struct XcdBarrier { unsigned* bar; unsigned x; volatile XLAS unsigned* st; };
__device__ __forceinline__ XcdBarrier xcd_barrier_post(unsigned* bar, volatile XLAS unsigned* st) {
  XcdBarrier b; b.bar = bar; b.x = xb_xcc_id(); b.st = st;
  if (tid_() == 0) (void)xb_add(&bar[XB_XCNT(b.x)], 1u);
  return b;
}
__device__ __forceinline__ void xcd_barrier_complete(unsigned* bar, unsigned x, unsigned& nloc, unsigned& nx) {
  const unsigned G = gridDim.x * gridDim.y * gridDim.z;
  unsigned sum, cnt, mine, sp = 0u;
  for (;;) {
    sum = 0u; cnt = 0u; mine = 0u;
#pragma unroll
    for (unsigned j = 0; j < 16; ++j) { const unsigned c = xb_ld(&bar[XB_XCNT(j)]); sum += c; cnt += (c > 0u) ? 1u : 0u; mine = (j == x) ? c : mine; }
    if (sum == G) break;
    __builtin_amdgcn_s_sleep(1);
    if ((++sp & 255u) == 0u) { if (xb_ld(&bar[XB_TMO])) break; if (sp > XB_SPIN_CAP) { atomicAdd(&bar[XB_TMO], 1u); break; } }
  }
  nloc = mine > 0u ? mine : 1u; nx = cnt > 0u ? cnt : 1u;
}
__device__ __forceinline__ void xcd_barrier(const XcdBarrier& b) {
  asm volatile("s_waitcnt vmcnt(0)" ::: "memory");
  __syncthreads();
  if (tid_() == 0) {
    unsigned* bar = b.bar;
    __builtin_amdgcn_s_waitcnt(0);
    unsigned nloc = b.st[0], nx = b.st[1];
    if (nloc == 0u) { xcd_barrier_complete(bar, b.x, nloc, nx); b.st[0] = nloc; b.st[1] = nx; }
    const unsigned old = xb_add(&bar[XB_XSUB(b.x)], 1u);
    const unsigned gen = old / nloc;
    if (old + 1u == (gen + 1u) * nloc) {
      __builtin_amdgcn_fence(__ATOMIC_RELEASE, "agent");
      asm volatile("s_waitcnt vmcnt(0)" ::: "memory");
      const unsigned og = xb_add(&bar[XB_TOP], 1u);
      const unsigned tg = og / nx;
      if (og + 1u == (tg + 1u) * nx) xb_add(&bar[XB_TOPGEN], 1u);
      else XB_SPIN(xb_ld(&bar[XB_TOPGEN]) == tg, bar);
      __builtin_amdgcn_fence(__ATOMIC_ACQUIRE, "agent");
      xb_add(&bar[XB_XGEN(b.x)], 1u);
      asm volatile("s_waitcnt vmcnt(0)" ::: "memory");
    } else {
      XB_SPIN(xb_ld(&bar[XB_XGEN(b.x)]) == gen, bar);
      __builtin_amdgcn_fence(__ATOMIC_ACQUIRE, "agent");
      asm volatile("s_waitcnt vmcnt(0)" ::: "memory");
    }
  }
  __syncthreads();
}

__global__ void __launch_bounds__(NTHR) fwd_megakernel(Params pk) {
  extern __shared__ __attribute__((aligned(16))) char lds[];
  cg::grid_group grid = cg::this_grid();
  PAcc p;
  p.pp = (CParamsPtr)__builtin_amdgcn_kernarg_segment_ptr();
  asm volatile("" : "+s"(p.pp));
  unsigned* xbar = (unsigned*)(p.pp->ws + WS_XBAR);
  volatile XLAS unsigned* xst = (volatile XLAS unsigned*)(lds + 128 * 1024);
  if (tid_() < 2) xst[tid_()] = 0u;
  if (blockIdx.x == 0) for (int i = tid_(); i < XCD_BAR_WORDS; i += NTHR) xbar[i] = 0u;
  const u16* WT = (const u16*)(p.pp->ws + WS_WT);
  u16* H = (u16*)(p.pp->ws + WS_H);
  u16* H2 = (u16*)(p.pp->ws + WS_H2);
  const float* MOD = (const float*)(p.pp->ws + WS_MOD);
  const float* xcur = p.pp->in[0];

#if DUP == 11
  for (int r_ = 0; r_ < 20; ++r_) grid.sync();
#endif
#if DUP == 5
  prep_phase(p, lds);
  grid.sync();
#endif
  prep_phase(p, lds);
  grid.sync();
  const XcdBarrier xb = xcd_barrier_post(xbar, xst);

  if (LAYER_MASK & 1) {
    for (int r_ = 0; r_ < ((DUP == 10) ? 2 : 1); ++r_) norm_phase<false, true, false>(p, p.pp->in[0], 0, H, nullptr);
    xcd_barrier(xb);
    for (int r_ = 0; r_ < ((DUP == 9) ? 2 : 1); ++r_) {
      pg8::EpiDsaMain e{(u16*)(p.pp->ws + DSA_QKVG), p.pp->in[6], p.pp->in[7], (const float2*)(p.pp->ws + WS_ROPE64), (u16*)(p.pp->ws + DSA_VT)};
      pg8::run<pg8::EpiDsaMain, true>(lds, H, H, H, WT + W_DSA_MAIN, WT + W_DSA_MAIN, WT + W_DSA_MAIN, 1024, 1024, 4, 1, 2560, e);
      pg8::EpiDsaIdx e2{(u16*)(p.pp->ws + DSA_QIHI), (u16*)(p.pp->ws + DSA_QILO), (u16*)(p.pp->ws + DSA_KIHI), (u16*)(p.pp->ws + DSA_KILO), (float*)(p.pp->ws + DSA_WI),
                        (const float2*)(p.pp->ws + WS_ROPE128)};
      pg8::run<pg8::EpiDsaIdx, true>(lds, H, H, H, WT + W_DSA_IDX_HI, WT + W_DSA_IDX_HI, WT + W_DSA_IDX_HI, 1024, 1024, 4, 1, 1280, e2);
    }
    xcd_barrier(xb);
#if DUP == 1
    dsa_unit_phase(p, lds, p.pp->ws == nullptr);
    xcd_barrier(xb);
#endif
    dsa_unit_phase(p, lds, true);
    xcd_barrier(xb);
    for (int r_ = 0; r_ < ((DUP == 9) ? 2 : 1); ++r_) {
      pg8::EpiResid<false, true> e{p.pp->ws + XR1, p.pp->in[0], MOD + 0 * 16 * 3072};
      const u16* A = (const u16*)(p.pp->ws + DSA_QKVG);
      pg8::run(lds, A, A, A, WT + W_DSA_OUT, WT + W_DSA_OUT, WT + W_DSA_OUT, 2560, 1024, 4, 1, 1024, e);
    }
    xcd_barrier(xb);
    xcur = p.pp->out;
  }
  if (LAYER_MASK & 2) {
    for (int r_ = 0; r_ < ((DUP == 10) ? 2 : 1); ++r_) norm_phase<false, false, true>(p, p.pp->ws + XR1, 1, H, nullptr);
    xcd_barrier(xb);
    for (int r_ = 0; r_ < ((DUP == 9) ? 2 : 1); ++r_) {
      pg8::EpiPlain e{(u16*)(p.pp->ws + LRU_UG), 2048, 2048};
      pg8::run(lds, H, H, H, WT + W_LRU_IN, WT + W_LRU_IN, WT + W_LRU_IN, 1024, 1024, 4, 1, 2048, e);
    }
    xcd_barrier(xb);
#if DUP == 4
    lru_fused_phase(p, lds);
    xcd_barrier(xb);
#endif
    lru_fused_phase(p, lds);
    xcd_barrier(xb);
    {
      pg8::EpiResid<true, true> e{p.pp->out, p.pp->ws + XR1, MOD + 1 * 16 * 3072};
      pg8::run(lds, H, H, H, WT + W_LRU_OUT, WT + W_LRU_OUT, WT + W_LRU_OUT, 1024, 1024, 4, 1, 1024, e);
    }
    xcd_barrier(xb);
    xcur = p.pp->out;
  }
  if (LAYER_MASK & 4) {
    for (int r_ = 0; r_ < ((DUP == 10) ? 2 : 1); ++r_) norm_phase<true, false, true>(p, p.pp->out, 2, H, nullptr);
    xcd_barrier(xb);
    for (int r_ = 0; r_ < ((DUP == 9) ? 2 : 1); ++r_) {
      pg8::EpiPlain e{(u16*)(p.pp->ws + RW_RKVG), 4096, 4096};
      pg8::run(lds, H, H, H, WT + W_RWKV_IN, WT + W_RWKV_IN, WT + W_RWKV_IN, 2048, 2048, 5, 1, 4096, e);
      EpiP e2{}; e2.o16 = (u16*)(p.pp->ws + RW_L1);
      gemm_phase<EPI_RWKV_L1>(p, H, H, H, WT + W_RWKV_L1, WT + W_RWKV_L1, WT + W_RWKV_L1, 2048, 2048, 2048, 1, 0, 1, e2, lds);
    }
    xcd_barrier(xb);
    for (int r_ = 0; r_ < ((DUP == 9) ? 2 : 1); ++r_) {
      const u16* L1 = (const u16*)(p.pp->ws + RW_L1);
      EpiP e{}; e.of = (float*)(p.pp->ws + RW_EW); e.f0 = p.pp->in[20];
      gemm_phase<EPI_RWKV_W>(p, L1, L1, L1, WT + W_RWKV_W2, WT + W_RWKV_W2, WT + W_RWKV_W2, 128, 64, 64, 1, 0, 8, e, lds);
      EpiP e2{}; e2.o16 = (u16*)(p.pp->ws + RW_A); e2.f0 = p.pp->in[23];
      gemm_phase<EPI_RWKV_A>(p, L1 + 64, L1 + 64, L1 + 64, WT + W_RWKV_A2, WT + W_RWKV_A2, WT + W_RWKV_A2, 128, 64, 64, 1, 0, 8, e2, lds);
    }
    xcd_barrier(xb);
#if DUP == 2
    rwkv_rec_phase(p, lds, p.pp->ws == nullptr);
    xcd_barrier(xb);
#endif
    rwkv_rec_phase(p, lds, true);
    xcd_barrier(xb);
    {
      pg8::EpiResid<true, true> e{p.pp->ws + XR3, p.pp->out, MOD + 2 * 16 * 3072};
      const u16* A = (const u16*)(p.pp->ws + RW_RKVG);
      pg8::run(lds, A, A, A, WT + W_RWKV_OUT, WT + W_RWKV_OUT, WT + W_RWKV_OUT, 4096, 1024, 4, 1, 1024, e);
    }
    xcd_barrier(xb);
    xcur = p.pp->out;
  }
  if (LAYER_MASK & 8) {
    for (int r_ = 0; r_ < ((DUP == 10) ? 2 : 1); ++r_) norm_phase<false, false, true>(p, p.pp->ws + XR3, 3, H, nullptr);
    xcd_barrier(xb);
    for (int r_ = 0; r_ < ((DUP == 9) ? 2 : 1); ++r_) {
      pg8::EpiPlain e{(u16*)(p.pp->ws + GL_P), 3088, 3088};
      pg8::run(lds, H, H, H, WT + W_GLA_IN, WT + W_GLA_IN, WT + W_GLA_IN, 1024, 1024, 4, 1, 3328, e);
    }
    xcd_barrier(xb);
    gla_pre_phase(p, lds);
    xcd_barrier(xb);
#if DUP == 3
    gla_phase(p, lds);
    xcd_barrier(xb);
#endif
    gla_phase(p, lds);
    xcd_barrier(xb);
    for (int r_ = 0; r_ < ((DUP == 10) ? 2 : 1); ++r_) gla_norm_phase(p);
    xcd_barrier(xb);
    {
      pg8::EpiResid<true, false> e{p.pp->out, p.pp->ws + XR3, MOD + 3 * 16 * 3072};
      pg8::run(lds, H, H, H, WT + W_GLA_OUT, WT + W_GLA_OUT, WT + W_GLA_OUT, 1024, 1024, 4, 1, 1024, e);
    }
    xcur = p.pp->out;
  }
  if (xcur != p.pp->out) {
    for (size_t i = (size_t)blockIdx.x * NTHR + tid_(); i < (size_t)T_ * 1024 / 4; i += (size_t)gridDim.x * NTHR)
      ((float4*)p.pp->out)[i] = ((const float4*)p.pp->in[0])[i];
  }
}

extern "C" void kernel_launch(void* const* d_in, const int* in_sizes, int n_in, void* d_out, int out_size, void* d_ws, size_t ws_size,
                              hipStream_t stream) {
  static int grid_blocks = 0;
  if (!grid_blocks) {
    int dev = 0, cus = 0, per_cu = 0;
    hipGetDevice(&dev);
    hipDeviceGetAttribute(&cus, hipDeviceAttributeMultiprocessorCount, dev);
    hipFuncSetAttribute((const void*)fwd_megakernel, hipFuncAttributeMaxDynamicSharedMemorySize, LDS_BYTES);
    hipOccupancyMaxActiveBlocksPerMultiprocessor(&per_cu, (const void*)fwd_megakernel, NTHR, LDS_BYTES);
    if (per_cu < 1) { fprintf(stderr, "occupancy query says %d blocks/CU\n", per_cu); per_cu = 1; }
    grid_blocks = cus;
  }
  Params p{};
  for (int i = 0; i < 37; ++i) p.in[i] = (const float*)d_in[i];
  p.out = (float*)d_out;
  p.ws = (unsigned char*)d_ws;
  for (int i = 0; i < 64; ++i) p.invf128[i] = (float)pow(10000.0, -(double)i / 64.0);
  for (int i = 0; i < 32; ++i) p.invf64[i] = (float)pow(10000.0, -(double)i / 32.0);
  void* args[] = {&p};
  hipError_t e = hipLaunchCooperativeKernel((const void*)fwd_megakernel, dim3(grid_blocks), dim3(NTHR), args, LDS_BYTES, stream);
  if (e != hipSuccess) fprintf(stderr, "cooperative launch failed: %s (grid %d)\n", hipGetErrorString(e), grid_blocks);
}
```

```cpp
#include <hip/hip_runtime.h>
#include <hip/hip_cooperative_groups.h>
#include <cstdio>
#include <cmath>
namespace cg = cooperative_groups;

#ifndef DUP
#define DUP 0
#endif
#ifndef LAYER_MASK
#define LAYER_MASK 15
#endif

typedef unsigned short u16;
using bf16x8 = __attribute__((ext_vector_type(8))) short;
using f32x4 = __attribute__((ext_vector_type(4))) float;

#define NTHR 512
constexpr int T_ = 32768;
constexpr size_t MiB = 1ull << 20;
constexpr int LDS_BYTES = 128 * 1024 + 64;
constexpr size_t WS_XBAR = 896 * 1024;

constexpr size_t WS_MOD = 0;
constexpr size_t WS_ROPE128 = 1 * MiB;
constexpr size_t WS_ROPE64 = 2 * MiB;
constexpr size_t WS_WT = 4 * MiB;
constexpr size_t WS_H = 52 * MiB;
constexpr size_t WS_H2 = 116 * MiB;
constexpr size_t WS_P = 180 * MiB;

constexpr size_t W_DSA_MAIN = 0;
constexpr size_t W_DSA_IDX_HI = W_DSA_MAIN + 2560ull * 1024;
constexpr size_t W_DSA_IDX_LO = W_DSA_IDX_HI + 1280ull * 1024;
constexpr size_t W_DSA_OUT = W_DSA_IDX_LO + 1280ull * 1024;
constexpr size_t W_LRU_IN = W_DSA_OUT + 1024ull * 1024;
constexpr size_t W_LRU_GATE = W_LRU_IN + 2048ull * 1024;
constexpr size_t W_LRU_OUT = W_LRU_GATE + 16ull * 128 * 64;
constexpr size_t W_RWKV_IN = W_LRU_OUT + 1024ull * 1024;
constexpr size_t W_RWKV_L1 = W_RWKV_IN + 4096ull * 2048;
constexpr size_t W_RWKV_W2 = W_RWKV_L1 + 128ull * 2048;
constexpr size_t W_RWKV_A2 = W_RWKV_W2 + 1024ull * 64;
constexpr size_t W_RWKV_OUT = W_RWKV_A2 + 1024ull * 64;
constexpr size_t W_GLA_IN = W_RWKV_OUT + 1024ull * 1024;
constexpr size_t W_GLA_OUT = W_GLA_IN + 3328ull * 1024;
constexpr size_t W_END = W_GLA_OUT + 1024ull * 1024;
static_assert(W_END * 2 <= 48 * MiB, "weights region");

constexpr size_t DSA_QKVG = WS_P;
constexpr size_t DSA_QIHI = WS_P + 160 * MiB;
constexpr size_t DSA_QILO = WS_P + 224 * MiB;
constexpr size_t DSA_KIHI = WS_P + 288 * MiB;
constexpr size_t DSA_KILO = WS_P + 296 * MiB;
constexpr size_t DSA_WI = WS_P + 304 * MiB;
constexpr size_t DSA_VT = WS_P + 306 * MiB;
constexpr size_t DSA_SCR = WS_H;
constexpr size_t LRU_UG = WS_H2;
constexpr size_t LRU_A = WS_H2 + 128 * MiB;
constexpr size_t LRU_B = WS_H2 + 256 * MiB;
constexpr size_t RW_RKVG = WS_P;
constexpr size_t RW_L1 = WS_P + 256 * MiB;
constexpr size_t RW_EW = WS_H;
constexpr size_t RW_A = WS_P + 264 * MiB;
constexpr size_t GL_P = WS_H2;
constexpr size_t GL_O = WS_H2 + 194 * MiB;
constexpr size_t GL_QD = WS_H2 + 258 * MiB;
constexpr size_t GL_KET = WS_H2 + 290 * MiB;
constexpr size_t GL_ATT_OUT = 0;
constexpr size_t GL_LAST_OUT = 16 * MiB;
constexpr size_t XR1 = 448 * MiB;
constexpr size_t XR3 = 438 * MiB;
constexpr size_t GL_VT = WS_H;

struct Params {
  const float* in[37];
  float* out;
  unsigned char* ws;
  float invf128[64];
  float invf64[32];
};

typedef const Params __attribute__((address_space(4))) * CParamsPtr;
struct PAcc { CParamsPtr pp; };

__device__ __forceinline__ int tid_() { int t = __builtin_amdgcn_workitem_id_x(); asm volatile("" : "+v"(t)); return t; }
__device__ __forceinline__ u16 f2bf(float f) {
  unsigned u = __float_as_uint(f);
  u += 0x7fffu + ((u >> 16) & 1u);
  return (u16)(u >> 16);
}
__device__ __forceinline__ float bf2f(u16 h) { return __uint_as_float(((unsigned)h) << 16); }
__device__ __forceinline__ float bflo(unsigned w) { return __uint_as_float(w << 16); }
__device__ __forceinline__ float bfhi(unsigned w) { return __uint_as_float(w & 0xffff0000u); }
__device__ __forceinline__ unsigned pack2(float a, float b) { return (unsigned)f2bf(a) | ((unsigned)f2bf(b) << 16); }
__device__ __forceinline__ float sigmoid_(float x) { return __builtin_amdgcn_rcpf(1.f + __expf(-x)); }
__device__ __forceinline__ float silu_(float x) { return x * __builtin_amdgcn_rcpf(1.f + __expf(-x)); }
__device__ __forceinline__ float softplus_(float x) { return x > 20.f ? x : log1pf(__expf(x)); }
template <int CTRL> __device__ __forceinline__ float dpp(float x) {
  return __builtin_bit_cast(float, __builtin_amdgcn_mov_dpp(__builtin_bit_cast(int, x), CTRL, 0xf, 0xf, true));
}
__device__ __forceinline__ float red8(float x) {
  x += dpp<0xB1>(x); x += dpp<0x4E>(x); x += dpp<0x141>(x); return x;
}
typedef _Float16 f16x8_t __attribute__((ext_vector_type(8)));
typedef _Float16 f16x2_t __attribute__((ext_vector_type(2)));
__device__ __forceinline__ f32x4 mfma16h(bf16x8 a, bf16x8 b, f32x4 c) {
  return __builtin_amdgcn_mfma_f32_16x16x32_f16(__builtin_bit_cast(f16x8_t, a), __builtin_bit_cast(f16x8_t, b), c, 0, 0, 0);
}
__device__ __forceinline__ unsigned packh2(float a, float b) {
  f16x2_t v; v.x = (_Float16)a; v.y = (_Float16)b; return __builtin_bit_cast(unsigned, v);
}
__device__ __forceinline__ float hlo(unsigned w) { return (float)__builtin_bit_cast(f16x2_t, w).x; }
__device__ __forceinline__ float hhi(unsigned w) { return (float)__builtin_bit_cast(f16x2_t, w).y; }
__device__ __forceinline__ u16 f2h(float a) { return __builtin_bit_cast(u16, (_Float16)a); }
__device__ __forceinline__ float red32(float x) {
  x += dpp<0xB1>(x); x += dpp<0x4E>(x); x += dpp<0x141>(x); x += dpp<0x140>(x);
  const auto s_ = __builtin_amdgcn_permlane16_swap(__float_as_uint(x), __float_as_uint(x), false, false);
  return __uint_as_float(s_[0]) + __uint_as_float(s_[1]);
}
__device__ __forceinline__ f32x4 mfma16(bf16x8 a, bf16x8 b, f32x4 c) {
  return __builtin_amdgcn_mfma_f32_16x16x32_bf16(a, b, c, 0, 0, 0);
}
__device__ __forceinline__ void sincos_d(double x, float& c, float& s) {
  double k = rint(x * 0.63661977236758134308);
  double r = fma(-k, 1.57079632679489655800, x);
  r = fma(-k, 6.12323399573676603587e-17, r);
  int q = ((int)k) & 3;
  double r2 = r * r;
  double sp = r * (1.0 + r2 * (-1.0 / 6 + r2 * (1.0 / 120 + r2 * (-1.0 / 5040 + r2 * (1.0 / 362880 + r2 * (-1.0 / 39916800 + r2 * (1.0 / 6227020800.0)))))));
  double cp = 1.0 + r2 * (-0.5 + r2 * (1.0 / 24 + r2 * (-1.0 / 720 + r2 * (1.0 / 40320 + r2 * (-1.0 / 3628800 + r2 * (1.0 / 479001600.0 + r2 * (-1.0 / 87178291200.0)))))));
  double ss = (q == 0) ? sp : (q == 1) ? cp : (q == 2) ? -sp : -cp;
  double cc = (q == 0) ? cp : (q == 1) ? -sp : (q == 2) ? -cp : sp;
  c = (float)cc; s = (float)ss;
}

__device__ __forceinline__ int idx_perm(int p) {
  int wc = p >> 6, jn = (p >> 4) & 3, fr = p & 15;
  return wc * 32 + (jn & 1) * 16 + fr + 64 * (jn >> 1);
}
__device__ __forceinline__ void tconv_job(const float* __restrict__ src, int ld_src, int K, int nrows, int colmode, int col_off, int nvalid,
                          u16* __restrict__ dst, u16* __restrict__ dst_lo, int ldd, int dst_col0,
                          const float* __restrict__ mu, int smode, float* tl, int fmt = 0) {
  const int tid = tid_();
  const int tk = K >> 6, tn = nrows >> 6;
  for (int tile = blockIdx.x; tile < tk * tn; tile += gridDim.x) {
    const int k0 = (tile % tk) << 6, j0 = (tile / tk) << 6;
    {
      const int jn = tid & 63;
      const int j = j0 + jn;
      int col;
      if (colmode == 0) col = (j < nvalid) ? col_off + j : -1;
      else if (colmode == 2) {
        if (j < 1280) { const int P = j & 255; col = (j & ~255) + ((P >> 5) & 3) * 64 + 32 * (P >> 7) + (P & 31); }
        else col = j;
      } else {
        const int P = j & 255, bj = P >> 7, wcc = (P >> 5) & 3, r5 = P & 31;
        if (j < 1024) col = 2560 + ((j >> 8) * 2 + (wcc >> 1)) * 128 + 32 * (wcc & 1) + r5 + 64 * bj;
        else if (wcc < 2) col = 3592 + 32 * (wcc & 1) + r5 + 64 * bj;
        else if (wcc == 2 && bj == 0 && r5 < 8) col = 3584 + r5;
        else col = -1;
      }
#pragma unroll
      for (int i = 0; i < 8; ++i) {
        const int kr = i * 8 + (tid >> 6);
        float v = 0.f;
        if (col >= 0) v = src[(size_t)(k0 + kr) * ld_src + col];
        if (smode == 1) v *= (1.f - mu[k0 + kr]);
        else if (smode == 2) v *= mu[k0 + kr];
        tl[kr * 65 + jn] = v;
      }
    }
    __syncthreads();
    {
      const int kr = tid & 63;
#pragma unroll
      for (int i = 0; i < 8; ++i) {
        const int jn = i * 8 + (tid >> 6);
        float v = tl[kr * 65 + jn];
        u16 hi = fmt ? f2h(v) : f2bf(v);
        size_t o = (size_t)(j0 + jn) * ldd + dst_col0 + k0 + kr;
        dst[o] = hi;
        if (dst_lo) dst_lo[o] = f2bf(v - bf2f(hi));
      }
    }
    __syncthreads();
  }
}

__device__ __forceinline__ void prep_phase(const PAcc& p, char* lds) {
  const int tid = tid_();
  u16* WT = (u16*)(p.pp->ws + WS_WT);
  float* fl = (float*)lds;
  if (blockIdx.x < 192) {
    float* cact = fl;
    float* red = fl + 16384;
    const float* c = p.pp->in[1];
    for (int i = tid; i < 16384; i += NTHR) { int b = i >> 10, k = i & 1023; cact[k * 16 + b] = silu_(c[i]); }
    __syncthreads();
    for (int item = blockIdx.x; item < 192; item += gridDim.x) {
      const int l = item / 48, n0 = (item % 48) * 64;
      const int col = tid & 63, kq = tid >> 6;
      float acc[16];
#pragma unroll
      for (int b = 0; b < 16; ++b) acc[b] = 0.f;
      const float* w = p.pp->in[3] + (size_t)l * 1024 * 3072 + n0 + col;
#pragma unroll 16
      for (int k = kq * 128; k < kq * 128 + 128; ++k) {
        float wv = w[(size_t)k * 3072];
        const float4* cp = (const float4*)(cact + k * 16);
        float4 c0 = cp[0], c1 = cp[1], c2 = cp[2], c3 = cp[3];
        acc[0] += c0.x * wv; acc[1] += c0.y * wv; acc[2] += c0.z * wv; acc[3] += c0.w * wv;
        acc[4] += c1.x * wv; acc[5] += c1.y * wv; acc[6] += c1.z * wv; acc[7] += c1.w * wv;
        acc[8] += c2.x * wv; acc[9] += c2.y * wv; acc[10] += c2.z * wv; acc[11] += c2.w * wv;
        acc[12] += c3.x * wv; acc[13] += c3.y * wv; acc[14] += c3.z * wv; acc[15] += c3.w * wv;
      }
#pragma unroll
      for (int b = 0; b < 16; ++b) red[(kq * 16 + b) * 64 + col] = acc[b];
      __syncthreads();
      for (int o = tid; o < 1024; o += NTHR) {
        int b = o >> 6, cc = o & 63;
        float s = 0.f;
#pragma unroll
        for (int q = 0; q < 8; ++q) s += red[(q * 16 + b) * 64 + cc];
        ((float*)(p.pp->ws + WS_MOD))[((size_t)l * 16 + b) * 3072 + n0 + cc] = s + p.pp->in[4][l * 3072 + n0 + cc];
      }
      __syncthreads();
    }
  }
  __syncthreads();
  {
    const float f128 = p.pp->invf128[tid & 63], f64 = p.pp->invf64[tid & 31];
    float2* r128 = (float2*)(p.pp->ws + WS_ROPE128);
    float2* r64 = (float2*)(p.pp->ws + WS_ROPE64);
    for (int idx = blockIdx.x * NTHR + tid; idx < 2048 * 64; idx += gridDim.x * NTHR) {
      int pos = idx >> 6;
      float ang = (float)pos * f128;
      float c_, s_; sincos_d((double)ang, c_, s_);
      r128[idx] = make_float2(c_, s_);
    }
    for (int idx = blockIdx.x * NTHR + tid; idx < 2048 * 32; idx += gridDim.x * NTHR) {
      int pos = idx >> 5;
      float ang = (float)pos * f64;
      float c_, s_; sincos_d((double)ang, c_, s_);
      r64[idx] = make_float2(c_, s_);
    }
  }
  float* tl = fl;
  tconv_job(p.pp->in[5], 3720, 1024, 2560, 2, 0, 2560, WT + W_DSA_MAIN, nullptr, 1024, 0, nullptr, 0, tl, 1);
  tconv_job(p.pp->in[5], 3720, 1024, 1280, 3, 0, 0, WT + W_DSA_IDX_HI, nullptr, 1024, 0, nullptr, 0, tl, 1);
  tconv_job(p.pp->in[8], 1024, 1024, 1024, 0, 0, 1024, WT + W_DSA_OUT, nullptr, 1024, 0, nullptr, 0, tl);
  tconv_job(p.pp->in[9], 2048, 1024, 2048, 0, 0, 2048, WT + W_LRU_IN, nullptr, 1024, 0, nullptr, 0, tl);
  tconv_job(p.pp->in[17], 1024, 1024, 1024, 0, 0, 1024, WT + W_LRU_OUT, nullptr, 1024, 0, nullptr, 0, tl);
  for (int n = 0; n < 4; ++n) {
    tconv_job(p.pp->in[19] + (size_t)n * 1024 * 1024, 1024, 1024, 1024, 0, 0, 1024, WT + W_RWKV_IN + (size_t)n * 1024 * 2048, nullptr, 2048, 0, p.pp->in[18] + n * 1024, 1, tl);
    tconv_job(p.pp->in[19] + (size_t)n * 1024 * 1024, 1024, 1024, 1024, 0, 0, 1024, WT + W_RWKV_IN + (size_t)n * 1024 * 2048, nullptr, 2048, 1024, p.pp->in[18] + n * 1024, 2, tl);
  }
  tconv_job(p.pp->in[21], 64, 1024, 64, 0, 0, 64, WT + W_RWKV_L1, nullptr, 2048, 0, p.pp->in[18] + 4 * 1024, 1, tl);
  tconv_job(p.pp->in[21], 64, 1024, 64, 0, 0, 64, WT + W_RWKV_L1, nullptr, 2048, 1024, p.pp->in[18] + 4 * 1024, 2, tl);
  tconv_job(p.pp->in[24], 64, 1024, 64, 0, 0, 64, WT + W_RWKV_L1 + 64 * 2048, nullptr, 2048, 0, p.pp->in[18] + 5 * 1024, 1, tl);
  tconv_job(p.pp->in[24], 64, 1024, 64, 0, 0, 64, WT + W_RWKV_L1 + 64 * 2048, nullptr, 2048, 1024, p.pp->in[18] + 5 * 1024, 2, tl);
  tconv_job(p.pp->in[22], 1024, 64, 1024, 0, 0, 1024, WT + W_RWKV_W2, nullptr, 64, 0, nullptr, 0, tl);
  tconv_job(p.pp->in[25], 1024, 64, 1024, 0, 0, 1024, WT + W_RWKV_A2, nullptr, 64, 0, nullptr, 0, tl);
  tconv_job(p.pp->in[31], 1024, 1024, 1024, 0, 0, 1024, WT + W_RWKV_OUT, nullptr, 1024, 0, nullptr, 0, tl);
  tconv_job(p.pp->in[32], 3088, 1024, 3328, 0, 0, 3088, WT + W_GLA_IN, nullptr, 1024, 0, nullptr, 0, tl);
  tconv_job(p.pp->in[36], 1024, 1024, 1024, 0, 0, 1024, WT + W_GLA_OUT, nullptr, 1024, 0, nullptr, 0, tl);
  for (int idx = blockIdx.x * NTHR + tid; idx < 16 * 128 * 64; idx += gridDim.x * NTHR) {
    int n = idx >> 13, pp = (idx >> 6) & 127, k = idx & 63;
    int wc = pp >> 6, jn = (pp >> 4) & 3, fr = pp & 15;
    int type = jn & 1, d = wc * 32 + (jn >> 1) * 16 + fr;
    const float* src = type ? p.pp->in[14] : p.pp->in[12];
    WT[W_LRU_GATE + idx] = f2bf(src[n * 4096 + k * 64 + d]);
  }
}

template <bool SHIFT, bool F16 = false, bool IN16 = false>
__device__ __forceinline__ void norm_phase(const PAcc& p, const void* __restrict__ xin, int layer, u16* __restrict__ Hhi, u16* __restrict__ Hlo) {
  const int lane = tid_() & 63;
  const int gw = blockIdx.x * (NTHR / 64) + (tid_() >> 6);
  const int nw = gridDim.x * (NTHR / 64);
  const float* gain = p.pp->in[2] + layer * 1024;
  const float* mod = (const float*)(p.pp->ws + WS_MOD) + (size_t)layer * 16 * 3072;
  for (int row = gw; row < T_; row += nw) {
    float4 v[4];
    float ss = 0.f;
    if (IN16) {
      const uint2* xr = (const uint2*)((const u16*)xin + (size_t)row * 1024);
#pragma unroll
      for (int i = 0; i < 4; ++i) { const uint2 t = xr[i * 64 + lane]; v[i] = make_float4(bflo(t.x), bfhi(t.x), bflo(t.y), bfhi(t.y)); }
    } else {
      const float4* xr = (const float4*)((const float*)xin + (size_t)row * 1024);
#pragma unroll
      for (int i = 0; i < 4; ++i) v[i] = xr[i * 64 + lane];
    }
#pragma unroll
    for (int i = 0; i < 4; ++i) ss += v[i].x * v[i].x + v[i].y * v[i].y + v[i].z * v[i].z + v[i].w * v[i].w;
#pragma unroll
    for (int m = 32; m >= 1; m >>= 1) ss += __shfl_xor(ss, m);
    const float rstd = rsqrtf(ss * (1.f / 1024.f) + 1e-6f);
    const float* mb = mod + (size_t)(row >> 11) * 3072;
#pragma unroll
    for (int i = 0; i < 4; ++i) {
      const int c = i * 256 + lane * 4;
      float4 g = *(const float4*)(gain + c);
      float4 sh = *(const float4*)(mb + c);
      float4 sc = *(const float4*)(mb + 1024 + c);
      float y0 = v[i].x * rstd * g.x * (1.f + sc.x) + sh.x;
      float y1 = v[i].y * rstd * g.y * (1.f + sc.y) + sh.y;
      float y2 = v[i].z * rstd * g.z * (1.f + sc.z) + sh.z;
      float y3 = v[i].w * rstd * g.w * (1.f + sc.w) + sh.w;
      uint2 o;
      if (F16) { o.x = packh2(y0, y1); o.y = packh2(y2, y3); }
      else { o.x = pack2(y0, y1); o.y = pack2(y2, y3); }
      if (SHIFT) {
        *(uint2*)(Hhi + (size_t)row * 2048 + c) = o;
        if (((row + 1) & 2047) != 0) *(uint2*)(Hhi + (size_t)(row + 1) * 2048 + 1024 + c) = o;
        if ((row & 2047) == 0) *(uint2*)(Hhi + (size_t)row * 2048 + 1024 + c) = make_uint2(0u, 0u);
      } else {
        *(uint2*)(Hhi + (size_t)row * 1024 + c) = o;
      }
      if (!SHIFT && Hlo) {
        uint2 l;
        l.x = packh2(y0 - hlo(o.x), y1 - hhi(o.x));
        l.y = packh2(y2 - hlo(o.y), y3 - hhi(o.y));
        *(uint2*)(Hlo + (size_t)row * 1024 + c) = l;
      }
    }
  }
}

enum { EPI_PLAIN = 0, EPI_DSA_MAIN, EPI_DSA_IDX, EPI_RESID, EPI_RWKV_L1, EPI_RWKV_W, EPI_RWKV_A };
struct EpiP {
  u16* o16; u16* o16b; u16* o16c; u16* o16d; float* of; const float* f0; const float* f1; const float* f2; const float* f3;
  int ldc; int nvalid;
};
constexpr int LROW = 40;

template <int EPI>
__device__ __forceinline__ void gemm_epilogue(const EpiP& e, const PAcc& p, f32x4 (&acc)[4][4], int rowbase, int colbase, int nt, int wc, int fr, int fq) {
  if (EPI == EPI_PLAIN) {
#pragma unroll
    for (int i = 0; i < 4; ++i)
#pragma unroll
      for (int j = 0; j < 4; ++j) {
        const int col = colbase + j * 16 + fr;
        if (col < e.nvalid) {
#pragma unroll
          for (int r = 0; r < 4; ++r) e.o16[(size_t)(rowbase + i * 16 + fq * 4 + r) * e.ldc + col] = f2bf(acc[i][j][r]);
        }
      }
  } else if (EPI == EPI_DSA_MAIN) {
    if (nt < 10) {
      const float* gain = (nt < 8) ? e.f0 : e.f1;
      const float g0 = gain[fr], g1 = gain[16 + fr], g2 = gain[32 + fr], g3 = gain[48 + fr];
      const float2* rope = (const float2*)(p.pp->ws + WS_ROPE64);
#pragma unroll
      for (int i = 0; i < 4; ++i)
#pragma unroll
        for (int r = 0; r < 4; ++r) {
          float v0 = acc[i][0][r], v1 = acc[i][1][r], v2 = acc[i][2][r], v3 = acc[i][3][r];
          float ss = v0 * v0 + v1 * v1 + v2 * v2 + v3 * v3;
          ss += __shfl_xor(ss, 1); ss += __shfl_xor(ss, 2); ss += __shfl_xor(ss, 4); ss += __shfl_xor(ss, 8);
          const float rstd = rsqrtf(ss * (1.f / 64.f) + 1e-6f);
          v0 *= rstd * g0; v1 *= rstd * g1; v2 *= rstd * g2; v3 *= rstd * g3;
          const int row = rowbase + i * 16 + fq * 4 + r;
          const int pos = row & 2047;
          const float2 ca = rope[pos * 32 + fr], cb = rope[pos * 32 + 16 + fr];
          const float o0 = v0 * ca.x - v2 * ca.y, o2 = v2 * ca.x + v0 * ca.y;
          const float o1 = v1 * cb.x - v3 * cb.y, o3 = v3 * cb.x + v1 * cb.y;
          u16* d = e.o16 + (size_t)row * 2560 + colbase + fr;
          d[0] = f2bf(o0); d[16] = f2bf(o1); d[32] = f2bf(o2); d[48] = f2bf(o3);
        }
    } else {
#pragma unroll
      for (int i = 0; i < 4; ++i)
#pragma unroll
        for (int j = 0; j < 4; ++j)
#pragma unroll
          for (int r = 0; r < 4; ++r) e.o16[(size_t)(rowbase + i * 16 + fq * 4 + r) * 2560 + colbase + j * 16 + fr] = f2bf(acc[i][j][r]);
    }
  } else if (EPI == EPI_DSA_IDX) {
    if (nt < 9) {
      const float2* rope = (const float2*)(p.pp->ws + WS_ROPE128);
#pragma unroll
      for (int i = 0; i < 4; ++i)
#pragma unroll
        for (int r = 0; r < 4; ++r) {
          const int row = rowbase + i * 16 + fq * 4 + r;
          const int pos = row & 2047;
#pragma unroll
          for (int jj = 0; jj < 2; ++jj) {
            const int ii = wc * 32 + jj * 16 + fr;
            const float2 cs = rope[pos * 64 + ii];
            const float x1 = acc[i][jj][r], x2 = acc[i][jj + 2][r];
            const float o1 = x1 * cs.x - x2 * cs.y, o2 = x2 * cs.x + x1 * cs.y;
            const u16 h1 = f2bf(o1), h2 = f2bf(o2);
            const u16 l1 = f2bf(o1 - bf2f(h1)), l2 = f2bf(o2 - bf2f(h2));
            if (nt < 8) {
              size_t o = (size_t)row * 1024 + nt * 128 + ii;
              e.o16[o] = h1; e.o16[o + 64] = h2; e.o16b[o] = l1; e.o16b[o + 64] = l2;
            } else {
              size_t o = (size_t)row * 128 + ii;
              e.o16c[o] = h1; e.o16c[o + 64] = h2; e.o16d[o] = l1; e.o16d[o + 64] = l2;
            }
          }
        }
    } else {
      if (wc == 0 && fr < 8) {
#pragma unroll
        for (int i = 0; i < 4; ++i)
#pragma unroll
          for (int r = 0; r < 4; ++r) e.of[(size_t)(rowbase + i * 16 + fq * 4 + r) * 8 + fr] = acc[i][0][r] * 0.03125f;
      }
    }
  } else if (EPI == EPI_RESID) {
#pragma unroll
    for (int i = 0; i < 4; ++i)
#pragma unroll
      for (int j = 0; j < 4; ++j) {
        const int col = colbase + j * 16 + fr;
#pragma unroll
        for (int r = 0; r < 4; ++r) {
          const int row = rowbase + i * 16 + fq * 4 + r;
          const float gate = e.f1[(size_t)(row >> 11) * 3072 + 2048 + col];
          const size_t o = (size_t)row * 1024 + col;
          e.of[o] = e.f0[o] + gate * acc[i][j][r];
        }
      }
  } else if (EPI == EPI_RWKV_L1) {
#pragma unroll
    for (int i = 0; i < 4; ++i)
#pragma unroll
      for (int j = 0; j < 4; ++j) {
        const int col = colbase + j * 16 + fr;
#pragma unroll
        for (int r = 0; r < 4; ++r) {
          float v = acc[i][j][r];
          if (col < 64) v = 1.f - 2.f * __builtin_amdgcn_rcpf(1.f + __expf(2.f * v));
          e.o16[(size_t)(rowbase + i * 16 + fq * 4 + r) * 128 + col] = f2bf(v);
        }
      }
  } else if (EPI == EPI_RWKV_W) {
#pragma unroll
    for (int i = 0; i < 4; ++i)
#pragma unroll
      for (int j = 0; j < 4; ++j) {
        const int col = colbase + j * 16 + fr;
        const float w0 = e.f0[col];
#pragma unroll
        for (int r = 0; r < 4; ++r) {
          const float w = w0 + acc[i][j][r];
          e.of[(size_t)(rowbase + i * 16 + fq * 4 + r) * 1024 + col] = sigmoid_(w) * 0.60653065971f;
        }
      }
  } else if (EPI == EPI_RWKV_A) {
#pragma unroll
    for (int i = 0; i < 4; ++i)
#pragma unroll
      for (int j = 0; j < 4; ++j) {
        const int col = colbase + j * 16 + fr;
        const float a0 = e.f0[col];
#pragma unroll
        for (int r = 0; r < 4; ++r)
          e.o16[(size_t)(rowbase + i * 16 + fq * 4 + r) * 1024 + col] = f2bf(sigmoid_(a0 + acc[i][j][r]));
      }
  }
}

template <int EPI>
__device__ __forceinline__ void gemm_phase(const PAcc& p, const u16* A0, const u16* A1, const u16* A2, const u16* B0, const u16* B1, const u16* B2,
                           int lda, int ldb, int kseg, int nseg, int shiftmask, int ntn, const EpiP& e, char* ldsc) {
  const int tid = tid_(), lane = tid & 63, wave = tid >> 6;
  const int wr = wave >> 1, wc = wave & 1, fr = lane & 15, fq = lane >> 4;
  u16* As = (u16*)ldsc;
  u16* Bs = As + 2 * 256 * LROW;
  const int kps = kseg >> 5;
  const int nk = nseg * kps;
  const int ntiles = 128 * ntn;
  const int lrow = tid >> 2, lkc = (tid & 3) * 8;
  for (int tile = blockIdx.x; tile < ntiles; tile += gridDim.x) {
    const int mt = tile / ntn, nt = tile - mt * ntn;
    const int m0 = mt * 256, n0 = nt * 128;
    f32x4 acc[4][4];
#pragma unroll
    for (int i = 0; i < 4; ++i)
#pragma unroll
      for (int j = 0; j < 4; ++j) acc[i][j] = (f32x4){0.f, 0.f, 0.f, 0.f};
    uint4 ra0, ra1, rb;
#define GLOAD(ks_)                                                                           \
  {                                                                                          \
    const int s_ = (ks_) / kps;                                                              \
    const int kk_ = ((ks_) - s_ * kps) << 5;                                                 \
    const u16* Ap_ = s_ == 0 ? A0 : (s_ == 1 ? A1 : A2);                                     \
    const u16* Bp_ = s_ == 0 ? B0 : (s_ == 1 ? B1 : B2);                                     \
    const int sh_ = (shiftmask >> s_) & 1;                                                   \
    const int g0_ = m0 + lrow, g1_ = m0 + 128 + lrow;                                        \
    ra0 = (sh_ && (g0_ & 2047) == 0) ? make_uint4(0, 0, 0, 0) : *(const uint4*)(Ap_ + (size_t)(g0_ - sh_) * lda + kk_ + lkc); \
    ra1 = (sh_ && (g1_ & 2047) == 0) ? make_uint4(0, 0, 0, 0) : *(const uint4*)(Ap_ + (size_t)(g1_ - sh_) * lda + kk_ + lkc); \
    rb = *(const uint4*)(Bp_ + (size_t)(n0 + lrow) * ldb + kk_ + lkc);                       \
  }
#define LSTORE(buf_)                                                                         \
  {                                                                                          \
    *(uint4*)(As + ((buf_) * 256 + lrow) * LROW + lkc) = ra0;                                \
    *(uint4*)(As + ((buf_) * 256 + 128 + lrow) * LROW + lkc) = ra1;                          \
    *(uint4*)(Bs + ((buf_) * 128 + lrow) * LROW + lkc) = rb;                                 \
  }
    GLOAD(0);
    LSTORE(0);
    __syncthreads();
    for (int ks = 0; ks < nk; ++ks) {
      const int buf = ks & 1;
      if (ks + 1 < nk) GLOAD(ks + 1);
      bf16x8 af[4], bfr[4];
#pragma unroll
      for (int i = 0; i < 4; ++i) af[i] = *(const bf16x8*)(As + (buf * 256 + wr * 64 + i * 16 + fr) * LROW + fq * 8);
#pragma unroll
      for (int j = 0; j < 4; ++j) bfr[j] = *(const bf16x8*)(Bs + (buf * 128 + wc * 64 + j * 16 + fr) * LROW + fq * 8);
#pragma unroll
      for (int i = 0; i < 4; ++i)
#pragma unroll
        for (int j = 0; j < 4; ++j) acc[i][j] = mfma16(af[i], bfr[j], acc[i][j]);
      if (ks + 1 < nk) LSTORE(buf ^ 1);
      __syncthreads();
    }
#undef GLOAD
#undef LSTORE
    gemm_epilogue<EPI>(e, p, acc, m0 + wr * 64, n0 + wc * 64, nt, wc, fr, fq);
  }
}


namespace pg8 {
#define PG8_LAS __attribute__((address_space(3)))
typedef unsigned u32x4 __attribute__((ext_vector_type(4)));
constexpr int BM = 256, BK = 64, HALF = 128, HTB = HALF * BK * 2, NXCD = 8, WGM = 8;
__device__ __forceinline__ int lds_byte(int r, int c) { const int st = (r >> 4) * 2 + (c >> 5), rr = r & 15, cc = c & 31, ob = rr * 64 + cc * 2; return st * 1024 + (ob ^ (((ob >> 9) & 1) << 5)); }
__device__ __forceinline__ void stage_rc(int b, int& R, int& C) { const int st = b / 1024, sb = b % 1024, swz = sb ^ (((sb >> 9) & 1) << 5); R = (st >> 1) * 16 + swz / 64; C = (st & 1) * 32 + (swz % 64) / 2; }
__device__ __forceinline__ int perm32(int rho) { const int n = rho >> 4, i = rho & 15; return 8 * (i >> 2) + 4 * n + (i & 3); }
struct Unit { int pm, pn; };
struct GemmD { const u16 *A0, *A1, *A2, *B0, *B1, *B2; int lda, ldb, lgnts, nseg, M, N; };
struct StaticOrder {
  int nM, nN, nwg, G, c;
  __device__ void init(int M, int N, int G_, int c_) { nM = M / BM; nN = N / BM; nwg = nM * nN; G = G_; c = c_; }
  __device__ bool next(int i, Unit& u) const {
    const long L = (long)i * G + c; if (L >= nwg) return false;
    int wgid = (int)L; { const int q = nwg / NXCD, r = nwg % NXCD, xcd = wgid % NXCD, off = wgid / NXCD; wgid = (xcd < r ? xcd * (q + 1) : r * (q + 1) + (xcd - r) * q) + off; }
    const int nig = WGM * nN, gid = wgid / nig, fm = gid * WGM, gsz = (nM - fm) < WGM ? (nM - fm) : WGM;
    u.pm = fm + ((wgid % nig) % gsz); u.pn = (wgid % nig) / gsz; return true;
  }
};
__device__ __forceinline__ unsigned cvt_pk_bf16(float lo, float hi) { unsigned r; asm volatile("v_cvt_pk_bf16_f32 %0, %1, %2" : "=v"(r) : "v"(lo), "v"(hi)); return r; }

struct EpiPlain {
  static constexpr bool PERM = true;
  u16* O; int ldc; int nvalid;
  __device__ __forceinline__ void operator()(const f32x4 (&acc)[2][2][4][2], const Unit& u, int wr, int wc, int fr, int fq) const {
    asm volatile("" : "+v"(fr), "+v"(fq));
    const int row0 = u.pm * BM + wr * 64 + fr, col0 = u.pn * BM + wc * 32 + 8 * fq;
#pragma unroll
    for (int ai = 0; ai < 2; ++ai)
#pragma unroll
      for (int m = 0; m < 4; ++m) {
        u16* rowp = O + (size_t)(row0 + ai * HALF + m * 16) * ldc;
#pragma unroll
        for (int bj = 0; bj < 2; ++bj) {
          const int col = col0 + bj * HALF;
          if (col < nvalid) {
            const f32x4 v0 = acc[ai][bj][m][0], v1 = acc[ai][bj][m][1];
            u32x4 w; w.x = cvt_pk_bf16(v0[0], v0[1]); w.y = cvt_pk_bf16(v0[2], v0[3]); w.z = cvt_pk_bf16(v1[0], v1[1]); w.w = cvt_pk_bf16(v1[2], v1[3]);
            *(u32x4*)(rowp + col) = w;
          }
        }
      }
  }
};
template <bool IN16, bool OUT16>
struct EpiResid {
  static constexpr bool PERM = true;
  void* out; const void* xin; const float* mod;
  __device__ __forceinline__ void operator()(const f32x4 (&acc)[2][2][4][2], const Unit& u, int wr, int wc, int fr, int fq) const {
    asm volatile("" : "+v"(fr), "+v"(fq));
    const int row0 = u.pm * BM + wr * 64 + fr, col0 = u.pn * BM + wc * 32 + 8 * fq;
#pragma unroll
    for (int ai = 0; ai < 2; ++ai)
#pragma unroll
      for (int m = 0; m < 4; ++m) {
        const int row = row0 + ai * HALF + m * 16;
        const float* gp = mod + (size_t)(row >> 11) * 3072 + 2048;
#pragma unroll
        for (int bj = 0; bj < 2; ++bj) {
          const int col = col0 + bj * HALF;
          const size_t o = (size_t)row * 1024 + col;
          const f32x4 g0 = *(const f32x4*)(gp + col), g1 = *(const f32x4*)(gp + col + 4);
          f32x4 x0, x1;
          if (IN16) {
            const u32x4 xv = *(const u32x4*)((const u16*)xin + o);
            x0 = (f32x4){bflo(xv.x), bfhi(xv.x), bflo(xv.y), bfhi(xv.y)};
            x1 = (f32x4){bflo(xv.z), bfhi(xv.z), bflo(xv.w), bfhi(xv.w)};
          } else {
            x0 = *(const f32x4*)((const float*)xin + o); x1 = *(const f32x4*)((const float*)xin + o + 4);
          }
          const f32x4 y0 = x0 + g0 * acc[ai][bj][m][0], y1 = x1 + g1 * acc[ai][bj][m][1];
          if (OUT16) {
            u32x4 w; w.x = cvt_pk_bf16(y0[0], y0[1]); w.y = cvt_pk_bf16(y0[2], y0[3]); w.z = cvt_pk_bf16(y1[0], y1[1]); w.w = cvt_pk_bf16(y1[2], y1[3]);
            *(u32x4*)((u16*)out + o) = w;
          } else {
            *(f32x4*)((float*)out + o) = y0; *(f32x4*)((float*)out + o + 4) = y1;
          }
        }
      }
  }
};
struct EpiDsaMain {
  static constexpr bool PERM = true;
  u16* O; const float* qg; const float* kg; const float2* rope; u16* VT;
  __device__ __forceinline__ void operator()(const f32x4 (&acc)[2][2][4][2], const Unit& u, int wr, int wc, int fr, int fq) const {
    asm volatile("" : "+v"(fr), "+v"(fq));
    const int row0 = u.pm * BM + wr * 64 + fr;
    if (u.pn <= 4) {
      const float* gain = (u.pn < 4) ? qg : kg;
      const int cb = u.pn * 256 + wc * 64 + 8 * fq;
#pragma unroll
      for (int ai = 0; ai < 2; ++ai)
#pragma unroll
        for (int m = 0; m < 4; ++m) {
          const int row = row0 + ai * HALF + m * 16;
          float ss = 0.f;
#pragma unroll
          for (int n = 0; n < 2; ++n)
#pragma unroll
            for (int j = 0; j < 4; ++j) { const float x = acc[ai][0][m][n][j], y = acc[ai][1][m][n][j]; ss += x * x + y * y; }
          ss += __shfl_xor(ss, 16); ss += __shfl_xor(ss, 32);
          const float rstd = rsqrtf(ss * (1.f / 64.f) + 1e-6f);
          const float2* rp = rope + (row & 2047) * 32 + 8 * fq;
          u16* d = O + (size_t)row * 2560 + cb;
#pragma unroll
          for (int n = 0; n < 2; ++n) {
            float ol[4], oh[4];
#pragma unroll
            for (int j = 0; j < 4; ++j) {
              const int e = 4 * n + j;
              const float2 cs = rp[e];
              const float xn = acc[ai][0][m][n][j] * rstd * gain[8 * fq + e], yn = acc[ai][1][m][n][j] * rstd * gain[32 + 8 * fq + e];
              ol[j] = xn * cs.x - yn * cs.y; oh[j] = yn * cs.x + xn * cs.y;
            }
            uint2 w; w.x = cvt_pk_bf16(ol[0], ol[1]); w.y = cvt_pk_bf16(ol[2], ol[3]);
            *(uint2*)(d + 4 * n) = w;
            w.x = cvt_pk_bf16(oh[0], oh[1]); w.y = cvt_pk_bf16(oh[2], oh[3]);
            *(uint2*)(d + 32 + 4 * n) = w;
          }
        }
    } else if (u.pn == 5) {
#pragma unroll
      for (int ai = 0; ai < 2; ++ai)
#pragma unroll
        for (int m = 0; m < 4; ++m) {
          const int row = row0 + ai * HALF + m * 16;
          u16* vb = VT + (size_t)(row >> 11) * 256 * 2048 + (row & 2047);
#pragma unroll
          for (int bj = 0; bj < 2; ++bj)
#pragma unroll
            for (int n = 0; n < 2; ++n)
#pragma unroll
              for (int j = 0; j < 4; ++j) vb[(size_t)(128 * bj + 32 * wc + 8 * fq + 4 * n + j) * 2048] = f2bf(acc[ai][bj][m][n][j]);
        }
    } else {
      const int col0 = u.pn * BM + wc * 32 + 8 * fq;
#pragma unroll
      for (int ai = 0; ai < 2; ++ai)
#pragma unroll
        for (int m = 0; m < 4; ++m) {
          u16* rowp = O + (size_t)(row0 + ai * HALF + m * 16) * 2560 + col0;
#pragma unroll
          for (int bj = 0; bj < 2; ++bj) {
            const f32x4 v0 = acc[ai][bj][m][0], v1 = acc[ai][bj][m][1];
            u32x4 w; w.x = cvt_pk_bf16(v0[0], v0[1]); w.y = cvt_pk_bf16(v0[2], v0[3]); w.z = cvt_pk_bf16(v1[0], v1[1]); w.w = cvt_pk_bf16(v1[2], v1[3]);
            *(u32x4*)(rowp + bj * HALF) = w;
          }
        }
    }
  }
};
struct EpiDsaIdx {
  static constexpr bool PERM = true;
  u16 *qh, *ql, *kh, *kl; float* wi; const float2* rope;
  __device__ __forceinline__ void operator()(const f32x4 (&acc)[2][2][4][2], const Unit& u, int wr, int wc, int fr, int fq) const {
    asm volatile("" : "+v"(fr), "+v"(fq));
    const int row0 = u.pm * BM + wr * 64 + fr;
    if (u.pn < 4 || wc < 2) {
      const int dl = 32 * (wc & 1) + 8 * fq;
      u16* dh; size_t ld; int cb;
      if (u.pn < 4) { dh = qh; ld = 1024; cb = (u.pn * 2 + (wc >> 1)) * 128 + dl; }
      else { dh = kh; ld = 128; cb = dl; }
#pragma unroll
      for (int ai = 0; ai < 2; ++ai)
#pragma unroll
        for (int m = 0; m < 4; ++m) {
          const int row = row0 + ai * HALF + m * 16;
          const float2* rp = rope + (row & 2047) * 64 + dl;
          const size_t o = (size_t)row * ld + cb;
#pragma unroll
          for (int n = 0; n < 2; ++n) {
            float o1[4], o2[4];
#pragma unroll
            for (int j = 0; j < 4; ++j) {
              const float2 cs = rp[4 * n + j];
              const float x = acc[ai][0][m][n][j], y = acc[ai][1][m][n][j];
              o1[j] = x * cs.x - y * cs.y; o2[j] = y * cs.x + x * cs.y;
            }
            uint2 h1, h2;
            h1.x = packh2(o1[0], o1[1]); h1.y = packh2(o1[2], o1[3]);
            h2.x = packh2(o2[0], o2[1]); h2.y = packh2(o2[2], o2[3]);
            *(uint2*)(dh + o + 4 * n) = h1; *(uint2*)(dh + o + 64 + 4 * n) = h2;
          }
        }
    } else if (wc == 2 && fq == 0) {
#pragma unroll
      for (int ai = 0; ai < 2; ++ai)
#pragma unroll
        for (int m = 0; m < 4; ++m) {
          const int row = row0 + ai * HALF + m * 16;
          *(f32x4*)(wi + (size_t)row * 8) = acc[ai][0][m][0] * 0.03125f;
          *(f32x4*)(wi + (size_t)row * 8 + 4) = acc[ai][0][m][1] * 0.03125f;
        }
    }
  }
};

template <class Epi, bool F16>
__device__ __forceinline__ void gemm_phase(PG8_LAS unsigned char* lds, const GemmD g, const StaticOrder& S, const Epi& E) {
  const int tid = tid_(), wid = __builtin_amdgcn_readfirstlane(tid >> 6), lane = tid & 63, wr = wid >> 2, wc = wid & 3, fr = lane & 15, fq = lane >> 4;
  const int lg = g.lgnts, nts = 1 << lg, nt = nts * g.nseg;
  unsigned voffA[2], voffB[2];
#pragma unroll
  for (int i = 0; i < 2; ++i) { int R, C; stage_rc(tid * 16 + i * 8192, R, C); const int Rb = Epi::PERM ? ((R & ~31) + perm32(R & 31)) : R;
    voffA[i] = (unsigned)(R * g.lda + C) * 2u; voffB[i] = (unsigned)(Rb * g.ldb + C) * 2u; }
  const size_t kstep = (size_t)(BK * 2);
  const size_t hstepA = (size_t)HALF * g.lda * 2, hstepB = (size_t)HALF * g.ldb * 2;
  const size_t tstepA = 2 * hstepA, tstepB = 2 * hstepB;
  const unsigned ldsw = (unsigned)wid * 1024u;
  const int aoff = lds_byte(wr * 64 + fr, fq * 8), boff = lds_byte(wc * 32 + fr, fq * 8);
#define PG8_APTR(pm_, t_) ((const char*)((((t_) >> lg) == 0) ? g.A0 : ((((t_) >> lg) == 1) ? g.A1 : g.A2)) + (size_t)(pm_) * tstepA + (size_t)((t_) & (nts - 1)) * kstep)
#define PG8_BPTR(pn_, t_) ((const char*)((((t_) >> lg) == 0) ? g.B0 : ((((t_) >> lg) == 1) ? g.B1 : g.B2)) + (size_t)(pn_) * tstepB + (size_t)((t_) & (nts - 1)) * kstep)
#define PG8_SA(b, h) (((b) * 2 + (h)) * HTB)
#define PG8_SB(b, h) ((4 + (b) * 2 + (h)) * HTB)
#define PG8_STAGE(bufoff, gbase, voff) do { _Pragma("unroll") for (int _i = 0; _i < 2; ++_i) \
    __builtin_amdgcn_global_load_lds((const unsigned*)((const char*)(gbase) + (voff)[_i]), (PG8_LAS unsigned*)(lds + (bufoff) + ldsw + _i * 8192), 16, 0, 0); } while (0)
#define PG8_LDA(dst, b, h) do { _Pragma("unroll") for (int m = 0; m < 4; ++m) _Pragma("unroll") for (int k = 0; k < 2; ++k) dst[m][k] = *(const PG8_LAS bf16x8*)(lds + PG8_SA(b, h) + aoff + m * 2048 + k * 1024); } while (0)
#define PG8_LDB(dst, b, h) do { _Pragma("unroll") for (int n = 0; n < 2; ++n) _Pragma("unroll") for (int k = 0; k < 2; ++k) dst[n][k] = *(const PG8_LAS bf16x8*)(lds + PG8_SB(b, h) + boff + n * 2048 + k * 1024); } while (0)
#define PG8_MMA(ai, bj, At, Bt) do { __builtin_amdgcn_s_setprio(1); _Pragma("unroll") for (int m = 0; m < 4; ++m) _Pragma("unroll") for (int n = 0; n < 2; ++n) _Pragma("unroll") for (int k = 0; k < 2; ++k) \
    acc[ai][bj][m][n] = F16 ? mfma16h(Bt[n][k], At[m][k], acc[ai][bj][m][n]) : __builtin_amdgcn_mfma_f32_16x16x32_bf16(Bt[n][k], At[m][k], acc[ai][bj][m][n], 0, 0, 0); __builtin_amdgcn_s_setprio(0); } while (0)
#define PG8_WAIT_V(n) asm volatile("s_waitcnt vmcnt(" #n ")" ::: "memory")
#define PG8_WAIT_L(n) asm volatile("s_waitcnt lgkmcnt(" #n ")" ::: "memory")
#define PG8_BAR __builtin_amdgcn_s_barrier()
#define PG8_SCHED __builtin_amdgcn_sched_barrier(0)
  Unit cur, nxt; int ui = 0;
  if (!S.next(0, cur)) return;
  f32x4 acc[2][2][4][2];
#pragma unroll
  for (int a = 0; a < 2; ++a)
#pragma unroll
    for (int b = 0; b < 2; ++b)
#pragma unroll
      for (int m = 0; m < 4; ++m)
#pragma unroll
        for (int n = 0; n < 2; ++n) acc[a][b][m][n] = (f32x4){0.f, 0.f, 0.f, 0.f};
  bf16x8 At[4][2], B0[2][2], B1[2][2];
  {
    const char* cA = PG8_APTR(cur.pm, 0); const char* cB = PG8_BPTR(cur.pn, 0);
    PG8_STAGE(PG8_SB(0, 0), cB, voffB); PG8_STAGE(PG8_SA(0, 0), cA, voffA); PG8_STAGE(PG8_SB(0, 1), cB + hstepB, voffB); PG8_STAGE(PG8_SA(0, 1), cA + hstepA, voffA);
    if (wr == 1) PG8_BAR;
    PG8_WAIT_V(4); PG8_BAR;
    PG8_STAGE(PG8_SB(1, 0), cB + kstep, voffB); PG8_STAGE(PG8_SA(1, 0), cA + kstep, voffA); PG8_STAGE(PG8_SB(1, 1), cB + hstepB + kstep, voffB);
    PG8_WAIT_V(6); PG8_BAR;
  }
  for (;;) {
    const bool has_next = S.next(ui + 1, nxt);
    const int npm = has_next ? nxt.pm : cur.pm, npn = has_next ? nxt.pn : cur.pn;
    for (int t = 0; t < nt; t += 2) {
      const bool last = (t == nt - 2);
      const char* a1 = PG8_APTR(cur.pm, t + 1);
      const char* a2 = last ? PG8_APTR(npm, 0) : PG8_APTR(cur.pm, t + 2);
      const char* b2 = last ? PG8_BPTR(npn, 0) : PG8_BPTR(cur.pn, t + 2);
      const char* a3 = a2 + kstep; const char* b3 = b2 + kstep;
      PG8_LDB(B0, 0, 0); PG8_SCHED; PG8_LDA(At, 0, 0); PG8_STAGE(PG8_SA(1, 1), a1 + hstepA, voffA);
      PG8_WAIT_L(8); PG8_BAR; PG8_WAIT_L(0); PG8_MMA(0, 0, At, B0); PG8_BAR; PG8_SCHED;
      PG8_LDB(B1, 0, 1); PG8_STAGE(PG8_SB(0, 0), b2, voffB);
      PG8_BAR; PG8_WAIT_L(0); PG8_MMA(0, 1, At, B1); PG8_BAR;
      PG8_LDA(At, 0, 1); PG8_STAGE(PG8_SA(0, 0), a2, voffA);
      PG8_BAR; PG8_WAIT_L(0); PG8_MMA(1, 0, At, B0); PG8_BAR; PG8_SCHED;
      PG8_STAGE(PG8_SB(0, 1), b2 + hstepB, voffB);
      PG8_WAIT_V(6); PG8_BAR; PG8_MMA(1, 1, At, B1); PG8_BAR;
      PG8_LDB(B0, 1, 0); PG8_SCHED; PG8_LDA(At, 1, 0); PG8_STAGE(PG8_SA(0, 1), a2 + hstepA, voffA);
      PG8_WAIT_L(8); PG8_BAR; PG8_WAIT_L(0); PG8_MMA(0, 0, At, B0); PG8_BAR; PG8_SCHED;
      PG8_LDB(B1, 1, 1); PG8_STAGE(PG8_SB(1, 0), b3, voffB);
      PG8_BAR; PG8_WAIT_L(0); PG8_MMA(0, 1, At, B1); PG8_BAR;
      PG8_LDA(At, 1, 1); PG8_STAGE(PG8_SA(1, 0), a3, voffA);
      PG8_BAR; PG8_WAIT_L(0); PG8_MMA(1, 0, At, B0); PG8_BAR; PG8_SCHED;
      PG8_STAGE(PG8_SB(1, 1), b3 + hstepB, voffB);
      PG8_WAIT_V(6); PG8_BAR; PG8_MMA(1, 1, At, B1); PG8_BAR;
    }
    E(acc, cur, wr, wc, fr, fq);
    if (!has_next) break;
#pragma unroll
    for (int a = 0; a < 2; ++a)
#pragma unroll
      for (int b = 0; b < 2; ++b)
#pragma unroll
        for (int m = 0; m < 4; ++m)
#pragma unroll
          for (int n = 0; n < 2; ++n) acc[a][b][m][n] = (f32x4){0.f, 0.f, 0.f, 0.f};
    cur = nxt; ++ui;
  }
  PG8_WAIT_V(0);
  if (wr == 0) PG8_BAR;
  PG8_BAR;
#undef PG8_APTR
#undef PG8_BPTR
#undef PG8_SA
#undef PG8_SB
#undef PG8_STAGE
#undef PG8_LDA
#undef PG8_LDB
#undef PG8_MMA
#undef PG8_WAIT_V
#undef PG8_WAIT_L
#undef PG8_BAR
#undef PG8_SCHED
}
template <class Epi, bool F16 = false>
__device__ __forceinline__ void run(char* lds, const u16* A0, const u16* A1, const u16* A2, const u16* B0, const u16* B1, const u16* B2,
                                    int lda, int ldb, int lgnts, int nseg, int N, const Epi& E) {
  GemmD g; g.A0 = A0; g.A1 = A1; g.A2 = A2; g.B0 = B0; g.B1 = B1; g.B2 = B2; g.lda = lda; g.ldb = ldb; g.lgnts = lgnts; g.nseg = nseg; g.M = T_; g.N = N;
  StaticOrder S; S.init(T_, N, (int)gridDim.x, (int)blockIdx.x);
  gemm_phase<Epi, F16>((PG8_LAS unsigned char*)lds, g, S, E);
}
}


template <int NE>
__device__ __forceinline__ void topk_row(const float* __restrict__ srow, int qpos, int lane, unsigned* __restrict__ mrow) {
  unsigned uk[NE];
#pragma unroll
  for (int e = 0; e < NE; ++e) {
    const int key = e * 64 + lane;
    const float v = srow[key];
    unsigned uu = __float_as_uint(v);
    uu = (uu & 0x80000000u) ? ~uu : (uu | 0x80000000u);
    uk[e] = (key <= qpos) ? uu : 0u;
  }
  unsigned prefix = 0u;
  for (int bit = 31; bit >= 0; --bit) {
    const unsigned cand = prefix | (1u << bit);
    int cnt = 0;
#pragma unroll
    for (int e = 0; e < NE; ++e) cnt += __popcll(__ballot(uk[e] >= cand));
    if (cnt >= 256) { prefix = cand; if (cnt == 256) break; }
  }
  int cgt = 0;
#pragma unroll
  for (int e = 0; e < NE; ++e) cgt += __popcll(__ballot(uk[e] > prefix));
  const int need = 256 - cgt;
  int eqused = 0;
  const unsigned long long lt = (1ull << lane) - 1ull;
#pragma unroll
  for (int e = 0; e < NE; ++e) {
    const bool gt = uk[e] > prefix, eq = uk[e] == prefix;
    const unsigned long long meq = __ballot(eq);
    const bool take = gt || (eq && (eqused + __popcll(meq & lt)) < need);
    const unsigned long long ms = __ballot(take);
    if (lane == 0) { mrow[2 * e] = (unsigned)ms; mrow[2 * e + 1] = (unsigned)(ms >> 32); }
    eqused += __popcll(meq);
  }
}

__device__ __forceinline__ void dsa_unit_phase(const PAcc& p, char* lds, bool st) {
  u16* qihi = (u16*)lds;
  unsigned* MASK = (unsigned*)lds;
  const u16* VT = (const u16*)(p.pp->ws + DSA_VT);
  float* wis = (float*)(lds + 73728);
  u16* QKVG = (u16*)(p.pp->ws + DSA_QKVG);
  const u16* QIH = (const u16*)(p.pp->ws + DSA_QIHI);
  const u16* KIH = (const u16*)(p.pp->ws + DSA_KIHI);
  const float* WI = (const float*)(p.pp->ws + DSA_WI);
  float* scr = (float*)(p.pp->ws + DSA_SCR) + (size_t)blockIdx.x * 16 * 2048;

  const bool xmap = (gridDim.x == 256);
  for (int u = blockIdx.x; u < 2048; u += gridDim.x) {
    const int tid = tid_(), lane = tid & 63, wave = tid >> 6, fr = lane & 15, fq = lane >> 4;
    int qt, b;
    if (xmap) { const int v = (blockIdx.x >> 3) + 32 * (u >> 8); b = 2 * (blockIdx.x & 7) + (v & 1); qt = 127 - (v >> 1); }
    else { qt = 127 - (u >> 4); b = u & 15; }
    const int q0 = qt * 16;
    const size_t tok0 = (size_t)b * 2048 + q0;
    const bool full = (q0 < 256);
    if (!full) {
#pragma unroll
      for (int i = 0; i < 4; ++i) {
        const int c = tid + i * NTHR;
        const int row = c >> 7, ch = c & 127;
        *(uint4*)(qihi + row * 1032 + ch * 8) = *(const uint4*)(QIH + (tok0 + row) * 1024 + ch * 8);
      }
      if (tid < 128) wis[tid] = WI[tok0 * 8 + tid];
      __syncthreads();
      const int nkeys = q0 + 16;
      const int nch = (nkeys + 31) >> 5;
      for (int rep_ = 0; rep_ < ((DUP == 6) ? 2 : 1); ++rep_)
      for (int c = wave; c < nch; c += 8) {
        const int kbase = c * 32;
        bf16x8 khi[2][4];
#pragma unroll
        for (int mt = 0; mt < 2; ++mt)
#pragma unroll
          for (int ks = 0; ks < 4; ++ks) {
            const size_t o = ((size_t)b * 2048 + kbase + mt * 16 + fr) * 128 + ks * 32 + fq * 8;
            khi[mt][ks] = *(const bf16x8*)(KIH + o);
          }
        f32x4 sc[2];
        sc[0] = (f32x4){0.f, 0.f, 0.f, 0.f}; sc[1] = sc[0];
#pragma unroll 1
        for (int h = 0; h < 8; ++h) {
          const float wv = wis[fr * 8 + h];
          f32x4 lg[2];
          lg[0] = (f32x4){0.f, 0.f, 0.f, 0.f}; lg[1] = lg[0];
#pragma unroll
          for (int ks = 0; ks < 4; ++ks) {
            const bf16x8 bh = *(const bf16x8*)(qihi + fr * 1032 + h * 128 + ks * 32 + fq * 8);
#pragma unroll
            for (int mt = 0; mt < 2; ++mt) {
              lg[mt] = mfma16h(khi[mt][ks], bh, lg[mt]);
            }
          }
#pragma unroll
          for (int mt = 0; mt < 2; ++mt)
#pragma unroll
            for (int r = 0; r < 4; ++r) sc[mt][r] += wv * fmaxf(lg[mt][r], 0.f);
        }
#pragma unroll
        for (int mt = 0; mt < 2; ++mt) *(f32x4*)(scr + fr * 2048 + kbase + mt * 16 + fq * 4) = sc[mt];
      }
    }
    __syncthreads();
    u16* QF = (u16*)(lds + 81920);
#pragma unroll
    for (int i = 0; i < 4; ++i) {
      const int c = tid + i * NTHR;
      const int row = c >> 7, ch = c & 127;
      *(uint4*)(QF + row * 1032 + ch * 8) = *(const uint4*)(QKVG + (tok0 + row) * 2560 + ch * 8);
    }
#pragma unroll 1
    for (int qi2 = 0; qi2 < ((DUP == 7) ? 4 : 2); ++qi2) {
      const int qq = wave * 2 + (qi2 & 1);
      const int qpos = q0 + qq;
      if (!full) {
        const int ng = ((q0 + 15) >> 8) + 1;
        const float* sr = scr + qq * 2048; unsigned* mr = MASK + qq * 64;
        switch (ng) {
          case 2: topk_row<8>(sr, qpos, lane, mr); break;
          case 3: topk_row<12>(sr, qpos, lane, mr); break;
          case 4: topk_row<16>(sr, qpos, lane, mr); break;
          case 5: topk_row<20>(sr, qpos, lane, mr); break;
          case 6: topk_row<24>(sr, qpos, lane, mr); break;
          case 7: topk_row<28>(sr, qpos, lane, mr); break;
          default: topk_row<32>(sr, qpos, lane, mr); break;
        }
      } else {
#pragma unroll
        for (int e = 0; e < 32; ++e) {
          const unsigned long long ms = __ballot((e * 64 + lane) <= qpos);
          if (lane == 0) { MASK[qq * 64 + 2 * e] = (unsigned)ms; MASK[qq * 64 + 2 * e + 1] = (unsigned)(ms >> 32); }
        }
      }
    }
    __syncthreads();
    {
      int fr_a = fr, fq_a = fq, lane_a = lane;
      asm volatile("" : "+v"(fr_a), "+v"(fq_a), "+v"(lane_a));
#define fr fr_a
#define fq fq_a
#define lane lane_a
      const int g = wave >> 1, half = wave & 1;
      float mq = fabsf(p.pp->in[6][lane]), mk = fabsf(p.pp->in[7][lane]);
#pragma unroll
      for (int mm = 32; mm >= 1; mm >>= 1) { mq = fmaxf(mq, __shfl_xor(mq, mm)); mk = fmaxf(mk, __shfl_xor(mk, mm)); }
      const float shift = 8.f * mq * mk; const float nshift2 = -shift * 1.44269504089f;
      const u16* qfp = QF + fr * 1032 + g * 256 + fq * 8;
      f32x4 o[4][4];
#pragma unroll
      for (int rr = 0; rr < 4; ++rr)
#pragma unroll
        for (int mt = 0; mt < 4; ++mt) o[rr][mt] = (f32x4){0.f, 0.f, 0.f, 0.f};
      float lsum[4] = {0.f, 0.f, 0.f, 0.f};
      const u16* Kb = QKVG + (size_t)b * 2048 * 2560 + 1024 + g * 64 + fq * 8 + (size_t)(8 * (fr >> 2) + (fr & 3)) * 2560;
      const u16* Vb = VT + (size_t)(b * 256 + g * 64 + fr) * 2048 + 8 * fq;
      const int nb = (q0 + 16 + 31) >> 5;
      bf16x8 kf[2][2], vf[4];
      {
        const int k0 = (half < nb ? half : 0) * 32;
#pragma unroll
        for (int s2 = 0; s2 < 2; ++s2)
#pragma unroll
          for (int ks = 0; ks < 2; ++ks) kf[s2][ks] = *(const bf16x8*)(Kb + (size_t)(k0 + 4 * s2) * 2560 + ks * 32);
#pragma unroll
        for (int mt = 0; mt < 4; ++mt) vf[mt] = *(const bf16x8*)(Vb + (size_t)mt * 16 * 2048 + k0);
      }
#pragma unroll 1
      for (int blk = half; blk < nb; blk += 2) {
        bf16x8 kn[2][2], vn[4];
        const int nx = (blk + 2 < nb) ? (blk + 2) * 32 : blk * 32;
#pragma unroll
        for (int s2 = 0; s2 < 2; ++s2)
#pragma unroll
          for (int ks = 0; ks < 2; ++ks) kn[s2][ks] = *(const bf16x8*)(Kb + (size_t)(nx + 4 * s2) * 2560 + ks * 32);
#pragma unroll
        for (int mt = 0; mt < 4; ++mt) vn[mt] = *(const bf16x8*)(Vb + (size_t)mt * 16 * 2048 + nx);
        const unsigned mw = MASK[fr * 64 + blk] >> (8 * fq);
        f32x4 mf[2];
#pragma unroll
        for (int s2 = 0; s2 < 2; ++s2)
#pragma unroll
          for (int r = 0; r < 4; ++r) mf[s2][r] = (float)((mw >> (4 * s2 + r)) & 1u);
#pragma unroll
        for (int rr = 0; rr < 4; ++rr) {
          float pv[8];
          f32x4 pq[2];
#pragma unroll
          for (int s2 = 0; s2 < 2; ++s2) {
            f32x4 stv = (f32x4){0.f, 0.f, 0.f, 0.f};
            stv = mfma16(kf[s2][0], *(const bf16x8*)(qfp + rr * 64), stv);
            stv = mfma16(kf[s2][1], *(const bf16x8*)(qfp + rr * 64 + 32), stv);
            stv = stv * (0.125f * 1.44269504089f) + nshift2;
#pragma unroll
            for (int r = 0; r < 4; ++r) stv[r] = __builtin_amdgcn_exp2f(stv[r]);
            pq[s2] = stv * mf[s2];
          }
          {
            const f32x4 sm_ = pq[0] + pq[1];
            lsum[rr] += (sm_[0] + sm_[1]) + (sm_[2] + sm_[3]);
          }
#pragma unroll
          for (int r = 0; r < 4; ++r) { pv[r] = pq[0][r]; pv[4 + r] = pq[1][r]; }
          union { bf16x8 v; unsigned w[4]; } pk;
          pk.w[0] = pg8::cvt_pk_bf16(pv[0], pv[1]); pk.w[1] = pg8::cvt_pk_bf16(pv[2], pv[3]);
          pk.w[2] = pg8::cvt_pk_bf16(pv[4], pv[5]); pk.w[3] = pg8::cvt_pk_bf16(pv[6], pv[7]);
#pragma unroll
          for (int mt = 0; mt < 4; ++mt) o[rr][mt] = mfma16(vf[mt], pk.v, o[rr][mt]);
        }
#pragma unroll
        for (int s2 = 0; s2 < 2; ++s2)
#pragma unroll
          for (int ks = 0; ks < 2; ++ks) kf[s2][ks] = kn[s2][ks];
#pragma unroll
        for (int mt = 0; mt < 4; ++mt) vf[mt] = vn[mt];
      }
      float* CB = (float*)(lds + 8192) + (size_t)g * 68 * 64 + lane;
      if (half == 1) {
#pragma unroll
        for (int rr = 0; rr < 4; ++rr) {
#pragma unroll
          for (int mt = 0; mt < 4; ++mt)
#pragma unroll
            for (int r = 0; r < 4; ++r) CB[((rr * 4 + mt) * 4 + r) * 64] = o[rr][mt][r];
          CB[(64 + rr) * 64] = lsum[rr];
        }
      }
      __syncthreads();
      if (half == 0) {
#pragma unroll
        for (int rr = 0; rr < 4; ++rr) {
          float l = lsum[rr] + CB[(64 + rr) * 64];
          l += __shfl_xor(l, 16); l += __shfl_xor(l, 32);
          const float inv = 1.f / l;
          const int h = g * 4 + rr;
#pragma unroll
          for (int mt = 0; mt < 4; ++mt) {
            u16* op = QKVG + (tok0 + fr) * 2560 + h * 64 + mt * 16 + fq * 4;
            const uint2 gg = *(const uint2*)(op + 1536);
            const float v0 = o[rr][mt][0] + CB[((rr * 4 + mt) * 4 + 0) * 64], v1 = o[rr][mt][1] + CB[((rr * 4 + mt) * 4 + 1) * 64];
            const float v2 = o[rr][mt][2] + CB[((rr * 4 + mt) * 4 + 2) * 64], v3 = o[rr][mt][3] + CB[((rr * 4 + mt) * 4 + 3) * 64];
            uint2 w;
            w.x = pg8::cvt_pk_bf16(v0 * inv * silu_(bflo(gg.x)), v1 * inv * silu_(bfhi(gg.x)));
            w.y = pg8::cvt_pk_bf16(v2 * inv * silu_(bflo(gg.y)), v3 * inv * silu_(bfhi(gg.y)));
            if (st) *(uint2*)op = w;
          }
        }
      }
#undef fr
#undef fq
#undef lane
    }
    __syncthreads();
  }
}

__device__ __forceinline__ void lru_gate_phase(const PAcc& p, char* lds) {
  const int tid = tid_(), lane = tid & 63, wave = tid >> 6;
  const int wr = wave >> 1, wc = wave & 1, fr = lane & 15, fq = lane >> 4;
  float* UC = (float*)lds;
  u16* Al = (u16*)(lds + 256 * 65 * 4);
  u16* Bl = Al + 256 * 72;
  const u16* UG = (const u16*)(p.pp->ws + LRU_UG);
  const u16* WG = (const u16*)(p.pp->ws + WS_WT) + W_LRU_GATE;
  float* LA = (float*)(p.pp->ws + LRU_A);
  float* LB = (float*)(p.pp->ws + LRU_B);
  for (int unit = blockIdx.x; unit < 2048; unit += gridDim.x) {
    const int n = unit & 15, mt = unit >> 4;
    const int m0 = mt * 256;
    {
      const int c = tid & 63, rg = tid >> 6;
      const int ch = n * 64 + c;
      const float w0 = p.pp->in[10][ch], w1 = p.pp->in[10][1024 + ch], w2 = p.pp->in[10][2048 + ch], w3 = p.pp->in[10][3072 + ch];
      const float cb = p.pp->in[11][ch];
      const int r0 = rg * 32;
      const int g0 = m0 + r0;
      float u3 = ((g0 & 2047) >= 3) ? bf2f(UG[(size_t)(g0 - 3) * 2048 + ch]) : 0.f;
      float u2 = ((g0 & 2047) >= 2) ? bf2f(UG[(size_t)(g0 - 2) * 2048 + ch]) : 0.f;
      float u1 = ((g0 & 2047) >= 1) ? bf2f(UG[(size_t)(g0 - 1) * 2048 + ch]) : 0.f;
#pragma unroll 8
      for (int r = 0; r < 32; ++r) {
        const float u0 = bf2f(UG[(size_t)(g0 + r) * 2048 + ch]);
        const float v = w0 * u3 + w1 * u2 + w2 * u1 + w3 * u0 + cb;
        UC[(r0 + r) * 65 + c] = v;
        Al[(r0 + r) * 72 + c] = f2bf(v);
        u3 = u2; u2 = u1; u1 = u0;
      }
#pragma unroll
      for (int i = 0; i < 2; ++i) {
        const int cidx = tid + i * NTHR;
        const int row = cidx >> 3, kc = (cidx & 7) * 8;
        *(uint4*)(Bl + row * 72 + kc) = *(const uint4*)(WG + (size_t)n * 8192 + row * 64 + kc);
      }
    }
    __syncthreads();
    f32x4 acc[4][4];
#pragma unroll
    for (int i = 0; i < 4; ++i)
#pragma unroll
      for (int j = 0; j < 4; ++j) acc[i][j] = (f32x4){0.f, 0.f, 0.f, 0.f};
#pragma unroll
    for (int ks = 0; ks < 2; ++ks) {
      bf16x8 af[4], bfr[4];
#pragma unroll
      for (int i = 0; i < 4; ++i) af[i] = *(const bf16x8*)(Al + (wr * 64 + i * 16 + fr) * 72 + ks * 32 + fq * 8);
#pragma unroll
      for (int j = 0; j < 4; ++j) bfr[j] = *(const bf16x8*)(Bl + (wc * 64 + j * 16 + fr) * 72 + ks * 32 + fq * 8);
#pragma unroll
      for (int i = 0; i < 4; ++i)
#pragma unroll
        for (int j = 0; j < 4; ++j) acc[i][j] = mfma16(af[i], bfr[j], acc[i][j]);
    }
#pragma unroll
    for (int jj = 0; jj < 2; ++jj) {
      const int d = wc * 32 + jj * 16 + fr;
      const int ch = n * 64 + d;
      const float ba = p.pp->in[13][ch], bx = p.pp->in[15][ch];
      const float spl = softplus_(-p.pp->in[16][ch]);
#pragma unroll
      for (int i = 0; i < 4; ++i)
#pragma unroll
        for (int r = 0; r < 4; ++r) {
          const int row = wr * 64 + i * 16 + fq * 4 + r;
          const float rr = sigmoid_(acc[i][jj * 2][r] + ba);
          const float ig = sigmoid_(acc[i][jj * 2 + 1][r] + bx);
          const float log_a = -8.f * rr * spl;
          const float a = __expf(log_a);
          const float bb = sqrtf(fmaxf(-expm1f(2.f * log_a), 0.f)) * (ig * UC[row * 65 + d]);
          const size_t o = (size_t)(m0 + row) * 1024 + ch;
          LA[o] = a; LB[o] = bb;
        }
    }
    __syncthreads();
  }
}


__device__ __forceinline__ void lru_fused_phase(const PAcc& p, char* lds) {
  const int tid = tid_(), lane = tid & 63, wave = tid >> 6;
  const int wr = wave >> 1, wc = wave & 1, fr = lane & 15, fq = lane >> 4;
  float* UB = (float*)lds;
  float* AA = UB + 128 * 65;
  u16* Al = (u16*)(AA + 128 * 65);
  u16* Bl = Al + 128 * 72;
  float* sA = (float*)(Bl + 128 * 72);
  float* sB = sA + 512;
  float* Hc = sB + 512;
  const u16* UG = (const u16*)(p.pp->ws + LRU_UG);
  const u16* WG = (const u16*)(p.pp->ws + WS_WT) + W_LRU_GATE;
  u16* OG = (u16*)(p.pp->ws + WS_H);
  const int c = tid & 63, rg = tid >> 6;
  for (int unit = blockIdx.x; unit < 256; unit += gridDim.x) {
    const int b = unit >> 4, n = unit & 15;
    const int ch = n * 64 + c;
    const float w0 = p.pp->in[10][ch], w1 = p.pp->in[10][1024 + ch], w2 = p.pp->in[10][2048 + ch], w3 = p.pp->in[10][3072 + ch];
    const float cb = p.pp->in[11][ch];
#pragma unroll
    for (int i = 0; i < 2; ++i) {
      const int cidx = tid + i * NTHR;
      const int row = cidx >> 3, kc = (cidx & 7) * 8;
      *(uint4*)(Bl + row * 72 + kc) = *(const uint4*)(WG + (size_t)n * 8192 + row * 64 + kc);
    }
    if (tid < 64) Hc[tid] = 0.f;
    float ba[2], bx[2], spl[2];
#pragma unroll
    for (int jj = 0; jj < 2; ++jj) {
      const int dch = n * 64 + wc * 32 + jj * 16 + fr;
      ba[jj] = p.pp->in[13][dch]; bx[jj] = p.pp->in[15][dch]; spl[jj] = softplus_(-p.pp->in[16][dch]);
    }
    u16 un[19], gn[16];
#define LRU_LOAD(mt_)                                                                      \
    { const size_t g0_ = (size_t)b * 2048 + (mt_) * 128 + rg * 16;                         \
      const int pos0_ = (mt_) * 128 + rg * 16;                                             \
      _Pragma("unroll") for (int r = 0; r < 3; ++r) un[r] = (pos0_ >= 3 - r) ? UG[(g0_ - 3 + r) * 2048 + ch] : (u16)0; \
      _Pragma("unroll") for (int r = 0; r < 16; ++r) { un[3 + r] = UG[(g0_ + r) * 2048 + ch]; gn[r] = UG[(g0_ + r) * 2048 + 1024 + ch]; } }
    LRU_LOAD(0);
#pragma unroll 1
    for (int mt = 0; mt < 16; ++mt) {
      const size_t m0 = (size_t)b * 2048 + mt * 128;
      const size_t g0 = m0 + rg * 16;
      u16 gg[16];
#pragma unroll
      for (int r = 0; r < 16; ++r) gg[r] = gn[r];
      {
        float u3 = bf2f(un[0]), u2 = bf2f(un[1]), u1 = bf2f(un[2]);
#pragma unroll
        for (int r = 0; r < 16; ++r) {
          const float u0 = bf2f(un[3 + r]);
          const float v = w0 * u3 + w1 * u2 + w2 * u1 + w3 * u0 + cb;
          UB[(rg * 16 + r) * 65 + c] = v;
          Al[(rg * 16 + r) * 72 + c] = f2bf(v);
          u3 = u2; u2 = u1; u1 = u0;
        }
      }
      if (mt + 1 < 16) LRU_LOAD(mt + 1);
      __syncthreads();
      f32x4 acc[2][4];
#pragma unroll
      for (int i = 0; i < 2; ++i)
#pragma unroll
        for (int j = 0; j < 4; ++j) acc[i][j] = (f32x4){0.f, 0.f, 0.f, 0.f};
#pragma unroll
      for (int ks = 0; ks < 2; ++ks) {
        bf16x8 af[2], bfr[4];
#pragma unroll
        for (int i = 0; i < 2; ++i) af[i] = *(const bf16x8*)(Al + (wr * 32 + i * 16 + fr) * 72 + ks * 32 + fq * 8);
#pragma unroll
        for (int j = 0; j < 4; ++j) bfr[j] = *(const bf16x8*)(Bl + (wc * 64 + j * 16 + fr) * 72 + ks * 32 + fq * 8);
#pragma unroll
        for (int i = 0; i < 2; ++i)
#pragma unroll
          for (int j = 0; j < 4; ++j) acc[i][j] = mfma16(af[i], bfr[j], acc[i][j]);
      }
#pragma unroll
      for (int jj = 0; jj < 2; ++jj) {
        const int d = wc * 32 + jj * 16 + fr;
#pragma unroll
        for (int i = 0; i < 2; ++i)
#pragma unroll
          for (int r = 0; r < 4; ++r) {
            const int row = wr * 32 + i * 16 + fq * 4 + r;
            const float rr = sigmoid_(acc[i][jj * 2][r] + ba[jj]);
            const float ig = sigmoid_(acc[i][jj * 2 + 1][r] + bx[jj]);
            const float log_a = -8.f * rr * spl[jj];
            const float av = __expf(log_a);
            AA[row * 65 + d] = av;
            UB[row * 65 + d] = __builtin_amdgcn_sqrtf(fmaxf((1.f - av) * (1.f + av), 0.f)) * (ig * UB[row * 65 + d]);
          }
      }
      __syncthreads();
      {
        float Aa = 1.f, Bb = 0.f;
#pragma unroll
        for (int r = 0; r < 16; ++r) {
          const float a = AA[(rg * 16 + r) * 65 + c], bb = UB[(rg * 16 + r) * 65 + c];
          Bb = a * Bb + bb; Aa *= a;
        }
        sA[rg * 64 + c] = Aa; sB[rg * 64 + c] = Bb;
        __syncthreads();
        float h = Hc[c];
        for (int v = 0; v < rg; ++v) h = sA[v * 64 + c] * h + sB[v * 64 + c];
#pragma unroll
        for (int r = 0; r < 16; ++r) {
          const float a = AA[(rg * 16 + r) * 65 + c], bb = UB[(rg * 16 + r) * 65 + c];
          h = a * h + bb;
          OG[(g0 + r) * 1024 + ch] = f2bf(h * silu_(bf2f(gg[r])));
        }
        __syncthreads();
        if (rg == 7) Hc[c] = h;
      }
    }
    __syncthreads();
  }
}

#undef LRU_LOAD
__device__ __forceinline__ void lru_scan_phase(const PAcc& p, char* lds) {
  const int tid = tid_(), c = tid & 63, tc = tid >> 6;
  float* sA = (float*)lds;
  float* sB = sA + 512;
  const float* LA = (const float*)(p.pp->ws + LRU_A);
  const float* LB = (const float*)(p.pp->ws + LRU_B);
  const u16* UG = (const u16*)(p.pp->ws + LRU_UG);
  u16* OG = (u16*)(p.pp->ws + WS_H);
  for (int item = blockIdx.x; item < 256; item += gridDim.x) {
    const int b = item >> 4, ch = (item & 15) * 64 + c;
    const size_t row0 = (size_t)b * 2048 + tc * 256;
    float Aa = 1.f, Bb = 0.f;
#pragma unroll 8
    for (int t = 0; t < 256; ++t) {
      const float a = LA[(row0 + t) * 1024 + ch], bb = LB[(row0 + t) * 1024 + ch];
      Bb = a * Bb + bb; Aa *= a;
    }
    sA[tc * 64 + c] = Aa; sB[tc * 64 + c] = Bb;
    __syncthreads();
    float h = 0.f;
    for (int v = 0; v < tc; ++v) h = sA[v * 64 + c] * h + sB[v * 64 + c];
#pragma unroll 8
    for (int t = 0; t < 256; ++t) {
      const float a = LA[(row0 + t) * 1024 + ch], bb = LB[(row0 + t) * 1024 + ch];
      h = a * h + bb;
      const float g = bf2f(UG[(row0 + t) * 2048 + 1024 + ch]);
      OG[(row0 + t) * 1024 + ch] = f2bf(h * silu_(g));
    }
    __syncthreads();
  }
}

__device__ __forceinline__ void rwkv_rec_phase(const PAcc& p, char* lds, bool st) {
  const int tid = tid_(), lane = tid & 63, wave = tid >> 6;
  float* Wd = (float*)lds;
  float* NKK = Wd + 1024;
  float* KKA = NKK + 1024;
  float* KM = KKA + 1024;
  float* Rr = KM + 1024;
  float* Vv = Rr + 1024;
  float* Yy = Vv + 1024;
  float* RKs = Yy + 1024;
  u16* RKVG = (u16*)(p.pp->ws + RW_RKVG);
  const float* EW = (const float*)(p.pp->ws + RW_EW);
  const u16* AB = (const u16*)(p.pp->ws + RW_A);
  const int tl = tid >> 5, jp = tid & 31;
  const int il = lane >> 3, js = lane & 7;
  for (int item = blockIdx.x; item < 256; item += gridDim.x) {
    const int b = item >> 4, h = item & 15;
    const int hc = h * 64 + 2 * jp;
    const float kk0 = p.pp->in[26][hc], kk1 = p.pp->in[26][hc + 1];
    const float ka0 = p.pp->in[27][hc], ka1 = p.pp->in[27][hc + 1];
    const float rk0 = p.pp->in[28][hc], rk1 = p.pp->in[28][hc + 1];
    const float lw0 = p.pp->in[29][hc], lw1 = p.pp->in[29][hc + 1];
    const float lb0 = p.pp->in[30][hc], lb1 = p.pp->in[30][hc + 1];
    f32x4 SA = (f32x4){0.f, 0.f, 0.f, 0.f}, SB = SA;
    const int irow = wave * 8 + il;
    unsigned r2, k2, v2, a2, g2n, g2; float2 e2;
    {
      const size_t row = (size_t)b * 2048 + tl;
      r2 = *(const unsigned*)(RKVG + row * 4096 + hc);
      k2 = *(const unsigned*)(RKVG + row * 4096 + 1024 + hc);
      v2 = *(const unsigned*)(RKVG + row * 4096 + 2048 + hc);
      g2n = *(const unsigned*)(RKVG + row * 4096 + 3072 + hc);
      a2 = *(const unsigned*)(AB + row * 1024 + hc);
      e2 = *(const float2*)(EW + row * 1024 + hc);
    }
    for (int t0 = 0; t0 < 2048; t0 += 16) {
      g2 = g2n;
      {
        const float r0 = bflo(r2), r1 = bfhi(r2), k0 = bflo(k2), k1 = bfhi(k2), v0 = bflo(v2), v1 = bfhi(v2);
        const float a0 = bflo(a2), a1 = bfhi(a2);
        float q0 = k0 * kk0, q1 = k1 * kk1;
        float ss = q0 * q0 + q1 * q1;
        ss = red32(ss);
        const float inv = rsqrtf(fmaxf(ss, 1e-24f));
        q0 *= inv; q1 *= inv;
        const float km0 = k0 * (1.f + (a0 - 1.f) * ka0), km1 = k1 * (1.f + (a1 - 1.f) * ka1);
        float bon = r0 * km0 * rk0 + r1 * km1 * rk1;
        bon = red32(bon);
        const int o = tl * 64 + 2 * jp;
        *(float2*)(Wd + o) = make_float2(__expf(-e2.x), __expf(-e2.y));
        *(float2*)(NKK + o) = make_float2(-q0, -q1);
        *(float2*)(KKA + o) = make_float2(q0 * a0, q1 * a1);
        *(float2*)(KM + o) = make_float2(km0, km1);
        *(float2*)(Rr + o) = make_float2(r0, r1);
        *(float2*)(Vv + o) = make_float2(v0, v1);
        if (jp == 0) RKs[tl] = bon;
      }
      __syncthreads();
      if (t0 + 16 < 2048) {
        const size_t row = (size_t)b * 2048 + t0 + 16 + tl;
        r2 = *(const unsigned*)(RKVG + row * 4096 + hc);
        k2 = *(const unsigned*)(RKVG + row * 4096 + 1024 + hc);
        v2 = *(const unsigned*)(RKVG + row * 4096 + 2048 + hc);
        g2n = *(const unsigned*)(RKVG + row * 4096 + 3072 + hc);
        a2 = *(const unsigned*)(AB + row * 1024 + hc);
        e2 = *(const float2*)(EW + row * 1024 + hc);
      }
#define RW_RD(W, N, C, M, R, V, t_)                                                        \
      { const int o_ = (t_) * 64 + js * 8;                                                   \
        W[0] = *(const f32x4*)(Wd + o_); W[1] = *(const f32x4*)(Wd + o_ + 4);                \
        N[0] = *(const f32x4*)(NKK + o_); N[1] = *(const f32x4*)(NKK + o_ + 4);              \
        C[0] = *(const f32x4*)(KKA + o_); C[1] = *(const f32x4*)(KKA + o_ + 4);              \
        M[0] = *(const f32x4*)(KM + o_); M[1] = *(const f32x4*)(KM + o_ + 4);                \
        R[0] = *(const f32x4*)(Rr + o_); R[1] = *(const f32x4*)(Rr + o_ + 4);                \
        V = Vv[(t_) * 64 + irow]; }
#define RW_CP(W, N, C, M, R, V, yout)                                                      \
      { const f32x4 p0_ = SA * N[0], p1_ = SB * N[1];                                        \
        float sa_ = ((p0_[0] + p0_[1]) + (p0_[2] + p0_[3])) + ((p1_[0] + p1_[1]) + (p1_[2] + p1_[3])); \
        sa_ = red8(sa_);                                                                     \
        SA = SA * W[0] + (C[0] * sa_ + M[0] * V);                                            \
        SB = SB * W[1] + (C[1] * sa_ + M[1] * V);                                            \
        const f32x4 y0_ = SA * R[0], y1_ = SB * R[1];                                        \
        float y_ = ((y0_[0] + y0_[1]) + (y0_[2] + y0_[3])) + ((y1_[0] + y1_[1]) + (y1_[2] + y1_[3])); \
        yout = red8(y_); }
      {
        f32x4 aW[2], aN[2], aC[2], aM[2], aR[2], bW[2], bN[2], bC[2], bM[2], bR[2];
        float aV, bV;
        RW_RD(aW, aN, aC, aM, aR, aV, 0);
        RW_RD(bW, bN, bC, bM, bR, bV, 1);
#pragma unroll
        for (int t = 0; t < 16; t += 2) {
          float ya, yb;
          RW_CP(aW, aN, aC, aM, aR, aV, ya);
          if (t + 2 < 16) RW_RD(aW, aN, aC, aM, aR, aV, t + 2);
          RW_CP(bW, bN, bC, bM, bR, bV, yb);
          if (t + 3 < 16) RW_RD(bW, bN, bC, bM, bR, bV, t + 3);
          if (js == 0) { Yy[t * 64 + irow] = ya; Yy[(t + 1) * 64 + irow] = yb; }
        }
      }
#undef RW_RD
#undef RW_CP
      __syncthreads();
      {
        const int o = tl * 64 + 2 * jp;
        const float2 y = *(const float2*)(Yy + o);
        float sm = y.x + y.y;
        sm = red32(sm);
        const float mean = sm * (1.f / 64.f);
        const float d0 = y.x - mean, d1 = y.y - mean;
        float vs = d0 * d0 + d1 * d1;
        vs = red32(vs);
        const float rstd = rsqrtf(vs * (1.f / 64.f) + 64e-5f);
        const float2 vv = *(const float2*)(Vv + o);
        const float bon = RKs[tl];
        const size_t row = (size_t)b * 2048 + t0 + tl;
        const float o0 = (d0 * rstd * lw0 + lb0 + bon * vv.x) * silu_(bflo(g2));
        const float o1 = (d1 * rstd * lw1 + lb1 + bon * vv.y) * silu_(bfhi(g2));
        if (st) *(unsigned*)(RKVG + row * 4096 + hc) = pack2(o0, o1);
      }
      __syncthreads();
    }
  }
}

__device__ __forceinline__ f32x4 wave_mma(const u16* A, int lda, const u16* B, int ldb, int K, f32x4 acc, int fr, int fq) {
  for (int k = 0; k < K; k += 32) {
    const bf16x8 a = *(const bf16x8*)(A + fr * lda + k + fq * 8);
    const bf16x8 b = *(const bf16x8*)(B + fr * ldb + k + fq * 8);
    acc = mfma16(a, b, acc);
  }
  return acc;
}

__device__ __forceinline__ void gla_pre_phase(const PAcc& p, char* lds) {
  const int tid = tid_(), lane = tid & 63, wave = tid >> 6, fr = lane & 15, fq = lane >> 4;
  float* AL = (float*)lds;
  float* TOT = AL + 1024;
  u16* QD = (u16*)(TOT + 512);
  u16* KI = QD + 64 * 136;
  const u16* P = (const u16*)(p.pp->ws + GL_P);
  u16* QDg = (u16*)(p.pp->ws + GL_QD);
  u16* KETg = (u16*)(p.pp->ws + GL_KET);
  u16* ATTg = (u16*)((char*)p.pp->out + GL_ATT_OUT);
  u16* VTg = (u16*)(p.pp->ws + GL_VT);
  float* LASTg = (float*)((char*)p.pp->out + GL_LAST_OUT);
  const int d = tid & 127, tg = tid >> 7;
  for (int item = blockIdx.x; item < 2048; item += gridDim.x) {
    const int h = item & 3, bn = item >> 2;
    const size_t row0 = (size_t)bn * 64;
    float w2c[16];
#pragma unroll
    for (int r = 0; r < 16; ++r) w2c[r] = p.pp->in[33][r * 512 + h * 128 + d];
    const float ab = p.pp->in[34][h * 128 + d];
    for (int i = tid; i < 1024; i += NTHR) AL[i] = bf2f(P[(row0 + (i >> 4)) * 3088 + 3072 + (i & 15)]);
    {
      const int e = tid & 255, th = tid >> 8;
      u16 vv[32];
#pragma unroll
      for (int t = 0; t < 32; ++t) vv[t] = P[(row0 + th * 32 + t) * 3088 + 1024 + h * 256 + e];
      u16* dst = VTg + ((size_t)item * 256 + e) * 64 + th * 32;
#pragma unroll
      for (int q4 = 0; q4 < 4; ++q4) {
        uint4 s0;
        s0.x = vv[q4 * 8 + 0] | ((unsigned)vv[q4 * 8 + 1] << 16); s0.y = vv[q4 * 8 + 2] | ((unsigned)vv[q4 * 8 + 3] << 16);
        s0.z = vv[q4 * 8 + 4] | ((unsigned)vv[q4 * 8 + 5] << 16); s0.w = vv[q4 * 8 + 6] | ((unsigned)vv[q4 * 8 + 7] << 16);
        *(uint4*)(dst + q4 * 8) = s0;
      }
    }
    __syncthreads();
    float cum[16];
    {
      float run = 0.f;
#pragma unroll
      for (int t = 0; t < 16; ++t) {
        const float4* al = (const float4*)(AL + (tg * 16 + t) * 16);
        const float4 x0 = al[0], x1 = al[1], x2 = al[2], x3 = al[3];
        float z = ab + x0.x * w2c[0] + x0.y * w2c[1] + x0.z * w2c[2] + x0.w * w2c[3] + x1.x * w2c[4] + x1.y * w2c[5] + x1.z * w2c[6] + x1.w * w2c[7]
                + x2.x * w2c[8] + x2.y * w2c[9] + x2.z * w2c[10] + x2.w * w2c[11] + x3.x * w2c[12] + x3.y * w2c[13] + x3.z * w2c[14] + x3.w * w2c[15];
        run += -((-z > 20.f) ? -z : __logf(1.f + __expf(-z))) * (1.f / 16.f);
        cum[t] = run;
      }
      TOT[tg * 128 + d] = run;
    }
    __syncthreads();
    {
      float off = 0.f, last = 0.f;
#pragma unroll
      for (int g = 0; g < 4; ++g) { const float tv = TOT[g * 128 + d]; if (g < tg) off += tv; last += tv; }
      if (tg == 0) LASTg[(size_t)item * 128 + d] = last;
      const float elast = __expf(last);
      u16 ke[16];
#pragma unroll
      for (int t = 0; t < 16; ++t) {
        const float c = cum[t] + off;
        const int tok = tg * 16 + t;
        const float q = bf2f(P[(row0 + tok) * 3088 + h * 128 + d]);
        const float k = bf2f(P[(row0 + tok) * 3088 + 512 + h * 128 + d]);
        const float ec = __expf(c), einv = __builtin_amdgcn_rcpf(ec);
        const u16 qd = f2bf(q * 0.08838834764831845f * ec);
        QD[tok * 136 + d] = qd;
        QDg[(row0 + tok) * 512 + h * 128 + d] = qd;
        KI[tok * 136 + d] = f2bf(k * einv);
        ke[t] = f2bf(k * elast * einv);
      }
      uint4 s0, s1;
      s0.x = ke[0] | ((unsigned)ke[1] << 16); s0.y = ke[2] | ((unsigned)ke[3] << 16); s0.z = ke[4] | ((unsigned)ke[5] << 16); s0.w = ke[6] | ((unsigned)ke[7] << 16);
      s1.x = ke[8] | ((unsigned)ke[9] << 16); s1.y = ke[10] | ((unsigned)ke[11] << 16); s1.z = ke[12] | ((unsigned)ke[13] << 16); s1.w = ke[14] | ((unsigned)ke[15] << 16);
      u16* kd = KETg + ((size_t)item * 128 + d) * 64 + tg * 16;
      *(uint4*)kd = s0;
      *(uint4*)(kd + 8) = s1;
    }
    __syncthreads();
    {
      const int ti = wave >> 1;
#pragma unroll
      for (int x = 0; x < 2; ++x) {
        const int tj = (wave & 1) * 2 + x;
        f32x4 a = (f32x4){0.f, 0.f, 0.f, 0.f};
        if (tj <= ti) a = wave_mma(QD + ti * 16 * 136, 136, KI + tj * 16 * 136, 136, 128, a, fr, fq);
#pragma unroll
        for (int r = 0; r < 4; ++r) {
          const int i = ti * 16 + fq * 4 + r, j = tj * 16 + fr;
          ATTg[(size_t)item * 4096 + i * 64 + j] = f2bf((j <= i) ? a[r] : 0.f);
        }
      }
    }
    __syncthreads();
  }
}

__device__ __forceinline__ void gla_phase(const PAcc& p, char* lds) {
  const int tid = tid_(), lane = tid & 63, wave = tid >> 6, fr = lane & 15, fq = lane >> 4;
  float* LAST = (float*)lds;
  u16* QD = (u16*)(LAST + 128);
  u16* KET = QD + 64 * 136;
  u16* VT = KET + 128 * 72;
  u16* ATT = VT + 64 * 72;
  u16* ST = ATT + 64 * 72;
  const u16* QDg = (const u16*)(p.pp->ws + GL_QD);
  const u16* KETg = (const u16*)(p.pp->ws + GL_KET);
  const u16* ATTg = (const u16*)((const char*)p.pp->out + GL_ATT_OUT);
  const u16* VTg = (const u16*)(p.pp->ws + GL_VT);
  const float* LASTg = (const float*)((const char*)p.pp->out + GL_LAST_OUT);
  u16* O = (u16*)(p.pp->ws + GL_O);
  for (int item = blockIdx.x; item < 256; item += gridDim.x) {
    const int b = item >> 4, h = (item >> 2) & 3, es = item & 3;
    f32x4 sacc[4];
#pragma unroll
    for (int i = 0; i < 4; ++i) sacc[i] = (f32x4){0.f, 0.f, 0.f, 0.f};
    for (int i = tid; i < 64 * 136 / 2; i += NTHR) ((unsigned*)ST)[i] = 0u;
    uint4 rA, rQ0, rQ1, rK0, rK1, rV; float rL = 0.f;
#define GLA_LOAD(n_)                                                                                            \
    {                                                                                                           \
      const size_t it_ = ((size_t)(b * 32 + (n_))) * 4 + h;                                                     \
      rA = *(const uint4*)(ATTg + it_ * 4096 + tid * 8);                                                        \
      { const int c0_ = tid, c1_ = tid + NTHR;                                                                  \
        rQ0 = *(const uint4*)(QDg + ((size_t)(b * 32 + (n_)) * 64 + (c0_ >> 4)) * 512 + h * 128 + (c0_ & 15) * 8); \
        rQ1 = *(const uint4*)(QDg + ((size_t)(b * 32 + (n_)) * 64 + (c1_ >> 4)) * 512 + h * 128 + (c1_ & 15) * 8); \
        rK0 = *(const uint4*)(KETg + it_ * 8192 + c0_ * 8);                                                     \
        rK1 = *(const uint4*)(KETg + it_ * 8192 + c1_ * 8); }                                                   \
      rV = *(const uint4*)(VTg + (it_ * 256 + es * 64) * 64 + tid * 8);                                         \
      if (tid < 128) rL = LASTg[it_ * 128 + tid];                                                               \
    }
    GLA_LOAD(0);
    for (int n = 0; n < 32; ++n) {
      const size_t row0 = (size_t)b * 2048 + n * 64;
      *(uint4*)(ATT + (tid >> 3) * 72 + (tid & 7) * 8) = rA;
      *(uint4*)(QD + (tid >> 4) * 136 + (tid & 15) * 8) = rQ0;
      *(uint4*)(QD + ((tid + NTHR) >> 4) * 136 + (tid & 15) * 8) = rQ1;
      *(uint4*)(KET + (tid >> 3) * 72 + (tid & 7) * 8) = rK0;
      *(uint4*)(KET + ((tid + NTHR) >> 3) * 72 + (tid & 7) * 8) = rK1;
      *(uint4*)(VT + (tid >> 3) * 72 + (tid & 7) * 8) = rV;
      if (tid < 128) LAST[tid] = rL;
      __syncthreads();
      if (n + 1 < 32) GLA_LOAD(n + 1);
      {
        const int ti = wave >> 1;
#pragma unroll
        for (int x = 0; x < 2; ++x) {
          const int te = (wave & 1) * 2 + x;
          f32x4 a = (f32x4){0.f, 0.f, 0.f, 0.f};
          a = wave_mma(ATT + ti * 16 * 72, 72, VT + te * 16 * 72, 72, 64, a, fr, fq);
          a = wave_mma(QD + ti * 16 * 136, 136, ST + te * 16 * 136, 136, 128, a, fr, fq);
#pragma unroll
          for (int r = 0; r < 4; ++r)
            O[(row0 + ti * 16 + fq * 4 + r) * 1024 + h * 256 + es * 64 + te * 16 + fr] = f2bf(a[r]);
        }
        const int et = wave >> 1;
#pragma unroll
        for (int x = 0; x < 4; ++x) {
          const int dt = (wave & 1) * 4 + x;
          const float dec = __expf(LAST[dt * 16 + fr]);
          f32x4 a = sacc[x];
          a[0] *= dec; a[1] *= dec; a[2] *= dec; a[3] *= dec;
          sacc[x] = wave_mma(VT + et * 16 * 72, 72, KET + dt * 16 * 72, 72, 64, a, fr, fq);
        }
      }
      __syncthreads();
      {
        const int et = wave >> 1;
#pragma unroll
        for (int x = 0; x < 4; ++x) {
          const int dt = (wave & 1) * 4 + x;
#pragma unroll
          for (int r = 0; r < 4; ++r) ST[(et * 16 + fq * 4 + r) * 136 + dt * 16 + fr] = f2bf(sacc[x][r]);
        }
      }
      __syncthreads();
    }
  }
}
#undef GLA_LOAD
__device__ __forceinline__ void gla_norm_phase(const PAcc& p) {
  const int lane = tid_() & 63;
  const int gw = blockIdx.x * (NTHR / 64) + (tid_() >> 6);
  const int nw = gridDim.x * (NTHR / 64);
  const u16* O = (const u16*)(p.pp->ws + GL_O);
  const u16* P = (const u16*)(p.pp->ws + GL_P);
  u16* OG = (u16*)(p.pp->ws + WS_H);
  const float4 gn = *(const float4*)(p.pp->in[35] + lane * 4);
  for (int row = gw; row < T_; row += nw) {
#pragma unroll
    for (int h = 0; h < 4; ++h) {
      const uint2 ov = *(const uint2*)(O + (size_t)row * 1024 + h * 256 + lane * 4);
      float4 v; v.x = bflo(ov.x); v.y = bfhi(ov.x); v.z = bflo(ov.y); v.w = bfhi(ov.y);
      float ss = v.x * v.x + v.y * v.y + v.z * v.z + v.w * v.w;
#pragma unroll
      for (int m = 32; m >= 1; m >>= 1) ss += __shfl_xor(ss, m);
      const float rstd = rsqrtf(ss * (1.f / 256.f) + 1e-6f);
      const uint2 g = *(const uint2*)(P + (size_t)row * 3088 + 2048 + h * 256 + lane * 4);
      uint2 o;
      o.x = pack2(v.x * rstd * gn.x * silu_(bflo(g.x)), v.y * rstd * gn.y * silu_(bfhi(g.x)));
      o.y = pack2(v.z * rstd * gn.z * silu_(bflo(g.y)), v.w * rstd * gn.w * silu_(bfhi(g.y)));
      *(uint2*)(OG + (size_t)row * 1024 + h * 256 + lane * 4) = o;
    }
  }
}


#define XB_TMO      128
#define XB_XCNT(j)  (256  + 64 * (j))
#define XB_XSUB(j)  (1280 + 64 * (j))
#define XB_XGEN(j)  (2304 + 64 * (j))
#define XB_TOP      3328
#define XB_TOPGEN   3392
#define XCD_BAR_WORDS 3456
#define XB_SPIN_CAP (1u << 18)
#define XLAS __attribute__((address_space(3)))
__device__ __forceinline__ unsigned xb_ld(unsigned* p)              { return __hip_atomic_load(p, __ATOMIC_RELAXED, __HIP_MEMORY_SCOPE_AGENT); }
__device__ __forceinline__ unsigned xb_add(unsigned* p, unsigned v) { return __hip_atomic_fetch_add(p, v, __ATOMIC_RELAXED, __HIP_MEMORY_SCOPE_AGENT); }
__device__ __forceinline__ unsigned xb_xcc_id() { return (unsigned)__builtin_amdgcn_s_getreg((3 << 11) | 20) & 0xFu; }
#define XB_SPIN(cond, bar) do { unsigned _sp = 0; while (cond) { __builtin_amdgcn_s_sleep(1); \
    if ((++_sp & 255u) == 0u) { if (xb_ld(&(bar)[XB_TMO])) break; if (_sp > XB_SPIN_CAP) { atomicAdd(&(bar)[XB_TMO], 1u); break; } } } } while (0)
struct XcdBarrier { unsigned* bar; unsigned x; volatile XLAS unsigned* st; };
__device__ __forceinline__ XcdBarrier xcd_barrier_post(unsigned* bar, volatile XLAS unsigned* st) {
  XcdBarrier b; b.bar = bar; b.x = xb_xcc_id(); b.st = st;
  if (tid_() == 0) (void)xb_add(&bar[XB_XCNT(b.x)], 1u);
  return b;
}
__device__ __forceinline__ void xcd_barrier_complete(unsigned* bar, unsigned x, unsigned& nloc, unsigned& nx) {
  const unsigned G = gridDim.x * gridDim.y * gridDim.z;
  unsigned sum, cnt, mine, sp = 0u;
  for (;;) {
    sum = 0u; cnt = 0u; mine = 0u;
#pragma unroll
    for (unsigned j = 0; j < 16; ++j) { const unsigned c = xb_ld(&bar[XB_XCNT(j)]); sum += c; cnt += (c > 0u) ? 1u : 0u; mine = (j == x) ? c : mine; }
    if (sum == G) break;
    __builtin_amdgcn_s_sleep(1);
    if ((++sp & 255u) == 0u) { if (xb_ld(&bar[XB_TMO])) break; if (sp > XB_SPIN_CAP) { atomicAdd(&bar[XB_TMO], 1u); break; } }
  }
  nloc = mine > 0u ? mine : 1u; nx = cnt > 0u ? cnt : 1u;
}
__device__ __forceinline__ void xcd_barrier(const XcdBarrier& b) {
  asm volatile("s_waitcnt vmcnt(0)" ::: "memory");
  __syncthreads();
  if (tid_() == 0) {
    unsigned* bar = b.bar;
    __builtin_amdgcn_s_waitcnt(0);
    unsigned nloc = b.st[0], nx = b.st[1];
    if (nloc == 0u) { xcd_barrier_complete(bar, b.x, nloc, nx); b.st[0] = nloc; b.st[1] = nx; }
    const unsigned old = xb_add(&bar[XB_XSUB(b.x)], 1u);
    const unsigned gen = old / nloc;
    if (old + 1u == (gen + 1u) * nloc) {
      __builtin_amdgcn_fence(__ATOMIC_RELEASE, "agent");
      asm volatile("s_waitcnt vmcnt(0)" ::: "memory");
      const unsigned og = xb_add(&bar[XB_TOP], 1u);
      const unsigned tg = og / nx;
      if (og + 1u == (tg + 1u) * nx) xb_add(&bar[XB_TOPGEN], 1u);
      else XB_SPIN(xb_ld(&bar[XB_TOPGEN]) == tg, bar);
      __builtin_amdgcn_fence(__ATOMIC_ACQUIRE, "agent");
      xb_add(&bar[XB_XGEN(b.x)], 1u);
      asm volatile("s_waitcnt vmcnt(0)" ::: "memory");
    } else {
      XB_SPIN(xb_ld(&bar[XB_XGEN(b.x)]) == gen, bar);
      __builtin_amdgcn_fence(__ATOMIC_ACQUIRE, "agent");
      asm volatile("s_waitcnt vmcnt(0)" ::: "memory");
    }
  }
  __syncthreads();
}

__global__ void __launch_bounds__(NTHR) fwd_megakernel(Params pk) {
  extern __shared__ __attribute__((aligned(16))) char lds[];
  cg::grid_group grid = cg::this_grid();
  PAcc p;
  p.pp = (CParamsPtr)__builtin_amdgcn_kernarg_segment_ptr();
  asm volatile("" : "+s"(p.pp));
  unsigned* xbar = (unsigned*)(p.pp->ws + WS_XBAR);
  volatile XLAS unsigned* xst = (volatile XLAS unsigned*)(lds + 128 * 1024);
  if (tid_() < 2) xst[tid_()] = 0u;
  if (blockIdx.x == 0) for (int i = tid_(); i < XCD_BAR_WORDS; i += NTHR) xbar[i] = 0u;
  const u16* WT = (const u16*)(p.pp->ws + WS_WT);
  u16* H = (u16*)(p.pp->ws + WS_H);
  u16* H2 = (u16*)(p.pp->ws + WS_H2);
  const float* MOD = (const float*)(p.pp->ws + WS_MOD);
  const float* xcur = p.pp->in[0];

#if DUP == 11
  for (int r_ = 0; r_ < 20; ++r_) grid.sync();
#endif
#if DUP == 5
  prep_phase(p, lds);
  grid.sync();
#endif
  prep_phase(p, lds);
  grid.sync();
  const XcdBarrier xb = xcd_barrier_post(xbar, xst);

  if (LAYER_MASK & 1) {
    for (int r_ = 0; r_ < ((DUP == 10) ? 2 : 1); ++r_) norm_phase<false, true, false>(p, p.pp->in[0], 0, H, nullptr);
    xcd_barrier(xb);
    for (int r_ = 0; r_ < ((DUP == 9) ? 2 : 1); ++r_) {
      pg8::EpiDsaMain e{(u16*)(p.pp->ws + DSA_QKVG), p.pp->in[6], p.pp->in[7], (const float2*)(p.pp->ws + WS_ROPE64), (u16*)(p.pp->ws + DSA_VT)};
      pg8::run<pg8::EpiDsaMain, true>(lds, H, H, H, WT + W_DSA_MAIN, WT + W_DSA_MAIN, WT + W_DSA_MAIN, 1024, 1024, 4, 1, 2560, e);
      pg8::EpiDsaIdx e2{(u16*)(p.pp->ws + DSA_QIHI), (u16*)(p.pp->ws + DSA_QILO), (u16*)(p.pp->ws + DSA_KIHI), (u16*)(p.pp->ws + DSA_KILO), (float*)(p.pp->ws + DSA_WI),
                        (const float2*)(p.pp->ws + WS_ROPE128)};
      pg8::run<pg8::EpiDsaIdx, true>(lds, H, H, H, WT + W_DSA_IDX_HI, WT + W_DSA_IDX_HI, WT + W_DSA_IDX_HI, 1024, 1024, 4, 1, 1280, e2);
    }
    xcd_barrier(xb);
#if DUP == 1
    dsa_unit_phase(p, lds, p.pp->ws == nullptr);
    xcd_barrier(xb);
#endif
    dsa_unit_phase(p, lds, true);
    xcd_barrier(xb);
    for (int r_ = 0; r_ < ((DUP == 9) ? 2 : 1); ++r_) {
      pg8::EpiResid<false, true> e{p.pp->ws + XR1, p.pp->in[0], MOD + 0 * 16 * 3072};
      const u16* A = (const u16*)(p.pp->ws + DSA_QKVG);
      pg8::run(lds, A, A, A, WT + W_DSA_OUT, WT + W_DSA_OUT, WT + W_DSA_OUT, 2560, 1024, 4, 1, 1024, e);
    }
    xcd_barrier(xb);
    xcur = p.pp->out;
  }
  if (LAYER_MASK & 2) {
    for (int r_ = 0; r_ < ((DUP == 10) ? 2 : 1); ++r_) norm_phase<false, false, true>(p, p.pp->ws + XR1, 1, H, nullptr);
    xcd_barrier(xb);
    for (int r_ = 0; r_ < ((DUP == 9) ? 2 : 1); ++r_) {
      pg8::EpiPlain e{(u16*)(p.pp->ws + LRU_UG), 2048, 2048};
      pg8::run(lds, H, H, H, WT + W_LRU_IN, WT + W_LRU_IN, WT + W_LRU_IN, 1024, 1024, 4, 1, 2048, e);
    }
    xcd_barrier(xb);
#if DUP == 4
    lru_fused_phase(p, lds);
    xcd_barrier(xb);
#endif
    lru_fused_phase(p, lds);
    xcd_barrier(xb);
    {
      pg8::EpiResid<true, true> e{p.pp->out, p.pp->ws + XR1, MOD + 1 * 16 * 3072};
      pg8::run(lds, H, H, H, WT + W_LRU_OUT, WT + W_LRU_OUT, WT + W_LRU_OUT, 1024, 1024, 4, 1, 1024, e);
    }
    xcd_barrier(xb);
    xcur = p.pp->out;
  }
  if (LAYER_MASK & 4) {
    for (int r_ = 0; r_ < ((DUP == 10) ? 2 : 1); ++r_) norm_phase<true, false, true>(p, p.pp->out, 2, H, nullptr);
    xcd_barrier(xb);
    for (int r_ = 0; r_ < ((DUP == 9) ? 2 : 1); ++r_) {
      pg8::EpiPlain e{(u16*)(p.pp->ws + RW_RKVG), 4096, 4096};
      pg8::run(lds, H, H, H, WT + W_RWKV_IN, WT + W_RWKV_IN, WT + W_RWKV_IN, 2048, 2048, 5, 1, 4096, e);
      EpiP e2{}; e2.o16 = (u16*)(p.pp->ws + RW_L1);
      gemm_phase<EPI_RWKV_L1>(p, H, H, H, WT + W_RWKV_L1, WT + W_RWKV_L1, WT + W_RWKV_L1, 2048, 2048, 2048, 1, 0, 1, e2, lds);
    }
    xcd_barrier(xb);
    for (int r_ = 0; r_ < ((DUP == 9) ? 2 : 1); ++r_) {
      const u16* L1 = (const u16*)(p.pp->ws + RW_L1);
      EpiP e{}; e.of = (float*)(p.pp->ws + RW_EW); e.f0 = p.pp->in[20];
      gemm_phase<EPI_RWKV_W>(p, L1, L1, L1, WT + W_RWKV_W2, WT + W_RWKV_W2, WT + W_RWKV_W2, 128, 64, 64, 1, 0, 8, e, lds);
      EpiP e2{}; e2.o16 = (u16*)(p.pp->ws + RW_A); e2.f0 = p.pp->in[23];
      gemm_phase<EPI_RWKV_A>(p, L1 + 64, L1 + 64, L1 + 64, WT + W_RWKV_A2, WT + W_RWKV_A2, WT + W_RWKV_A2, 128, 64, 64, 1, 0, 8, e2, lds);
    }
    xcd_barrier(xb);
#if DUP == 2
    rwkv_rec_phase(p, lds, p.pp->ws == nullptr);
    xcd_barrier(xb);
#endif
    rwkv_rec_phase(p, lds, true);
    xcd_barrier(xb);
    {
      pg8::EpiResid<true, true> e{p.pp->ws + XR3, p.pp->out, MOD + 2 * 16 * 3072};
      const u16* A = (const u16*)(p.pp->ws + RW_RKVG);
      pg8::run(lds, A, A, A, WT + W_RWKV_OUT, WT + W_RWKV_OUT, WT + W_RWKV_OUT, 4096, 1024, 4, 1, 1024, e);
    }
    xcd_barrier(xb);
    xcur = p.pp->out;
  }
  if (LAYER_MASK & 8) {
    for (int r_ = 0; r_ < ((DUP == 10) ? 2 : 1); ++r_) norm_phase<false, false, true>(p, p.pp->ws + XR3, 3, H, nullptr);
    xcd_barrier(xb);
    for (int r_ = 0; r_ < ((DUP == 9) ? 2 : 1); ++r_) {
      pg8::EpiPlain e{(u16*)(p.pp->ws + GL_P), 3088, 3088};
      pg8::run(lds, H, H, H, WT + W_GLA_IN, WT + W_GLA_IN, WT + W_GLA_IN, 1024, 1024, 4, 1, 3328, e);
    }
    xcd_barrier(xb);
    gla_pre_phase(p, lds);
    xcd_barrier(xb);
#if DUP == 3
    gla_phase(p, lds);
    xcd_barrier(xb);
#endif
    gla_phase(p, lds);
    xcd_barrier(xb);
    for (int r_ = 0; r_ < ((DUP == 10) ? 2 : 1); ++r_) gla_norm_phase(p);
    xcd_barrier(xb);
    {
      pg8::EpiResid<true, false> e{p.pp->out, p.pp->ws + XR3, MOD + 3 * 16 * 3072};
      pg8::run(lds, H, H, H, WT + W_GLA_OUT, WT + W_GLA_OUT, WT + W_GLA_OUT, 1024, 1024, 4, 1, 1024, e);
    }
    xcur = p.pp->out;
  }
  if (xcur != p.pp->out) {
    for (size_t i = (size_t)blockIdx.x * NTHR + tid_(); i < (size_t)T_ * 1024 / 4; i += (size_t)gridDim.x * NTHR)
      ((float4*)p.pp->out)[i] = ((const float4*)p.pp->in[0])[i];
  }
}

extern "C" void kernel_launch(void* const* d_in, const int* in_sizes, int n_in, void* d_out, int out_size, void* d_ws, size_t ws_size,
                              hipStream_t stream) {
  static int grid_blocks = 0;
  if (!grid_blocks) {
    int dev = 0, cus = 0, per_cu = 0;
    hipGetDevice(&dev);
    hipDeviceGetAttribute(&cus, hipDeviceAttributeMultiprocessorCount, dev);
    hipFuncSetAttribute((const void*)fwd_megakernel, hipFuncAttributeMaxDynamicSharedMemorySize, LDS_BYTES);
    hipOccupancyMaxActiveBlocksPerMultiprocessor(&per_cu, (const void*)fwd_megakernel, NTHR, LDS_BYTES);
    if (per_cu < 1) { fprintf(stderr, "occupancy query says %d blocks/CU\n", per_cu); per_cu = 1; }
    grid_blocks = cus;
  }
  Params p{};
  for (int i = 0; i < 37; ++i) p.in[i] = (const float*)d_in[i];
  p.out = (float*)d_out;
  p.ws = (unsigned char*)d_ws;
  for (int i = 0; i < 64; ++i) p.invf128[i] = (float)pow(10000.0, -(double)i / 64.0);
  for (int i = 0; i < 32; ++i) p.invf64[i] = (float)pow(10000.0, -(double)i / 32.0);
  void* args[] = {&p};
  hipError_t e = hipLaunchCooperativeKernel((const void*)fwd_megakernel, dim3(grid_blocks), dim3(NTHR), args, LDS_BYTES, stream);
  if (e != hipSuccess) fprintf(stderr, "cooperative launch failed: %s (grid %d)\n", hipGetErrorString(e), grid_blocks);
}
```

```cpp
#include <hip/hip_runtime.h>
#include <hip/hip_cooperative_groups.h>
#include <cstdio>
#include <cmath>
namespace cg = cooperative_groups;

#ifndef DUP
#define DUP 0
#endif
#ifndef LAYER_MASK
#define LAYER_MASK 15
#endif

typedef unsigned short u16;
using bf16x8 = __attribute__((ext_vector_type(8))) short;
using f32x4 = __attribute__((ext_vector_type(4))) float;

#define NTHR 512
constexpr int T_ = 32768;
constexpr size_t MiB = 1ull << 20;
constexpr int LDS_BYTES = 128 * 1024 + 64;
constexpr size_t WS_XBAR = 896 * 1024;

constexpr size_t WS_MOD = 0;
constexpr size_t WS_ROPE128 = 1 * MiB;
constexpr size_t WS_ROPE64 = 2 * MiB;
constexpr size_t WS_WT = 4 * MiB;
constexpr size_t WS_H = 52 * MiB;
constexpr size_t WS_H2 = 116 * MiB;
constexpr size_t WS_P = 180 * MiB;

constexpr size_t W_DSA_MAIN = 0;
constexpr size_t W_DSA_IDX_HI = W_DSA_MAIN + 2560ull * 1024;
constexpr size_t W_DSA_IDX_LO = W_DSA_IDX_HI + 1280ull * 1024;
constexpr size_t W_DSA_OUT = W_DSA_IDX_LO + 1280ull * 1024;
constexpr size_t W_LRU_IN = W_DSA_OUT + 1024ull * 1024;
constexpr size_t W_LRU_GATE = W_LRU_IN + 2048ull * 1024;
constexpr size_t W_LRU_OUT = W_LRU_GATE + 16ull * 128 * 64;
constexpr size_t W_RWKV_IN = W_LRU_OUT + 1024ull * 1024;
constexpr size_t W_RWKV_L1 = W_RWKV_IN + 4096ull * 2048;
constexpr size_t W_RWKV_W2 = W_RWKV_L1 + 128ull * 2048;
constexpr size_t W_RWKV_A2 = W_RWKV_W2 + 1024ull * 64;
constexpr size_t W_RWKV_OUT = W_RWKV_A2 + 1024ull * 64;
constexpr size_t W_GLA_IN = W_RWKV_OUT + 1024ull * 1024;
constexpr size_t W_GLA_OUT = W_GLA_IN + 3328ull * 1024;
constexpr size_t W_END = W_GLA_OUT + 1024ull * 1024;
static_assert(W_END * 2 <= 48 * MiB, "weights region");

constexpr size_t DSA_QKVG = WS_P;
constexpr size_t DSA_QIHI = WS_P + 160 * MiB;
constexpr size_t DSA_QILO = WS_P + 224 * MiB;
constexpr size_t DSA_KIHI = WS_P + 288 * MiB;
constexpr size_t DSA_KILO = WS_P + 296 * MiB;
constexpr size_t DSA_WI = WS_P + 304 * MiB;
constexpr size_t DSA_VT = WS_P + 306 * MiB;
constexpr size_t DSA_SCR = WS_H;
constexpr size_t LRU_UG = WS_H2;
constexpr size_t LRU_A = WS_H2 + 128 * MiB;
constexpr size_t LRU_B = WS_H2 + 256 * MiB;
constexpr size_t RW_RKVG = WS_P;
constexpr size_t RW_L1 = WS_P + 256 * MiB;
constexpr size_t RW_EW = WS_H;
constexpr size_t RW_A = WS_P + 264 * MiB;
constexpr size_t GL_P = WS_H2;
constexpr size_t GL_O = WS_H2 + 194 * MiB;
constexpr size_t GL_QD = WS_H2 + 258 * MiB;
constexpr size_t GL_KET = WS_H2 + 290 * MiB;
constexpr size_t GL_ATT_OUT = 0;
constexpr size_t GL_LAST_OUT = 16 * MiB;
constexpr size_t XR1 = 448 * MiB;
constexpr size_t XR3 = 438 * MiB;
constexpr size_t GL_VT = WS_H;

struct Params {
  const float* in[37];
  float* out;
  unsigned char* ws;
  float invf128[64];
  float invf64[32];
};

typedef const Params __attribute__((address_space(4))) * CParamsPtr;
struct PAcc { CParamsPtr pp; };

__device__ __forceinline__ int tid_() { int t = __builtin_amdgcn_workitem_id_x(); asm volatile("" : "+v"(t)); return t; }
__device__ __forceinline__ u16 f2bf(float f) {
  unsigned u = __float_as_uint(f);
  u += 0x7fffu + ((u >> 16) & 1u);
  return (u16)(u >> 16);
}
__device__ __forceinline__ float bf2f(u16 h) { return __uint_as_float(((unsigned)h) << 16); }
__device__ __forceinline__ float bflo(unsigned w) { return __uint_as_float(w << 16); }
__device__ __forceinline__ float bfhi(unsigned w) { return __uint_as_float(w & 0xffff0000u); }
__device__ __forceinline__ unsigned pack2(float a, float b) { return (unsigned)f2bf(a) | ((unsigned)f2bf(b) << 16); }
__device__ __forceinline__ float sigmoid_(float x) { return __builtin_amdgcn_rcpf(1.f + __expf(-x)); }
__device__ __forceinline__ float silu_(float x) { return x * __builtin_amdgcn_rcpf(1.f + __expf(-x)); }
__device__ __forceinline__ float softplus_(float x) { return x > 20.f ? x : log1pf(__expf(x)); }
template <int CTRL> __device__ __forceinline__ float dpp(float x) {
  return __builtin_bit_cast(float, __builtin_amdgcn_mov_dpp(__builtin_bit_cast(int, x), CTRL, 0xf, 0xf, true));
}
__device__ __forceinline__ float red8(float x) {
  x += dpp<0xB1>(x); x += dpp<0x4E>(x); x += dpp<0x141>(x); return x;
}
typedef _Float16 f16x8_t __attribute__((ext_vector_type(8)));
typedef _Float16 f16x2_t __attribute__((ext_vector_type(2)));
__device__ __forceinline__ f32x4 mfma16h(bf16x8 a, bf16x8 b, f32x4 c) {
  return __builtin_amdgcn_mfma_f32_16x16x32_f16(__builtin_bit_cast(f16x8_t, a), __builtin_bit_cast(f16x8_t, b), c, 0, 0, 0);
}
__device__ __forceinline__ unsigned packh2(float a, float b) {
  f16x2_t v; v.x = (_Float16)a; v.y = (_Float16)b; return __builtin_bit_cast(unsigned, v);
}
__device__ __forceinline__ float hlo(unsigned w) { return (float)__builtin_bit_cast(f16x2_t, w).x; }
__device__ __forceinline__ float hhi(unsigned w) { return (float)__builtin_bit_cast(f16x2_t, w).y; }
__device__ __forceinline__ u16 f2h(float a) { return __builtin_bit_cast(u16, (_Float16)a); }
__device__ __forceinline__ float red32(float x) {
  x += dpp<0xB1>(x); x += dpp<0x4E>(x); x += dpp<0x141>(x); x += dpp<0x140>(x);
  const auto s_ = __builtin_amdgcn_permlane16_swap(__float_as_uint(x), __float_as_uint(x), false, false);
  return __uint_as_float(s_[0]) + __uint_as_float(s_[1]);
}
__device__ __forceinline__ f32x4 mfma16(bf16x8 a, bf16x8 b, f32x4 c) {
  return __builtin_amdgcn_mfma_f32_16x16x32_bf16(a, b, c, 0, 0, 0);
}
__device__ __forceinline__ void sincos_d(double x, float& c, float& s) {
  double k = rint(x * 0.63661977236758134308);
  double r = fma(-k, 1.57079632679489655800, x);
  r = fma(-k, 6.12323399573676603587e-17, r);
  int q = ((int)k) & 3;
  double r2 = r * r;
  double sp = r * (1.0 + r2 * (-1.0 / 6 + r2 * (1.0 / 120 + r2 * (-1.0 / 5040 + r2 * (1.0 / 362880 + r2 * (-1.0 / 39916800 + r2 * (1.0 / 6227020800.0)))))));
  double cp = 1.0 + r2 * (-0.5 + r2 * (1.0 / 24 + r2 * (-1.0 / 720 + r2 * (1.0 / 40320 + r2 * (-1.0 / 3628800 + r2 * (1.0 / 479001600.0 + r2 * (-1.0 / 87178291200.0)))))));
  double ss = (q == 0) ? sp : (q == 1) ? cp : (q == 2) ? -sp : -cp;
  double cc = (q == 0) ? cp : (q == 1) ? -sp : (q == 2) ? -cp : sp;
  c = (float)cc; s = (float)ss;
}

__device__ __forceinline__ int idx_perm(int p) {
  int wc = p >> 6, jn = (p >> 4) & 3, fr = p & 15;
  return wc * 32 + (jn & 1) * 16 + fr + 64 * (jn >> 1);
}
__device__ __forceinline__ void tconv_job(const float* __restrict__ src, int ld_src, int K, int nrows, int colmode, int col_off, int nvalid,
                          u16* __restrict__ dst, u16* __restrict__ dst_lo, int ldd, int dst_col0,
                          const float* __restrict__ mu, int smode, float* tl, int fmt = 0) {
  const int tid = tid_();
  const int tk = K >> 6, tn = nrows >> 6;
  for (int tile = blockIdx.x; tile < tk * tn; tile += gridDim.x) {
    const int k0 = (tile % tk) << 6, j0 = (tile / tk) << 6;
    {
      const int jn = tid & 63;
      const int j = j0 + jn;
      int col;
      if (colmode == 0) col = (j < nvalid) ? col_off + j : -1;
      else if (colmode == 2) {
        if (j < 1280) { const int P = j & 255; col = (j & ~255) + ((P >> 5) & 3) * 64 + 32 * (P >> 7) + (P & 31); }
        else col = j;
      } else {
        const int P = j & 255, bj = P >> 7, wcc = (P >> 5) & 3, r5 = P & 31;
        if (j < 1024) col = 2560 + ((j >> 8) * 2 + (wcc >> 1)) * 128 + 32 * (wcc & 1) + r5 + 64 * bj;
        else if (wcc < 2) col = 3592 + 32 * (wcc & 1) + r5 + 64 * bj;
        else if (wcc == 2 && bj == 0 && r5 < 8) col = 3584 + r5;
        else col = -1;
      }
#pragma unroll
      for (int i = 0; i < 8; ++i) {
        const int kr = i * 8 + (tid >> 6);
        float v = 0.f;
        if (col >= 0) v = src[(size_t)(k0 + kr) * ld_src + col];
        if (smode == 1) v *= (1.f - mu[k0 + kr]);
        else if (smode == 2) v *= mu[k0 + kr];
        tl[kr * 65 + jn] = v;
      }
    }
    __syncthreads();
    {
      const int kr = tid & 63;
#pragma unroll
      for (int i = 0; i < 8; ++i) {
        const int jn = i * 8 + (tid >> 6);
        float v = tl[kr * 65 + jn];
        u16 hi = fmt ? f2h(v) : f2bf(v);
        size_t o = (size_t)(j0 + jn) * ldd + dst_col0 + k0 + kr;
        dst[o] = hi;
        if (dst_lo) dst_lo[o] = f2bf(v - bf2f(hi));
      }
    }
    __syncthreads();
  }
}

__device__ __forceinline__ void prep_phase(const PAcc& p, char* lds) {
  const int tid = tid_();
  u16* WT = (u16*)(p.pp->ws + WS_WT);
  float* fl = (float*)lds;
  if (blockIdx.x < 192) {
    float* cact = fl;
    float* red = fl + 16384;
    const float* c = p.pp->in[1];
    for (int i = tid; i < 16384; i += NTHR) { int b = i >> 10, k = i & 1023; cact[k * 16 + b] = silu_(c[i]); }
    __syncthreads();
    for (int item = blockIdx.x; item < 192; item += gridDim.x) {
      const int l = item / 48, n0 = (item % 48) * 64;
      const int col = tid & 63, kq = tid >> 6;
      float acc[16];
#pragma unroll
      for (int b = 0; b < 16; ++b) acc[b] = 0.f;
      const float* w = p.pp->in[3] + (size_t)l * 1024 * 3072 + n0 + col;
#pragma unroll 16
      for (int k = kq * 128; k < kq * 128 + 128; ++k) {
        float wv = w[(size_t)k * 3072];
        const float4* cp = (const float4*)(cact + k * 16);
        float4 c0 = cp[0], c1 = cp[1], c2 = cp[2], c3 = cp[3];
        acc[0] += c0.x * wv; acc[1] += c0.y * wv; acc[2] += c0.z * wv; acc[3] += c0.w * wv;
        acc[4] += c1.x * wv; acc[5] += c1.y * wv; acc[6] += c1.z * wv; acc[7] += c1.w * wv;
        acc[8] += c2.x * wv; acc[9] += c2.y * wv; acc[10] += c2.z * wv; acc[11] += c2.w * wv;
        acc[12] += c3.x * wv; acc[13] += c3.y * wv; acc[14] += c3.z * wv; acc[15] += c3.w * wv;
      }
#pragma unroll
      for (int b = 0; b < 16; ++b) red[(kq * 16 + b) * 64 + col] = acc[b];
      __syncthreads();
      for (int o = tid; o < 1024; o += NTHR) {
        int b = o >> 6, cc = o & 63;
        float s = 0.f;
#pragma unroll
        for (int q = 0; q < 8; ++q) s += red[(q * 16 + b) * 64 + cc];
        ((float*)(p.pp->ws + WS_MOD))[((size_t)l * 16 + b) * 3072 + n0 + cc] = s + p.pp->in[4][l * 3072 + n0 + cc];
      }
      __syncthreads();
    }
  }
  __syncthreads();
  {
    const float f128 = p.pp->invf128[tid & 63], f64 = p.pp->invf64[tid & 31];
    float2* r128 = (float2*)(p.pp->ws + WS_ROPE128);
    float2* r64 = (float2*)(p.pp->ws + WS_ROPE64);
    for (int idx = blockIdx.x * NTHR + tid; idx < 2048 * 64; idx += gridDim.x * NTHR) {
      int pos = idx >> 6;
      float ang = (float)pos * f128;
      float c_, s_; sincos_d((double)ang, c_, s_);
      r128[idx] = make_float2(c_, s_);
    }
    for (int idx = blockIdx.x * NTHR + tid; idx < 2048 * 32; idx += gridDim.x * NTHR) {
      int pos = idx >> 5;
      float ang = (float)pos * f64;
      float c_, s_; sincos_d((double)ang, c_, s_);
      r64[idx] = make_float2(c_, s_);
    }
  }
  float* tl = fl;
  tconv_job(p.pp->in[5], 3720, 1024, 2560, 2, 0, 2560, WT + W_DSA_MAIN, nullptr, 1024, 0, nullptr, 0, tl, 1);
  tconv_job(p.pp->in[5], 3720, 1024, 1280, 3, 0, 0, WT + W_DSA_IDX_HI, nullptr, 1024, 0, nullptr, 0, tl, 1);
  tconv_job(p.pp->in[8], 1024, 1024, 1024, 0, 0, 1024, WT + W_DSA_OUT, nullptr, 1024, 0, nullptr, 0, tl);
  tconv_job(p.pp->in[9], 2048, 1024, 2048, 0, 0, 2048, WT + W_LRU_IN, nullptr, 1024, 0, nullptr, 0, tl);
  tconv_job(p.pp->in[17], 1024, 1024, 1024, 0, 0, 1024, WT + W_LRU_OUT, nullptr, 1024, 0, nullptr, 0, tl);
  for (int n = 0; n < 4; ++n) {
    tconv_job(p.pp->in[19] + (size_t)n * 1024 * 1024, 1024, 1024, 1024, 0, 0, 1024, WT + W_RWKV_IN + (size_t)n * 1024 * 2048, nullptr, 2048, 0, p.pp->in[18] + n * 1024, 1, tl);
    tconv_job(p.pp->in[19] + (size_t)n * 1024 * 1024, 1024, 1024, 1024, 0, 0, 1024, WT + W_RWKV_IN + (size_t)n * 1024 * 2048, nullptr, 2048, 1024, p.pp->in[18] + n * 1024, 2, tl);
  }
  tconv_job(p.pp->in[21], 64, 1024, 64, 0, 0, 64, WT + W_RWKV_L1, nullptr, 2048, 0, p.pp->in[18] + 4 * 1024, 1, tl);
  tconv_job(p.pp->in[21], 64, 1024, 64, 0, 0, 64, WT + W_RWKV_L1, nullptr, 2048, 1024, p.pp->in[18] + 4 * 1024, 2, tl);
  tconv_job(p.pp->in[24], 64, 1024, 64, 0, 0, 64, WT + W_RWKV_L1 + 64 * 2048, nullptr, 2048, 0, p.pp->in[18] + 5 * 1024, 1, tl);
  tconv_job(p.pp->in[24], 64, 1024, 64, 0, 0, 64, WT + W_RWKV_L1 + 64 * 2048, nullptr, 2048, 1024, p.pp->in[18] + 5 * 1024, 2, tl);
  tconv_job(p.pp->in[22], 1024, 64, 1024, 0, 0, 1024, WT + W_RWKV_W2, nullptr, 64, 0, nullptr, 0, tl);
  tconv_job(p.pp->in[25], 1024, 64, 1024, 0, 0, 1024, WT + W_RWKV_A2, nullptr, 64, 0, nullptr, 0, tl);
  tconv_job(p.pp->in[31], 1024, 1024, 1024, 0, 0, 1024, WT + W_RWKV_OUT, nullptr, 1024, 0, nullptr, 0, tl);
  tconv_job(p.pp->in[32], 3088, 1024, 3328, 0, 0, 3088, WT + W_GLA_IN, nullptr, 1024, 0, nullptr, 0, tl);
  tconv_job(p.pp->in[36], 1024, 1024, 1024, 0, 0, 1024, WT + W_GLA_OUT, nullptr, 1024, 0, nullptr, 0, tl);
  for (int idx = blockIdx.x * NTHR + tid; idx < 16 * 128 * 64; idx += gridDim.x * NTHR) {
    int n = idx >> 13, pp = (idx >> 6) & 127, k = idx & 63;
    int wc = pp >> 6, jn = (pp >> 4) & 3, fr = pp & 15;
    int type = jn & 1, d = wc * 32 + (jn >> 1) * 16 + fr;
    const float* src = type ? p.pp->in[14] : p.pp->in[12];
    WT[W_LRU_GATE + idx] = f2bf(src[n * 4096 + k * 64 + d]);
  }
}

template <bool SHIFT, bool F16 = false, bool IN16 = false>
__device__ __forceinline__ void norm_phase(const PAcc& p, const void* __restrict__ xin, int layer, u16* __restrict__ Hhi, u16* __restrict__ Hlo) {
  const int lane = tid_() & 63;
  const int gw = blockIdx.x * (NTHR / 64) + (tid_() >> 6);
  const int nw = gridDim.x * (NTHR / 64);
  const float* gain = p.pp->in[2] + layer * 1024;
  const float* mod = (const float*)(p.pp->ws + WS_MOD) + (size_t)layer * 16 * 3072;
  for (int row = gw; row < T_; row += nw) {
    float4 v[4];
    float ss = 0.f;
    if (IN16) {
      const uint2* xr = (const uint2*)((const u16*)xin + (size_t)row * 1024);
#pragma unroll
      for (int i = 0; i < 4; ++i) { const uint2 t = xr[i * 64 + lane]; v[i] = make_float4(bflo(t.x), bfhi(t.x), bflo(t.y), bfhi(t.y)); }
    } else {
      const float4* xr = (const float4*)((const float*)xin + (size_t)row * 1024);
#pragma unroll
      for (int i = 0; i < 4; ++i) v[i] = xr[i * 64 + lane];
    }
#pragma unroll
    for (int i = 0; i < 4; ++i) ss += v[i].x * v[i].x + v[i].y * v[i].y + v[i].z * v[i].z + v[i].w * v[i].w;
#pragma unroll
    for (int m = 32; m >= 1; m >>= 1) ss += __shfl_xor(ss, m);
    const float rstd = rsqrtf(ss * (1.f / 1024.f) + 1e-6f);
    const float* mb = mod + (size_t)(row >> 11) * 3072;
#pragma unroll
    for (int i = 0; i < 4; ++i) {
      const int c = i * 256 + lane * 4;
      float4 g = *(const float4*)(gain + c);
      float4 sh = *(const float4*)(mb + c);
      float4 sc = *(const float4*)(mb + 1024 + c);
      float y0 = v[i].x * rstd * g.x * (1.f + sc.x) + sh.x;
      float y1 = v[i].y * rstd * g.y * (1.f + sc.y) + sh.y;
      float y2 = v[i].z * rstd * g.z * (1.f + sc.z) + sh.z;
      float y3 = v[i].w * rstd * g.w * (1.f + sc.w) + sh.w;
      uint2 o;
      if (F16) { o.x = packh2(y0, y1); o.y = packh2(y2, y3); }
      else { o.x = pack2(y0, y1); o.y = pack2(y2, y3); }
      if (SHIFT) {
        *(uint2*)(Hhi + (size_t)row * 2048 + c) = o;
        if (((row + 1) & 2047) != 0) *(uint2*)(Hhi + (size_t)(row + 1) * 2048 + 1024 + c) = o;
        if ((row & 2047) == 0) *(uint2*)(Hhi + (size_t)row * 2048 + 1024 + c) = make_uint2(0u, 0u);
      } else {
        *(uint2*)(Hhi + (size_t)row * 1024 + c) = o;
      }
      if (!SHIFT && Hlo) {
        uint2 l;
        l.x = packh2(y0 - hlo(o.x), y1 - hhi(o.x));
        l.y = packh2(y2 - hlo(o.y), y3 - hhi(o.y));
        *(uint2*)(Hlo + (size_t)row * 1024 + c) = l;
      }
    }
  }
}

enum { EPI_PLAIN = 0, EPI_DSA_MAIN, EPI_DSA_IDX, EPI_RESID, EPI_RWKV_L1, EPI_RWKV_W, EPI_RWKV_A };
struct EpiP {
  u16* o16; u16* o16b; u16* o16c; u16* o16d; float* of; const float* f0; const float* f1; const float* f2; const float* f3;
  int ldc; int nvalid;
};
constexpr int LROW = 40;

template <int EPI>
__device__ __forceinline__ void gemm_epilogue(const EpiP& e, const PAcc& p, f32x4 (&acc)[4][4], int rowbase, int colbase, int nt, int wc, int fr, int fq) {
  if (EPI == EPI_PLAIN) {
#pragma unroll
    for (int i = 0; i < 4; ++i)
#pragma unroll
      for (int j = 0; j < 4; ++j) {
        const int col = colbase + j * 16 + fr;
        if (col < e.nvalid) {
#pragma unroll
          for (int r = 0; r < 4; ++r) e.o16[(size_t)(rowbase + i * 16 + fq * 4 + r) * e.ldc + col] = f2bf(acc[i][j][r]);
        }
      }
  } else if (EPI == EPI_DSA_MAIN) {
    if (nt < 10) {
      const float* gain = (nt < 8) ? e.f0 : e.f1;
      const float g0 = gain[fr], g1 = gain[16 + fr], g2 = gain[32 + fr], g3 = gain[48 + fr];
      const float2* rope = (const float2*)(p.pp->ws + WS_ROPE64);
#pragma unroll
      for (int i = 0; i < 4; ++i)
#pragma unroll
        for (int r = 0; r < 4; ++r) {
          float v0 = acc[i][0][r], v1 = acc[i][1][r], v2 = acc[i][2][r], v3 = acc[i][3][r];
          float ss = v0 * v0 + v1 * v1 + v2 * v2 + v3 * v3;
          ss += __shfl_xor(ss, 1); ss += __shfl_xor(ss, 2); ss += __shfl_xor(ss, 4); ss += __shfl_xor(ss, 8);
          const float rstd = rsqrtf(ss * (1.f / 64.f) + 1e-6f);
          v0 *= rstd * g0; v1 *= rstd * g1; v2 *= rstd * g2; v3 *= rstd * g3;
          const int row = rowbase + i * 16 + fq * 4 + r;
          const int pos = row & 2047;
          const float2 ca = rope[pos * 32 + fr], cb = rope[pos * 32 + 16 + fr];
          const float o0 = v0 * ca.x - v2 * ca.y, o2 = v2 * ca.x + v0 * ca.y;
          const float o1 = v1 * cb.x - v3 * cb.y, o3 = v3 * cb.x + v1 * cb.y;
          u16* d = e.o16 + (size_t)row * 2560 + colbase + fr;
          d[0] = f2bf(o0); d[16] = f2bf(o1); d[32] = f2bf(o2); d[48] = f2bf(o3);
        }
    } else {
#pragma unroll
      for (int i = 0; i < 4; ++i)
#pragma unroll
        for (int j = 0; j < 4; ++j)
#pragma unroll
          for (int r = 0; r < 4; ++r) e.o16[(size_t)(rowbase + i * 16 + fq * 4 + r) * 2560 + colbase + j * 16 + fr] = f2bf(acc[i][j][r]);
    }
  } else if (EPI == EPI_DSA_IDX) {
    if (nt < 9) {
      const float2* rope = (const float2*)(p.pp->ws + WS_ROPE128);
#pragma unroll
      for (int i = 0; i < 4; ++i)
#pragma unroll
        for (int r = 0; r < 4; ++r) {
          const int row = rowbase + i * 16 + fq * 4 + r;
          const int pos = row & 2047;
#pragma unroll
          for (int jj = 0; jj < 2; ++jj) {
            const int ii = wc * 32 + jj * 16 + fr;
            const float2 cs = rope[pos * 64 + ii];
            const float x1 = acc[i][jj][r], x2 = acc[i][jj + 2][r];
            const float o1 = x1 * cs.x - x2 * cs.y, o2 = x2 * cs.x + x1 * cs.y;
            const u16 h1 = f2bf(o1), h2 = f2bf(o2);
            const u16 l1 = f2bf(o1 - bf2f(h1)), l2 = f2bf(o2 - bf2f(h2));
            if (nt < 8) {
              size_t o = (size_t)row * 1024 + nt * 128 + ii;
              e.o16[o] = h1; e.o16[o + 64] = h2; e.o16b[o] = l1; e.o16b[o + 64] = l2;
            } else {
              size_t o = (size_t)row * 128 + ii;
              e.o16c[o] = h1; e.o16c[o + 64] = h2; e.o16d[o] = l1; e.o16d[o + 64] = l2;
            }
          }
        }
    } else {
      if (wc == 0 && fr < 8) {
#pragma unroll
        for (int i = 0; i < 4; ++i)
#pragma unroll
          for (int r = 0; r < 4; ++r) e.of[(size_t)(rowbase + i * 16 + fq * 4 + r) * 8 + fr] = acc[i][0][r] * 0.03125f;
      }
    }
  } else if (EPI == EPI_RESID) {
#pragma unroll
    for (int i = 0; i < 4; ++i)
#pragma unroll
      for (int j = 0; j < 4; ++j) {
        const int col = colbase + j * 16 + fr;
#pragma unroll
        for (int r = 0; r < 4; ++r) {
          const int row = rowbase + i * 16 + fq * 4 + r;
          const float gate = e.f1[(size_t)(row >> 11) * 3072 + 2048 + col];
          const size_t o = (size_t)row * 1024 + col;
          e.of[o] = e.f0[o] + gate * acc[i][j][r];
        }
      }
  } else if (EPI == EPI_RWKV_L1) {
#pragma unroll
    for (int i = 0; i < 4; ++i)
#pragma unroll
      for (int j = 0; j < 4; ++j) {
        const int col = colbase + j * 16 + fr;
#pragma unroll
        for (int r = 0; r < 4; ++r) {
          float v = acc[i][j][r];
          if (col < 64) v = 1.f - 2.f * __builtin_amdgcn_rcpf(1.f + __expf(2.f * v));
          e.o16[(size_t)(rowbase + i * 16 + fq * 4 + r) * 128 + col] = f2bf(v);
        }
      }
  } else if (EPI == EPI_RWKV_W) {
#pragma unroll
    for (int i = 0; i < 4; ++i)
#pragma unroll
      for (int j = 0; j < 4; ++j) {
        const int col = colbase + j * 16 + fr;
        const float w0 = e.f0[col];
#pragma unroll
        for (int r = 0; r < 4; ++r) {
          const float w = w0 + acc[i][j][r];
          e.of[(size_t)(rowbase + i * 16 + fq * 4 + r) * 1024 + col] = sigmoid_(w) * 0.60653065971f;
        }
      }
  } else if (EPI == EPI_RWKV_A) {
#pragma unroll
    for (int i = 0; i < 4; ++i)
#pragma unroll
      for (int j = 0; j < 4; ++j) {
        const int col = colbase + j * 16 + fr;
        const float a0 = e.f0[col];
#pragma unroll
        for (int r = 0; r < 4; ++r)
          e.o16[(size_t)(rowbase + i * 16 + fq * 4 + r) * 1024 + col] = f2bf(sigmoid_(a0 + acc[i][j][r]));
      }
  }
}

template <int EPI>
__device__ __forceinline__ void gemm_phase(const PAcc& p, const u16* A0, const u16* A1, const u16* A2, const u16* B0, const u16* B1, const u16* B2,
                           int lda, int ldb, int kseg, int nseg, int shiftmask, int ntn, const EpiP& e, char* ldsc) {
  const int tid = tid_(), lane = tid & 63, wave = tid >> 6;
  const int wr = wave >> 1, wc = wave & 1, fr = lane & 15, fq = lane >> 4;
  u16* As = (u16*)ldsc;
  u16* Bs = As + 2 * 256 * LROW;
  const int kps = kseg >> 5;
  const int nk = nseg * kps;
  const int ntiles = 128 * ntn;
  const int lrow = tid >> 2, lkc = (tid & 3) * 8;
  for (int tile = blockIdx.x; tile < ntiles; tile += gridDim.x) {
    const int mt = tile / ntn, nt = tile - mt * ntn;
    const int m0 = mt * 256, n0 = nt * 128;
    f32x4 acc[4][4];
#pragma unroll
    for (int i = 0; i < 4; ++i)
#pragma unroll
      for (int j = 0; j < 4; ++j) acc[i][j] = (f32x4){0.f, 0.f, 0.f, 0.f};
    uint4 ra0, ra1, rb;
#define GLOAD(ks_)                                                                           \
  {                                                                                          \
    const int s_ = (ks_) / kps;                                                              \
    const int kk_ = ((ks_) - s_ * kps) << 5;                                                 \
    const u16* Ap_ = s_ == 0 ? A0 : (s_ == 1 ? A1 : A2);                                     \
    const u16* Bp_ = s_ == 0 ? B0 : (s_ == 1 ? B1 : B2);                                     \
    const int sh_ = (shiftmask >> s_) & 1;                                                   \
    const int g0_ = m0 + lrow, g1_ = m0 + 128 + lrow;                                        \
    ra0 = (sh_ && (g0_ & 2047) == 0) ? make_uint4(0, 0, 0, 0) : *(const uint4*)(Ap_ + (size_t)(g0_ - sh_) * lda + kk_ + lkc); \
    ra1 = (sh_ && (g1_ & 2047) == 0) ? make_uint4(0, 0, 0, 0) : *(const uint4*)(Ap_ + (size_t)(g1_ - sh_) * lda + kk_ + lkc); \
    rb = *(const uint4*)(Bp_ + (size_t)(n0 + lrow) * ldb + kk_ + lkc);                       \
  }
#define LSTORE(buf_)                                                                         \
  {                                                                                          \
    *(uint4*)(As + ((buf_) * 256 + lrow) * LROW + lkc) = ra0;                                \
    *(uint4*)(As + ((buf_) * 256 + 128 + lrow) * LROW + lkc) = ra1;                          \
    *(uint4*)(Bs + ((buf_) * 128 + lrow) * LROW + lkc) = rb;                                 \
  }
    GLOAD(0);
    LSTORE(0);
    __syncthreads();
    for (int ks = 0; ks < nk; ++ks) {
      const int buf = ks & 1;
      if (ks + 1 < nk) GLOAD(ks + 1);
      bf16x8 af[4], bfr[4];
#pragma unroll
      for (int i = 0; i < 4; ++i) af[i] = *(const bf16x8*)(As + (buf * 256 + wr * 64 + i * 16 + fr) * LROW + fq * 8);
#pragma unroll
      for (int j = 0; j < 4; ++j) bfr[j] = *(const bf16x8*)(Bs + (buf * 128 + wc * 64 + j * 16 + fr) * LROW + fq * 8);
#pragma unroll
      for (int i = 0; i < 4; ++i)
#pragma unroll
        for (int j = 0; j < 4; ++j) acc[i][j] = mfma16(af[i], bfr[j], acc[i][j]);
      if (ks + 1 < nk) LSTORE(buf ^ 1);
      __syncthreads();
    }
#undef GLOAD
#undef LSTORE
    gemm_epilogue<EPI>(e, p, acc, m0 + wr * 64, n0 + wc * 64, nt, wc, fr, fq);
  }
}


namespace pg8 {
#define PG8_LAS __attribute__((address_space(3)))
typedef unsigned u32x4 __attribute__((ext_vector_type(4)));
constexpr int BM = 256, BK = 64, HALF = 128, HTB = HALF * BK * 2, NXCD = 8, WGM = 8;
__device__ __forceinline__ int lds_byte(int r, int c) { const int st = (r >> 4) * 2 + (c >> 5), rr = r & 15, cc = c & 31, ob = rr * 64 + cc * 2; return st * 1024 + (ob ^ (((ob >> 9) & 1) << 5)); }
__device__ __forceinline__ void stage_rc(int b, int& R, int& C) { const int st = b / 1024, sb = b % 1024, swz = sb ^ (((sb >> 9) & 1) << 5); R = (st >> 1) * 16 + swz / 64; C = (st & 1) * 32 + (swz % 64) / 2; }
__device__ __forceinline__ int perm32(int rho) { const int n = rho >> 4, i = rho & 15; return 8 * (i >> 2) + 4 * n + (i & 3); }
struct Unit { int pm, pn; };
struct GemmD { const u16 *A0, *A1, *A2, *B0, *B1, *B2; int lda, ldb, lgnts, nseg, M, N; };
struct StaticOrder {
  int nM, nN, nwg, G, c;
  __device__ void init(int M, int N, int G_, int c_) { nM = M / BM; nN = N / BM; nwg = nM * nN; G = G_; c = c_; }
  __device__ bool next(int i, Unit& u) const {
    const long L = (long)i * G + c; if (L >= nwg) return false;
    int wgid = (int)L; { const int q = nwg / NXCD, r = nwg % NXCD, xcd = wgid % NXCD, off = wgid / NXCD; wgid = (xcd < r ? xcd * (q + 1) : r * (q + 1) + (xcd - r) * q) + off; }
    const int nig = WGM * nN, gid = wgid / nig, fm = gid * WGM, gsz = (nM - fm) < WGM ? (nM - fm) : WGM;
    u.pm = fm + ((wgid % nig) % gsz); u.pn = (wgid % nig) / gsz; return true;
  }
};
__device__ __forceinline__ unsigned cvt_pk_bf16(float lo, float hi) { unsigned r; asm volatile("v_cvt_pk_bf16_f32 %0, %1, %2" : "=v"(r) : "v"(lo), "v"(hi)); return r; }

struct EpiPlain {
  static constexpr bool PERM = true;
  u16* O; int ldc; int nvalid;
  __device__ __forceinline__ void operator()(const f32x4 (&acc)[2][2][4][2], const Unit& u, int wr, int wc, int fr, int fq) const {
    asm volatile("" : "+v"(fr), "+v"(fq));
    const int row0 = u.pm * BM + wr * 64 + fr, col0 = u.pn * BM + wc * 32 + 8 * fq;
#pragma unroll
    for (int ai = 0; ai < 2; ++ai)
#pragma unroll
      for (int m = 0; m < 4; ++m) {
        u16* rowp = O + (size_t)(row0 + ai * HALF + m * 16) * ldc;
#pragma unroll
        for (int bj = 0; bj < 2; ++bj) {
          const int col = col0 + bj * HALF;
          if (col < nvalid) {
            const f32x4 v0 = acc[ai][bj][m][0], v1 = acc[ai][bj][m][1];
            u32x4 w; w.x = cvt_pk_bf16(v0[0], v0[1]); w.y = cvt_pk_bf16(v0[2], v0[3]); w.z = cvt_pk_bf16(v1[0], v1[1]); w.w = cvt_pk_bf16(v1[2], v1[3]);
            *(u32x4*)(rowp + col) = w;
          }
        }
      }
  }
};
template <bool IN16, bool OUT16>
struct EpiResid {
  static constexpr bool PERM = true;
  void* out; const void* xin; const float* mod;
  __device__ __forceinline__ void operator()(const f32x4 (&acc)[2][2][4][2], const Unit& u, int wr, int wc, int fr, int fq) const {
    asm volatile("" : "+v"(fr), "+v"(fq));
    const int row0 = u.pm * BM + wr * 64 + fr, col0 = u.pn * BM + wc * 32 + 8 * fq;
#pragma unroll
    for (int ai = 0; ai < 2; ++ai)
#pragma unroll
      for (int m = 0; m < 4; ++m) {
        const int row = row0 + ai * HALF + m * 16;
        const float* gp = mod + (size_t)(row >> 11) * 3072 + 2048;
#pragma unroll
        for (int bj = 0; bj < 2; ++bj) {
          const int col = col0 + bj * HALF;
          const size_t o = (size_t)row * 1024 + col;
          const f32x4 g0 = *(const f32x4*)(gp + col), g1 = *(const f32x4*)(gp + col + 4);
          f32x4 x0, x1;
          if (IN16) {
            const u32x4 xv = *(const u32x4*)((const u16*)xin + o);
            x0 = (f32x4){bflo(xv.x), bfhi(xv.x), bflo(xv.y), bfhi(xv.y)};
            x1 = (f32x4){bflo(xv.z), bfhi(xv.z), bflo(xv.w), bfhi(xv.w)};
          } else {
            x0 = *(const f32x4*)((const float*)xin + o); x1 = *(const f32x4*)((const float*)xin + o + 4);
          }
          const f32x4 y0 = x0 + g0 * acc[ai][bj][m][0], y1 = x1 + g1 * acc[ai][bj][m][1];
          if (OUT16) {
            u32x4 w; w.x = cvt_pk_bf16(y0[0], y0[1]); w.y = cvt_pk_bf16(y0[2], y0[3]); w.z = cvt_pk_bf16(y1[0], y1[1]); w.w = cvt_pk_bf16(y1[2], y1[3]);
            *(u32x4*)((u16*)out + o) = w;
          } else {
            *(f32x4*)((float*)out + o) = y0; *(f32x4*)((float*)out + o + 4) = y1;
          }
        }
      }
  }
};
struct EpiDsaMain {
  static constexpr bool PERM = true;
  u16* O; const float* qg; const float* kg; const float2* rope; u16* VT;
  __device__ __forceinline__ void operator()(const f32x4 (&acc)[2][2][4][2], const Unit& u, int wr, int wc, int fr, int fq) const {
    asm volatile("" : "+v"(fr), "+v"(fq));
    const int row0 = u.pm * BM + wr * 64 + fr;
    if (u.pn <= 4) {
      const float* gain = (u.pn < 4) ? qg : kg;
      const int cb = u.pn * 256 + wc * 64 + 8 * fq;
#pragma unroll
      for (int ai = 0; ai < 2; ++ai)
#pragma unroll
        for (int m = 0; m < 4; ++m) {
          const int row = row0 + ai * HALF + m * 16;
          float ss = 0.f;
#pragma unroll
          for (int n = 0; n < 2; ++n)
#pragma unroll
            for (int j = 0; j < 4; ++j) { const float x = acc[ai][0][m][n][j], y = acc[ai][1][m][n][j]; ss += x * x + y * y; }
          ss += __shfl_xor(ss, 16); ss += __shfl_xor(ss, 32);
          const float rstd = rsqrtf(ss * (1.f / 64.f) + 1e-6f);
          const float2* rp = rope + (row & 2047) * 32 + 8 * fq;
          u16* d = O + (size_t)row * 2560 + cb;
#pragma unroll
          for (int n = 0; n < 2; ++n) {
            float ol[4], oh[4];
#pragma unroll
            for (int j = 0; j < 4; ++j) {
              const int e = 4 * n + j;
              const float2 cs = rp[e];
              const float xn = acc[ai][0][m][n][j] * rstd * gain[8 * fq + e], yn = acc[ai][1][m][n][j] * rstd * gain[32 + 8 * fq + e];
              ol[j] = xn * cs.x - yn * cs.y; oh[j] = yn * cs.x + xn * cs.y;
            }
            uint2 w; w.x = cvt_pk_bf16(ol[0], ol[1]); w.y = cvt_pk_bf16(ol[2], ol[3]);
            *(uint2*)(d + 4 * n) = w;
            w.x = cvt_pk_bf16(oh[0], oh[1]); w.y = cvt_pk_bf16(oh[2], oh[3]);
            *(uint2*)(d + 32 + 4 * n) = w;
          }
        }
    } else if (u.pn == 5) {
#pragma unroll
      for (int ai = 0; ai < 2; ++ai)
#pragma unroll
        for (int m = 0; m < 4; ++m) {
          const int row = row0 + ai * HALF + m * 16;
          u16* vb = VT + (size_t)(row >> 11) * 256 * 2048 + (row & 2047);
#pragma unroll
          for (int bj = 0; bj < 2; ++bj)
#pragma unroll
            for (int n = 0; n < 2; ++n)
#pragma unroll
              for (int j = 0; j < 4; ++j) vb[(size_t)(128 * bj + 32 * wc + 8 * fq + 4 * n + j) * 2048] = f2bf(acc[ai][bj][m][n][j]);
        }
    } else {
      const int col0 = u.pn * BM + wc * 32 + 8 * fq;
#pragma unroll
      for (int ai = 0; ai < 2; ++ai)
#pragma unroll
        for (int m = 0; m < 4; ++m) {
          u16* rowp = O + (size_t)(row0 + ai * HALF + m * 16) * 2560 + col0;
#pragma unroll
          for (int bj = 0; bj < 2; ++bj) {
            const f32x4 v0 = acc[ai][bj][m][0], v1 = acc[ai][bj][m][1];
            u32x4 w; w.x = cvt_pk_bf16(v0[0], v0[1]); w.y = cvt_pk_bf16(v0[2], v0[3]); w.z = cvt_pk_bf16(v1[0], v1[1]); w.w = cvt_pk_bf16(v1[2], v1[3]);
            *(u32x4*)(rowp + bj * HALF) = w;
          }
        }
    }
  }
};
struct EpiDsaIdx {
  static constexpr bool PERM = true;
  u16 *qh, *ql, *kh, *kl; float* wi; const float2* rope;
  __device__ __forceinline__ void operator()(const f32x4 (&acc)[2][2][4][2], const Unit& u, int wr, int wc, int fr, int fq) const {
    asm volatile("" : "+v"(fr), "+v"(fq));
    const int row0 = u.pm * BM + wr * 64 + fr;
    if (u.pn < 4 || wc < 2) {
      const int dl = 32 * (wc & 1) + 8 * fq;
      u16* dh; size_t ld; int cb;
      if (u.pn < 4) { dh = qh; ld = 1024; cb = (u.pn * 2 + (wc >> 1)) * 128 + dl; }
      else { dh = kh; ld = 128; cb = dl; }
#pragma unroll
      for (int ai = 0; ai < 2; ++ai)
#pragma unroll
        for (int m = 0; m < 4; ++m) {
          const int row = row0 + ai * HALF + m * 16;
          const float2* rp = rope + (row & 2047) * 64 + dl;
          const size_t o = (size_t)row * ld + cb;
#pragma unroll
          for (int n = 0; n < 2; ++n) {
            float o1[4], o2[4];
#pragma unroll
            for (int j = 0; j < 4; ++j) {
              const float2 cs = rp[4 * n + j];
              const float x = acc[ai][0][m][n][j], y = acc[ai][1][m][n][j];
              o1[j] = x * cs.x - y * cs.y; o2[j] = y * cs.x + x * cs.y;
            }
            uint2 h1, h2;
            h1.x = packh2(o1[0], o1[1]); h1.y = packh2(o1[2], o1[3]);
            h2.x = packh2(o2[0], o2[1]); h2.y = packh2(o2[2], o2[3]);
            *(uint2*)(dh + o + 4 * n) = h1; *(uint2*)(dh + o + 64 + 4 * n) = h2;
          }
        }
    } else if (wc == 2 && fq == 0) {
#pragma unroll
      for (int ai = 0; ai < 2; ++ai)
#pragma unroll
        for (int m = 0; m < 4; ++m) {
          const int row = row0 + ai * HALF + m * 16;
          *(f32x4*)(wi + (size_t)row * 8) = acc[ai][0][m][0] * 0.03125f;
          *(f32x4*)(wi + (size_t)row * 8 + 4) = acc[ai][0][m][1] * 0.03125f;
        }
    }
  }
};

template <class Epi, bool F16>
__device__ __forceinline__ void gemm_phase(PG8_LAS unsigned char* lds, const GemmD g, const StaticOrder& S, const Epi& E) {
  const int tid = tid_(), wid = __builtin_amdgcn_readfirstlane(tid >> 6), lane = tid & 63, wr = wid >> 2, wc = wid & 3, fr = lane & 15, fq = lane >> 4;
  const int lg = g.lgnts, nts = 1 << lg, nt = nts * g.nseg;
  unsigned voffA[2], voffB[2];
#pragma unroll
  for (int i = 0; i < 2; ++i) { int R, C; stage_rc(tid * 16 + i * 8192, R, C); const int Rb = Epi::PERM ? ((R & ~31) + perm32(R & 31)) : R;
    voffA[i] = (unsigned)(R * g.lda + C) * 2u; voffB[i] = (unsigned)(Rb * g.ldb + C) * 2u; }
  const size_t kstep = (size_t)(BK * 2);
  const size_t hstepA = (size_t)HALF * g.lda * 2, hstepB = (size_t)HALF * g.ldb * 2;
  const size_t tstepA = 2 * hstepA, tstepB = 2 * hstepB;
  const unsigned ldsw = (unsigned)wid * 1024u;
  const int aoff = lds_byte(wr * 64 + fr, fq * 8), boff = lds_byte(wc * 32 + fr, fq * 8);
#define PG8_APTR(pm_, t_) ((const char*)((((t_) >> lg) == 0) ? g.A0 : ((((t_) >> lg) == 1) ? g.A1 : g.A2)) + (size_t)(pm_) * tstepA + (size_t)((t_) & (nts - 1)) * kstep)
#define PG8_BPTR(pn_, t_) ((const char*)((((t_) >> lg) == 0) ? g.B0 : ((((t_) >> lg) == 1) ? g.B1 : g.B2)) + (size_t)(pn_) * tstepB + (size_t)((t_) & (nts - 1)) * kstep)
#define PG8_SA(b, h) (((b) * 2 + (h)) * HTB)
#define PG8_SB(b, h) ((4 + (b) * 2 + (h)) * HTB)
#define PG8_STAGE(bufoff, gbase, voff) do { _Pragma("unroll") for (int _i = 0; _i < 2; ++_i) \
    __builtin_amdgcn_global_load_lds((const unsigned*)((const char*)(gbase) + (voff)[_i]), (PG8_LAS unsigned*)(lds + (bufoff) + ldsw + _i * 8192), 16, 0, 0); } while (0)
#define PG8_LDA(dst, b, h) do { _Pragma("unroll") for (int m = 0; m < 4; ++m) _Pragma("unroll") for (int k = 0; k < 2; ++k) dst[m][k] = *(const PG8_LAS bf16x8*)(lds + PG8_SA(b, h) + aoff + m * 2048 + k * 1024); } while (0)
#define PG8_LDB(dst, b, h) do { _Pragma("unroll") for (int n = 0; n < 2; ++n) _Pragma("unroll") for (int k = 0; k < 2; ++k) dst[n][k] = *(const PG8_LAS bf16x8*)(lds + PG8_SB(b, h) + boff + n * 2048 + k * 1024); } while (0)
#define PG8_MMA(ai, bj, At, Bt) do { __builtin_amdgcn_s_setprio(1); _Pragma("unroll") for (int m = 0; m < 4; ++m) _Pragma("unroll") for (int n = 0; n < 2; ++n) _Pragma("unroll") for (int k = 0; k < 2; ++k) \
    acc[ai][bj][m][n] = F16 ? mfma16h(Bt[n][k], At[m][k], acc[ai][bj][m][n]) : __builtin_amdgcn_mfma_f32_16x16x32_bf16(Bt[n][k], At[m][k], acc[ai][bj][m][n], 0, 0, 0); __builtin_amdgcn_s_setprio(0); } while (0)
#define PG8_WAIT_V(n) asm volatile("s_waitcnt vmcnt(" #n ")" ::: "memory")
#define PG8_WAIT_L(n) asm volatile("s_waitcnt lgkmcnt(" #n ")" ::: "memory")
#define PG8_BAR __builtin_amdgcn_s_barrier()
#define PG8_SCHED __builtin_amdgcn_sched_barrier(0)
  Unit cur, nxt; int ui = 0;
  if (!S.next(0, cur)) return;
  f32x4 acc[2][2][4][2];
#pragma unroll
  for (int a = 0; a < 2; ++a)
#pragma unroll
    for (int b = 0; b < 2; ++b)
#pragma unroll
      for (int m = 0; m < 4; ++m)
#pragma unroll
        for (int n = 0; n < 2; ++n) acc[a][b][m][n] = (f32x4){0.f, 0.f, 0.f, 0.f};
  bf16x8 At[4][2], B0[2][2], B1[2][2];
  {
    const char* cA = PG8_APTR(cur.pm, 0); const char* cB = PG8_BPTR(cur.pn, 0);
    PG8_STAGE(PG8_SB(0, 0), cB, voffB); PG8_STAGE(PG8_SA(0, 0), cA, voffA); PG8_STAGE(PG8_SB(0, 1), cB + hstepB, voffB); PG8_STAGE(PG8_SA(0, 1), cA + hstepA, voffA);
    if (wr == 1) PG8_BAR;
    PG8_WAIT_V(4); PG8_BAR;
    PG8_STAGE(PG8_SB(1, 0), cB + kstep, voffB); PG8_STAGE(PG8_SA(1, 0), cA + kstep, voffA); PG8_STAGE(PG8_SB(1, 1), cB + hstepB + kstep, voffB);
    PG8_WAIT_V(6); PG8_BAR;
  }
  for (;;) {
    const bool has_next = S.next(ui + 1, nxt);
    const int npm = has_next ? nxt.pm : cur.pm, npn = has_next ? nxt.pn : cur.pn;
    for (int t = 0; t < nt; t += 2) {
      const bool last = (t == nt - 2);
      const char* a1 = PG8_APTR(cur.pm, t + 1);
      const char* a2 = last ? PG8_APTR(npm, 0) : PG8_APTR(cur.pm, t + 2);
      const char* b2 = last ? PG8_BPTR(npn, 0) : PG8_BPTR(cur.pn, t + 2);
      const char* a3 = a2 + kstep; const char* b3 = b2 + kstep;
      PG8_LDB(B0, 0, 0); PG8_SCHED; PG8_LDA(At, 0, 0); PG8_STAGE(PG8_SA(1, 1), a1 + hstepA, voffA);
      PG8_WAIT_L(8); PG8_BAR; PG8_WAIT_L(0); PG8_MMA(0, 0, At, B0); PG8_BAR; PG8_SCHED;
      PG8_LDB(B1, 0, 1); PG8_STAGE(PG8_SB(0, 0), b2, voffB);
      PG8_BAR; PG8_WAIT_L(0); PG8_MMA(0, 1, At, B1); PG8_BAR;
      PG8_LDA(At, 0, 1); PG8_STAGE(PG8_SA(0, 0), a2, voffA);
      PG8_BAR; PG8_WAIT_L(0); PG8_MMA(1, 0, At, B0); PG8_BAR; PG8_SCHED;
      PG8_STAGE(PG8_SB(0, 1), b2 + hstepB, voffB);
      PG8_WAIT_V(6); PG8_BAR; PG8_MMA(1, 1, At, B1); PG8_BAR;
      PG8_LDB(B0, 1, 0); PG8_SCHED; PG8_LDA(At, 1, 0); PG8_STAGE(PG8_SA(0, 1), a2 + hstepA, voffA);
      PG8_WAIT_L(8); PG8_BAR; PG8_WAIT_L(0); PG8_MMA(0, 0, At, B0); PG8_BAR; PG8_SCHED;
      PG8_LDB(B1, 1, 1); PG8_STAGE(PG8_SB(1, 0), b3, voffB);
      PG8_BAR; PG8_WAIT_L(0); PG8_MMA(0, 1, At, B1); PG8_BAR;
      PG8_LDA(At, 1, 1); PG8_STAGE(PG8_SA(1, 0), a3, voffA);
      PG8_BAR; PG8_WAIT_L(0); PG8_MMA(1, 0, At, B0); PG8_BAR; PG8_SCHED;
      PG8_STAGE(PG8_SB(1, 1), b3 + hstepB, voffB);
      PG8_WAIT_V(6); PG8_BAR; PG8_MMA(1, 1, At, B1); PG8_BAR;
    }
    E(acc, cur, wr, wc, fr, fq);
    if (!has_next) break;
#pragma unroll
    for (int a = 0; a < 2; ++a)
#pragma unroll
      for (int b = 0; b < 2; ++b)
#pragma unroll
        for (int m = 0; m < 4; ++m)
#pragma unroll
          for (int n = 0; n < 2; ++n) acc[a][b][m][n] = (f32x4){0.f, 0.f, 0.f, 0.f};
    cur = nxt; ++ui;
  }
  PG8_WAIT_V(0);
  if (wr == 0) PG8_BAR;
  PG8_BAR;
#undef PG8_APTR
#undef PG8_BPTR
#undef PG8_SA
#undef PG8_SB
#undef PG8_STAGE
#undef PG8_LDA
#undef PG8_LDB
#undef PG8_MMA
#undef PG8_WAIT_V
#undef PG8_WAIT_L
#undef PG8_BAR
#undef PG8_SCHED
}
template <class Epi, bool F16 = false>
__device__ __forceinline__ void run(char* lds, const u16* A0, const u16* A1, const u16* A2, const u16* B0, const u16* B1, const u16* B2,
                                    int lda, int ldb, int lgnts, int nseg, int N, const Epi& E) {
  GemmD g; g.A0 = A0; g.A1 = A1; g.A2 = A2; g.B0 = B0; g.B1 = B1; g.B2 = B2; g.lda = lda; g.ldb = ldb; g.lgnts = lgnts; g.nseg = nseg; g.M = T_; g.N = N;
  StaticOrder S; S.init(T_, N, (int)gridDim.x, (int)blockIdx.x);
  gemm_phase<Epi, F16>((PG8_LAS unsigned char*)lds, g, S, E);
}
}


template <int NE>
__device__ __forceinline__ void topk_row(const float* __restrict__ srow, int qpos, int lane, unsigned* __restrict__ mrow) {
  unsigned uk[NE];
#pragma unroll
  for (int e = 0; e < NE; ++e) {
    const int key = e * 64 + lane;
    const float v = srow[key];
    unsigned uu = __float_as_uint(v);
    uu = (uu & 0x80000000u) ? ~uu : (uu | 0x80000000u);
    uk[e] = (key <= qpos) ? uu : 0u;
  }
  unsigned prefix = 0u;
  for (int bit = 31; bit >= 0; --bit) {
    const unsigned cand = prefix | (1u << bit);
    int cnt = 0;
#pragma unroll
    for (int e = 0; e < NE; ++e) cnt += __popcll(__ballot(uk[e] >= cand));
    if (cnt >= 256) { prefix = cand; if (cnt == 256) break; }
  }
  int cgt = 0;
#pragma unroll
  for (int e = 0; e < NE; ++e) cgt += __popcll(__ballot(uk[e] > prefix));
  const int need = 256 - cgt;
  int eqused = 0;
  const unsigned long long lt = (1ull << lane) - 1ull;
#pragma unroll
  for (int e = 0; e < NE; ++e) {
    const bool gt = uk[e] > prefix, eq = uk[e] == prefix;
    const unsigned long long meq = __ballot(eq);
    const bool take = gt || (eq && (eqused + __popcll(meq & lt)) < need);
    const unsigned long long ms = __ballot(take);
    if (lane == 0) { mrow[2 * e] = (unsigned)ms; mrow[2 * e + 1] = (unsigned)(ms >> 32); }
    eqused += __popcll(meq);
  }
}

__device__ __forceinline__ void dsa_unit_phase(const PAcc& p, char* lds, bool st) {
  u16* qihi = (u16*)lds;
  unsigned* MASK = (unsigned*)lds;
  const u16* VT = (const u16*)(p.pp->ws + DSA_VT);
  float* wis = (float*)(lds + 73728);
  u16* QKVG = (u16*)(p.pp->ws + DSA_QKVG);
  const u16* QIH = (const u16*)(p.pp->ws + DSA_QIHI);
  const u16* KIH = (const u16*)(p.pp->ws + DSA_KIHI);
  const float* WI = (const float*)(p.pp->ws + DSA_WI);
  float* scr = (float*)(p.pp->ws + DSA_SCR) + (size_t)blockIdx.x * 16 * 2048;

  const bool xmap = (gridDim.x == 256);
  for (int u = blockIdx.x; u < 2048; u += gridDim.x) {
    const int tid = tid_(), lane = tid & 63, wave = tid >> 6, fr = lane & 15, fq = lane >> 4;
    int qt, b;
    if (xmap) { const int v = (blockIdx.x >> 3) + 32 * (u >> 8); b = 2 * (blockIdx.x & 7) + (v & 1); qt = 127 - (v >> 1); }
    else { qt = 127 - (u >> 4); b = u & 15; }
    const int q0 = qt * 16;
    const size_t tok0 = (size_t)b * 2048 + q0;
    const bool full = (q0 < 256);
    if (!full) {
#pragma unroll
      for (int i = 0; i < 4; ++i) {
        const int c = tid + i * NTHR;
        const int row = c >> 7, ch = c & 127;
        *(uint4*)(qihi + row * 1032 + ch * 8) = *(const uint4*)(QIH + (tok0 + row) * 1024 + ch * 8);
      }
      if (tid < 128) wis[tid] = WI[tok0 * 8 + tid];
      __syncthreads();
      const int nkeys = q0 + 16;
      const int nch = (nkeys + 31) >> 5;
      for (int rep_ = 0; rep_ < ((DUP == 6) ? 2 : 1); ++rep_)
      for (int c = wave; c < nch; c += 8) {
        const int kbase = c * 32;
        bf16x8 khi[2][4];
#pragma unroll
        for (int mt = 0; mt < 2; ++mt)
#pragma unroll
          for (int ks = 0; ks < 4; ++ks) {
            const size_t o = ((size_t)b * 2048 + kbase + mt * 16 + fr) * 128 + ks * 32 + fq * 8;
            khi[mt][ks] = *(const bf16x8*)(KIH + o);
          }
        f32x4 sc[2];
        sc[0] = (f32x4){0.f, 0.f, 0.f, 0.f}; sc[1] = sc[0];
#pragma unroll 1
        for (int h = 0; h < 8; ++h) {
          const float wv = wis[fr * 8 + h];
          f32x4 lg[2];
          lg[0] = (f32x4){0.f, 0.f, 0.f, 0.f}; lg[1] = lg[0];
#pragma unroll
          for (int ks = 0; ks < 4; ++ks) {
            const bf16x8 bh = *(const bf16x8*)(qihi + fr * 1032 + h * 128 + ks * 32 + fq * 8);
#pragma unroll
            for (int mt = 0; mt < 2; ++mt) {
              lg[mt] = mfma16h(khi[mt][ks], bh, lg[mt]);
            }
          }
#pragma unroll
          for (int mt = 0; mt < 2; ++mt)
#pragma unroll
            for (int r = 0; r < 4; ++r) sc[mt][r] += wv * fmaxf(lg[mt][r], 0.f);
        }
#pragma unroll
        for (int mt = 0; mt < 2; ++mt) *(f32x4*)(scr + fr * 2048 + kbase + mt * 16 + fq * 4) = sc[mt];
      }
    }
    __syncthreads();
    u16* QF = (u16*)(lds + 81920);
#pragma unroll
    for (int i = 0; i < 4; ++i) {
      const int c = tid + i * NTHR;
      const int row = c >> 7, ch = c & 127;
      *(uint4*)(QF + row * 1032 + ch * 8) = *(const uint4*)(QKVG + (tok0 + row) * 2560 + ch * 8);
    }
#pragma unroll 1
    for (int qi2 = 0; qi2 < ((DUP == 7) ? 4 : 2); ++qi2) {
      const int qq = wave * 2 + (qi2 & 1);
      const int qpos = q0 + qq;
      if (!full) {
        const int ng = ((q0 + 15) >> 8) + 1;
        const float* sr = scr + qq * 2048; unsigned* mr = MASK + qq * 64;
        switch (ng) {
          case 2: topk_row<8>(sr, qpos, lane, mr); break;
          case 3: topk_row<12>(sr, qpos, lane, mr); break;
          case 4: topk_row<16>(sr, qpos, lane, mr); break;
          case 5: topk_row<20>(sr, qpos, lane, mr); break;
          case 6: topk_row<24>(sr, qpos, lane, mr); break;
          case 7: topk_row<28>(sr, qpos, lane, mr); break;
          default: topk_row<32>(sr, qpos, lane, mr); break;
        }
      } else {
#pragma unroll
        for (int e = 0; e < 32; ++e) {
          const unsigned long long ms = __ballot((e * 64 + lane) <= qpos);
          if (lane == 0) { MASK[qq * 64 + 2 * e] = (unsigned)ms; MASK[qq * 64 + 2 * e + 1] = (unsigned)(ms >> 32); }
        }
      }
    }
    __syncthreads();
    {
      int fr_a = fr, fq_a = fq, lane_a = lane;
      asm volatile("" : "+v"(fr_a), "+v"(fq_a), "+v"(lane_a));
#define fr fr_a
#define fq fq_a
#define lane lane_a
      const int g = wave >> 1, half = wave & 1;
      float mq = fabsf(p.pp->in[6][lane]), mk = fabsf(p.pp->in[7][lane]);
#pragma unroll
      for (int mm = 32; mm >= 1; mm >>= 1) { mq = fmaxf(mq, __shfl_xor(mq, mm)); mk = fmaxf(mk, __shfl_xor(mk, mm)); }
      const float shift = 8.f * mq * mk; const float nshift2 = -shift * 1.44269504089f;
      const u16* qfp = QF + fr * 1032 + g * 256 + fq * 8;
      f32x4 o[4][4];
#pragma unroll
      for (int rr = 0; rr < 4; ++rr)
#pragma unroll
        for (int mt = 0; mt < 4; ++mt) o[rr][mt] = (f32x4){0.f, 0.f, 0.f, 0.f};
      float lsum[4] = {0.f, 0.f, 0.f, 0.f};
      const u16* Kb = QKVG + (size_t)b * 2048 * 2560 + 1024 + g * 64 + fq * 8 + (size_t)(8 * (fr >> 2) + (fr & 3)) * 2560;
      const u16* Vb = VT + (size_t)(b * 256 + g * 64 + fr) * 2048 + 8 * fq;
      const int nb = (q0 + 16 + 31) >> 5;
      bf16x8 kf[2][2], vf[4];
      {
        const int k0 = (half < nb ? half : 0) * 32;
#pragma unroll
        for (int s2 = 0; s2 < 2; ++s2)
#pragma unroll
          for (int ks = 0; ks < 2; ++ks) kf[s2][ks] = *(const bf16x8*)(Kb + (size_t)(k0 + 4 * s2) * 2560 + ks * 32);
#pragma unroll
        for (int mt = 0; mt < 4; ++mt) vf[mt] = *(const bf16x8*)(Vb + (size_t)mt * 16 * 2048 + k0);
      }
#pragma unroll 1
      for (int blk = half; blk < nb; blk += 2) {
        bf16x8 kn[2][2], vn[4];
        const int nx = (blk + 2 < nb) ? (blk + 2) * 32 : blk * 32;
#pragma unroll
        for (int s2 = 0; s2 < 2; ++s2)
#pragma unroll
          for (int ks = 0; ks < 2; ++ks) kn[s2][ks] = *(const bf16x8*)(Kb + (size_t)(nx + 4 * s2) * 2560 + ks * 32);
#pragma unroll
        for (int mt = 0; mt < 4; ++mt) vn[mt] = *(const bf16x8*)(Vb + (size_t)mt * 16 * 2048 + nx);
        const unsigned mw = MASK[fr * 64 + blk] >> (8 * fq);
        f32x4 mf[2];
#pragma unroll
        for (int s2 = 0; s2 < 2; ++s2)
#pragma unroll
          for (int r = 0; r < 4; ++r) mf[s2][r] = (float)((mw >> (4 * s2 + r)) & 1u);
#pragma unroll
        for (int rr = 0; rr < 4; ++rr) {
          float pv[8];
          f32x4 pq[2];
#pragma unroll
          for (int s2 = 0; s2 < 2; ++s2) {
            f32x4 stv = (f32x4){0.f, 0.f, 0.f, 0.f};
            stv = mfma16(kf[s2][0], *(const bf16x8*)(qfp + rr * 64), stv);
            stv = mfma16(kf[s2][1], *(const bf16x8*)(qfp + rr * 64 + 32), stv);
            stv = stv * (0.125f * 1.44269504089f) + nshift2;
#pragma unroll
            for (int r = 0; r < 4; ++r) stv[r] = __builtin_amdgcn_exp2f(stv[r]);
            pq[s2] = stv * mf[s2];
          }
          {
            const f32x4 sm_ = pq[0] + pq[1];
            lsum[rr] += (sm_[0] + sm_[1]) + (sm_[2] + sm_[3]);
          }
#pragma unroll
          for (int r = 0; r < 4; ++r) { pv[r] = pq[0][r]; pv[4 + r] = pq[1][r]; }
          union { bf16x8 v; unsigned w[4]; } pk;
          pk.w[0] = pg8::cvt_pk_bf16(pv[0], pv[1]); pk.w[1] = pg8::cvt_pk_bf16(pv[2], pv[3]);
          pk.w[2] = pg8::cvt_pk_bf16(pv[4], pv[5]); pk.w[3] = pg8::cvt_pk_bf16(pv[6], pv[7]);
#pragma unroll
          for (int mt = 0; mt < 4; ++mt) o[rr][mt] = mfma16(vf[mt], pk.v, o[rr][mt]);
        }
#pragma unroll
        for (int s2 = 0; s2 < 2; ++s2)
#pragma unroll
          for (int ks = 0; ks < 2; ++ks) kf[s2][ks] = kn[s2][ks];
#pragma unroll
        for (int mt = 0; mt < 4; ++mt) vf[mt] = vn[mt];
      }
      float* CB = (float*)(lds + 8192) + (size_t)g * 68 * 64 + lane;
      if (half == 1) {
#pragma unroll
        for (int rr = 0; rr < 4; ++rr) {
#pragma unroll
          for (int mt = 0; mt < 4; ++mt)
#pragma unroll
            for (int r = 0; r < 4; ++r) CB[((rr * 4 + mt) * 4 + r) * 64] = o[rr][mt][r];
          CB[(64 + rr) * 64] = lsum[rr];
        }
      }
      __syncthreads();
      if (half == 0) {
#pragma unroll
        for (int rr = 0; rr < 4; ++rr) {
          float l = lsum[rr] + CB[(64 + rr) * 64];
          l += __shfl_xor(l, 16); l += __shfl_xor(l, 32);
          const float inv = 1.f / l;
          const int h = g * 4 + rr;
#pragma unroll
          for (int mt = 0; mt < 4; ++mt) {
            u16* op = QKVG + (tok0 + fr) * 2560 + h * 64 + mt * 16 + fq * 4;
            const uint2 gg = *(const uint2*)(op + 1536);
            const float v0 = o[rr][mt][0] + CB[((rr * 4 + mt) * 4 + 0) * 64], v1 = o[rr][mt][1] + CB[((rr * 4 + mt) * 4 + 1) * 64];
            const float v2 = o[rr][mt][2] + CB[((rr * 4 + mt) * 4 + 2) * 64], v3 = o[rr][mt][3] + CB[((rr * 4 + mt) * 4 + 3) * 64];
            uint2 w;
            w.x = pg8::cvt_pk_bf16(v0 * inv * silu_(bflo(gg.x)), v1 * inv * silu_(bfhi(gg.x)));
            w.y = pg8::cvt_pk_bf16(v2 * inv * silu_(bflo(gg.y)), v3 * inv * silu_(bfhi(gg.y)));
            if (st) *(uint2*)op = w;
          }
        }
      }
#undef fr
#undef fq
#undef lane
    }
    __syncthreads();
  }
}

__device__ __forceinline__ void lru_gate_phase(const PAcc& p, char* lds) {
  const int tid = tid_(), lane = tid & 63, wave = tid >> 6;
  const int wr = wave >> 1, wc = wave & 1, fr = lane & 15, fq = lane >> 4;
  float* UC = (float*)lds;
  u16* Al = (u16*)(lds + 256 * 65 * 4);
  u16* Bl = Al + 256 * 72;
  const u16* UG = (const u16*)(p.pp->ws + LRU_UG);
  const u16* WG = (const u16*)(p.pp->ws + WS_WT) + W_LRU_GATE;
  float* LA = (float*)(p.pp->ws + LRU_A);
  float* LB = (float*)(p.pp->ws + LRU_B);
  for (int unit = blockIdx.x; unit < 2048; unit += gridDim.x) {
    const int n = unit & 15, mt = unit >> 4;
    const int m0 = mt * 256;
    {
      const int c = tid & 63, rg = tid >> 6;
      const int ch = n * 64 + c;
      const float w0 = p.pp->in[10][ch], w1 = p.pp->in[10][1024 + ch], w2 = p.pp->in[10][2048 + ch], w3 = p.pp->in[10][3072 + ch];
      const float cb = p.pp->in[11][ch];
      const int r0 = rg * 32;
      const int g0 = m0 + r0;
      float u3 = ((g0 & 2047) >= 3) ? bf2f(UG[(size_t)(g0 - 3) * 2048 + ch]) : 0.f;
      float u2 = ((g0 & 2047) >= 2) ? bf2f(UG[(size_t)(g0 - 2) * 2048 + ch]) : 0.f;
      float u1 = ((g0 & 2047) >= 1) ? bf2f(UG[(size_t)(g0 - 1) * 2048 + ch]) : 0.f;
#pragma unroll 8
      for (int r = 0; r < 32; ++r) {
        const float u0 = bf2f(UG[(size_t)(g0 + r) * 2048 + ch]);
        const float v = w0 * u3 + w1 * u2 + w2 * u1 + w3 * u0 + cb;
        UC[(r0 + r) * 65 + c] = v;
        Al[(r0 + r) * 72 + c] = f2bf(v);
        u3 = u2; u2 = u1; u1 = u0;
      }
#pragma unroll
      for (int i = 0; i < 2; ++i) {
        const int cidx = tid + i * NTHR;
        const int row = cidx >> 3, kc = (cidx & 7) * 8;
        *(uint4*)(Bl + row * 72 + kc) = *(const uint4*)(WG + (size_t)n * 8192 + row * 64 + kc);
      }
    }
    __syncthreads();
    f32x4 acc[4][4];
#pragma unroll
    for (int i = 0; i < 4; ++i)
#pragma unroll
      for (int j = 0; j < 4; ++j) acc[i][j] = (f32x4){0.f, 0.f, 0.f, 0.f};
#pragma unroll
    for (int ks = 0; ks < 2; ++ks) {
      bf16x8 af[4], bfr[4];
#pragma unroll
      for (int i = 0; i < 4; ++i) af[i] = *(const bf16x8*)(Al + (wr * 64 + i * 16 + fr) * 72 + ks * 32 + fq * 8);
#pragma unroll
      for (int j = 0; j < 4; ++j) bfr[j] = *(const bf16x8*)(Bl + (wc * 64 + j * 16 + fr) * 72 + ks * 32 + fq * 8);
#pragma unroll
      for (int i = 0; i < 4; ++i)
#pragma unroll
        for (int j = 0; j < 4; ++j) acc[i][j] = mfma16(af[i], bfr[j], acc[i][j]);
    }
#pragma unroll
    for (int jj = 0; jj < 2; ++jj) {
      const int d = wc * 32 + jj * 16 + fr;
      const int ch = n * 64 + d;
      const float ba = p.pp->in[13][ch], bx = p.pp->in[15][ch];
      const float spl = softplus_(-p.pp->in[16][ch]);
#pragma unroll
      for (int i = 0; i < 4; ++i)
#pragma unroll
        for (int r = 0; r < 4; ++r) {
          const int row = wr * 64 + i * 16 + fq * 4 + r;
          const float rr = sigmoid_(acc[i][jj * 2][r] + ba);
          const float ig = sigmoid_(acc[i][jj * 2 + 1][r] + bx);
          const float log_a = -8.f * rr * spl;
          const float a = __expf(log_a);
          const float bb = sqrtf(fmaxf(-expm1f(2.f * log_a), 0.f)) * (ig * UC[row * 65 + d]);
          const size_t o = (size_t)(m0 + row) * 1024 + ch;
          LA[o] = a; LB[o] = bb;
        }
    }
    __syncthreads();
  }
}


__device__ __forceinline__ void lru_fused_phase(const PAcc& p, char* lds) {
  const int tid = tid_(), lane = tid & 63, wave = tid >> 6;
  const int wr = wave >> 1, wc = wave & 1, fr = lane & 15, fq = lane >> 4;
  float* UB = (float*)lds;
  float* AA = UB + 128 * 65;
  u16* Al = (u16*)(AA + 128 * 65);
  u16* Bl = Al + 128 * 72;
  float* sA = (float*)(Bl + 128 * 72);
  float* sB = sA + 512;
  float* Hc = sB + 512;
  const u16* UG = (const u16*)(p.pp->ws + LRU_UG);
  const u16* WG = (const u16*)(p.pp->ws + WS_WT) + W_LRU_GATE;
  u16* OG = (u16*)(p.pp->ws + WS_H);
  const int c = tid & 63, rg = tid >> 6;
  for (int unit = blockIdx.x; unit < 256; unit += gridDim.x) {
    const int b = unit >> 4, n = unit & 15;
    const int ch = n * 64 + c;
    const float w0 = p.pp->in[10][ch], w1 = p.pp->in[10][1024 + ch], w2 = p.pp->in[10][2048 + ch], w3 = p.pp->in[10][3072 + ch];
    const float cb = p.pp->in[11][ch];
#pragma unroll
    for (int i = 0; i < 2; ++i) {
      const int cidx = tid + i * NTHR;
      const int row = cidx >> 3, kc = (cidx & 7) * 8;
      *(uint4*)(Bl + row * 72 + kc) = *(const uint4*)(WG + (size_t)n * 8192 + row * 64 + kc);
    }
    if (tid < 64) Hc[tid] = 0.f;
    float ba[2], bx[2], spl[2];
#pragma unroll
    for (int jj = 0; jj < 2; ++jj) {
      const int dch = n * 64 + wc * 32 + jj * 16 + fr;
      ba[jj] = p.pp->in[13][dch]; bx[jj] = p.pp->in[15][dch]; spl[jj] = softplus_(-p.pp->in[16][dch]);
    }
    u16 un[19], gn[16];
#define LRU_LOAD(mt_)                                                                      \
    { const size_t g0_ = (size_t)b * 2048 + (mt_) * 128 + rg * 16;                         \
      const int pos0_ = (mt_) * 128 + rg * 16;                                             \
      _Pragma("unroll") for (int r = 0; r < 3; ++r) un[r] = (pos0_ >= 3 - r) ? UG[(g0_ - 3 + r) * 2048 + ch] : (u16)0; \
      _Pragma("unroll") for (int r = 0; r < 16; ++r) { un[3 + r] = UG[(g0_ + r) * 2048 + ch]; gn[r] = UG[(g0_ + r) * 2048 + 1024 + ch]; } }
    LRU_LOAD(0);
#pragma unroll 1
    for (int mt = 0; mt < 16; ++mt) {
      const size_t m0 = (size_t)b * 2048 + mt * 128;
      const size_t g0 = m0 + rg * 16;
      u16 gg[16];
#pragma unroll
      for (int r = 0; r < 16; ++r) gg[r] = gn[r];
      {
        float u3 = bf2f(un[0]), u2 = bf2f(un[1]), u1 = bf2f(un[2]);
#pragma unroll
        for (int r = 0; r < 16; ++r) {
          const float u0 = bf2f(un[3 + r]);
          const float v = w0 * u3 + w1 * u2 + w2 * u1 + w3 * u0 + cb;
          UB[(rg * 16 + r) * 65 + c] = v;
          Al[(rg * 16 + r) * 72 + c] = f2bf(v);
          u3 = u2; u2 = u1; u1 = u0;
        }
      }
      if (mt + 1 < 16) LRU_LOAD(mt + 1);
      __syncthreads();
      f32x4 acc[2][4];
#pragma unroll
      for (int i = 0; i < 2; ++i)
#pragma unroll
        for (int j = 0; j < 4; ++j) acc[i][j] = (f32x4){0.f, 0.f, 0.f, 0.f};
#pragma unroll
      for (int ks = 0; ks < 2; ++ks) {
        bf16x8 af[2], bfr[4];
#pragma unroll
        for (int i = 0; i < 2; ++i) af[i] = *(const bf16x8*)(Al + (wr * 32 + i * 16 + fr) * 72 + ks * 32 + fq * 8);
#pragma unroll
        for (int j = 0; j < 4; ++j) bfr[j] = *(const bf16x8*)(Bl + (wc * 64 + j * 16 + fr) * 72 + ks * 32 + fq * 8);
#pragma unroll
        for (int i = 0; i < 2; ++i)
#pragma unroll
          for (int j = 0; j < 4; ++j) acc[i][j] = mfma16(af[i], bfr[j], acc[i][j]);
      }
#pragma unroll
      for (int jj = 0; jj < 2; ++jj) {
        const int d = wc * 32 + jj * 16 + fr;
#pragma unroll
        for (int i = 0; i < 2; ++i)
#pragma unroll
          for (int r = 0; r < 4; ++r) {
            const int row = wr * 32 + i * 16 + fq * 4 + r;
            const float rr = sigmoid_(acc[i][jj * 2][r] + ba[jj]);
            const float ig = sigmoid_(acc[i][jj * 2 + 1][r] + bx[jj]);
            const float log_a = -8.f * rr * spl[jj];
            const float av = __expf(log_a);
            AA[row * 65 + d] = av;
            UB[row * 65 + d] = __builtin_amdgcn_sqrtf(fmaxf((1.f - av) * (1.f + av), 0.f)) * (ig * UB[row * 65 + d]);
          }
      }
      __syncthreads();
      {
        float Aa = 1.f, Bb = 0.f;
#pragma unroll
        for (int r = 0; r < 16; ++r) {
          const float a = AA[(rg * 16 + r) * 65 + c], bb = UB[(rg * 16 + r) * 65 + c];
          Bb = a * Bb + bb; Aa *= a;
        }
        sA[rg * 64 + c] = Aa; sB[rg * 64 + c] = Bb;
        __syncthreads();
        float h = Hc[c];
        for (int v = 0; v < rg; ++v) h = sA[v * 64 + c] * h + sB[v * 64 + c];
#pragma unroll
        for (int r = 0; r < 16; ++r) {
          const float a = AA[(rg * 16 + r) * 65 + c], bb = UB[(rg * 16 + r) * 65 + c];
          h = a * h + bb;
          OG[(g0 + r) * 1024 + ch] = f2bf(h * silu_(bf2f(gg[r])));
        }
        __syncthreads();
        if (rg == 7) Hc[c] = h;
      }
    }
    __syncthreads();
  }
}

#undef LRU_LOAD
__device__ __forceinline__ void lru_scan_phase(const PAcc& p, char* lds) {
  const int tid = tid_(), c = tid & 63, tc = tid >> 6;
  float* sA = (float*)lds;
  float* sB = sA + 512;
  const float* LA = (const float*)(p.pp->ws + LRU_A);
  const float* LB = (const float*)(p.pp->ws + LRU_B);
  const u16* UG = (const u16*)(p.pp->ws + LRU_UG);
  u16* OG = (u16*)(p.pp->ws + WS_H);
  for (int item = blockIdx.x; item < 256; item += gridDim.x) {
    const int b = item >> 4, ch = (item & 15) * 64 + c;
    const size_t row0 = (size_t)b * 2048 + tc * 256;
    float Aa = 1.f, Bb = 0.f;
#pragma unroll 8
    for (int t = 0; t < 256; ++t) {
      const float a = LA[(row0 + t) * 1024 + ch], bb = LB[(row0 + t) * 1024 + ch];
      Bb = a * Bb + bb; Aa *= a;
    }
    sA[tc * 64 + c] = Aa; sB[tc * 64 + c] = Bb;
    __syncthreads();
    float h = 0.f;
    for (int v = 0; v < tc; ++v) h = sA[v * 64 + c] * h + sB[v * 64 + c];
#pragma unroll 8
    for (int t = 0; t < 256; ++t) {
      const float a = LA[(row0 + t) * 1024 + ch], bb = LB[(row0 + t) * 1024 + ch];
      h = a * h + bb;
      const float g = bf2f(UG[(row0 + t) * 2048 + 1024 + ch]);
      OG[(row0 + t) * 1024 + ch] = f2bf(h * silu_(g));
    }
    __syncthreads();
  }
}

__device__ __forceinline__ void rwkv_rec_phase(const PAcc& p, char* lds, bool st) {
  const int tid = tid_(), lane = tid & 63, wave = tid >> 6;
  float* Wd = (float*)lds;
  float* NKK = Wd + 1024;
  float* KKA = NKK + 1024;
  float* KM = KKA + 1024;
  float* Rr = KM + 1024;
  float* Vv = Rr + 1024;
  float* Yy = Vv + 1024;
  float* RKs = Yy + 1024;
  u16* RKVG = (u16*)(p.pp->ws + RW_RKVG);
  const float* EW = (const float*)(p.pp->ws + RW_EW);
  const u16* AB = (const u16*)(p.pp->ws + RW_A);
  const int tl = tid >> 5, jp = tid & 31;
  const int il = lane >> 3, js = lane & 7;
  for (int item = blockIdx.x; item < 256; item += gridDim.x) {
    const int b = item >> 4, h = item & 15;
    const int hc = h * 64 + 2 * jp;
    const float kk0 = p.pp->in[26][hc], kk1 = p.pp->in[26][hc + 1];
    const float ka0 = p.pp->in[27][hc], ka1 = p.pp->in[27][hc + 1];
    const float rk0 = p.pp->in[28][hc], rk1 = p.pp->in[28][hc + 1];
    const float lw0 = p.pp->in[29][hc], lw1 = p.pp->in[29][hc + 1];
    const float lb0 = p.pp->in[30][hc], lb1 = p.pp->in[30][hc + 1];
    f32x4 SA = (f32x4){0.f, 0.f, 0.f, 0.f}, SB = SA;
    const int irow = wave * 8 + il;
    unsigned r2, k2, v2, a2, g2n, g2; float2 e2;
    {
      const size_t row = (size_t)b * 2048 + tl;
      r2 = *(const unsigned*)(RKVG + row * 4096 + hc);
      k2 = *(const unsigned*)(RKVG + row * 4096 + 1024 + hc);
      v2 = *(const unsigned*)(RKVG + row * 4096 + 2048 + hc);
      g2n = *(const unsigned*)(RKVG + row * 4096 + 3072 + hc);
      a2 = *(const unsigned*)(AB + row * 1024 + hc);
      e2 = *(const float2*)(EW + row * 1024 + hc);
    }
    for (int t0 = 0; t0 < 2048; t0 += 16) {
      g2 = g2n;
      {
        const float r0 = bflo(r2), r1 = bfhi(r2), k0 = bflo(k2), k1 = bfhi(k2), v0 = bflo(v2), v1 = bfhi(v2);
        const float a0 = bflo(a2), a1 = bfhi(a2);
        float q0 = k0 * kk0, q1 = k1 * kk1;
        float ss = q0 * q0 + q1 * q1;
        ss = red32(ss);
        const float inv = rsqrtf(fmaxf(ss, 1e-24f));
        q0 *= inv; q1 *= inv;
        const float km0 = k0 * (1.f + (a0 - 1.f) * ka0), km1 = k1 * (1.f + (a1 - 1.f) * ka1);
        float bon = r0 * km0 * rk0 + r1 * km1 * rk1;
        bon = red32(bon);
        const int o = tl * 64 + 2 * jp;
        *(float2*)(Wd + o) = make_float2(__expf(-e2.x), __expf(-e2.y));
        *(float2*)(NKK + o) = make_float2(-q0, -q1);
        *(float2*)(KKA + o) = make_float2(q0 * a0, q1 * a1);
        *(float2*)(KM + o) = make_float2(km0, km1);
        *(float2*)(Rr + o) = make_float2(r0, r1);
        *(float2*)(Vv + o) = make_float2(v0, v1);
        if (jp == 0) RKs[tl] = bon;
      }
      __syncthreads();
      if (t0 + 16 < 2048) {
        const size_t row = (size_t)b * 2048 + t0 + 16 + tl;
        r2 = *(const unsigned*)(RKVG + row * 4096 + hc);
        k2 = *(const unsigned*)(RKVG + row * 4096 + 1024 + hc);
        v2 = *(const unsigned*)(RKVG + row * 4096 + 2048 + hc);
        g2n = *(const unsigned*)(RKVG + row * 4096 + 3072 + hc);
        a2 = *(const unsigned*)(AB + row * 1024 + hc);
        e2 = *(const float2*)(EW + row * 1024 + hc);
      }
#define RW_RD(W, N, C, M, R, V, t_)                                                        \
      { const int o_ = (t_) * 64 + js * 8;                                                   \
        W[0] = *(const f32x4*)(Wd + o_); W[1] = *(const f32x4*)(Wd + o_ + 4);                \
        N[0] = *(const f32x4*)(NKK + o_); N[1] = *(const f32x4*)(NKK + o_ + 4);              \
        C[0] = *(const f32x4*)(KKA + o_); C[1] = *(const f32x4*)(KKA + o_ + 4);              \
        M[0] = *(const f32x4*)(KM + o_); M[1] = *(const f32x4*)(KM + o_ + 4);                \
        R[0] = *(const f32x4*)(Rr + o_); R[1] = *(const f32x4*)(Rr + o_ + 4);                \
        V = Vv[(t_) * 64 + irow]; }
#define RW_CP(W, N, C, M, R, V, yout)                                                      \
      { f32x4 q_ = SA * N[0]; q_ = SB * N[1] + q_;          \
        float sa_ = (q_[0] + q_[1]) + (q_[2] + q_[3]);                                       \
        sa_ = red8(sa_);                                                                     \
        SA = SA * W[0] + (C[0] * sa_ + M[0] * V);                                            \
        SB = SB * W[1] + (C[1] * sa_ + M[1] * V);                                            \
        f32x4 yq_ = SA * R[0]; yq_ = SB * R[1] + yq_;                                        \
        float y_ = (yq_[0] + yq_[1]) + (yq_[2] + yq_[3]);                                    \
        yout = red8(y_); }
      {
        f32x4 aW[2], aN[2], aC[2], aM[2], aR[2], bW[2], bN[2], bC[2], bM[2], bR[2];
        float aV, bV;
        RW_RD(aW, aN, aC, aM, aR, aV, 0);
        RW_RD(bW, bN, bC, bM, bR, bV, 1);
#pragma unroll
        for (int t = 0; t < 16; t += 2) {
          float ya, yb;
          RW_CP(aW, aN, aC, aM, aR, aV, ya);
          if (t + 2 < 16) RW_RD(aW, aN, aC, aM, aR, aV, t + 2);
          RW_CP(bW, bN, bC, bM, bR, bV, yb);
          if (t + 3 < 16) RW_RD(bW, bN, bC, bM, bR, bV, t + 3);
          if (js == 0) { Yy[t * 64 + irow] = ya; Yy[(t + 1) * 64 + irow] = yb; }
        }
      }
#undef RW_RD
#undef RW_CP
      __syncthreads();
      {
        const int o = tl * 64 + 2 * jp;
        const float2 y = *(const float2*)(Yy + o);
        float sm = y.x + y.y;
        sm = red32(sm);
        const float mean = sm * (1.f / 64.f);
        const float d0 = y.x - mean, d1 = y.y - mean;
        float vs = d0 * d0 + d1 * d1;
        vs = red32(vs);
        const float rstd = rsqrtf(vs * (1.f / 64.f) + 64e-5f);
        const float2 vv = *(const float2*)(Vv + o);
        const float bon = RKs[tl];
        const size_t row = (size_t)b * 2048 + t0 + tl;
        const float o0 = (d0 * rstd * lw0 + lb0 + bon * vv.x) * silu_(bflo(g2));
        const float o1 = (d1 * rstd * lw1 + lb1 + bon * vv.y) * silu_(bfhi(g2));
        if (st) *(unsigned*)(RKVG + row * 4096 + hc) = pack2(o0, o1);
      }
      __syncthreads();
    }
  }
}

__device__ __forceinline__ f32x4 wave_mma(const u16* A, int lda, const u16* B, int ldb, int K, f32x4 acc, int fr, int fq) {
  for (int k = 0; k < K; k += 32) {
    const bf16x8 a = *(const bf16x8*)(A + fr * lda + k + fq * 8);
    const bf16x8 b = *(const bf16x8*)(B + fr * ldb + k + fq * 8);
    acc = mfma16(a, b, acc);
  }
  return acc;
}

__device__ __forceinline__ void gla_pre_phase(const PAcc& p, char* lds) {
  const int tid = tid_(), lane = tid & 63, wave = tid >> 6, fr = lane & 15, fq = lane >> 4;
  float* AL = (float*)lds;
  float* TOT = AL + 1024;
  u16* QD = (u16*)(TOT + 512);
  u16* KI = QD + 64 * 136;
  const u16* P = (const u16*)(p.pp->ws + GL_P);
  u16* QDg = (u16*)(p.pp->ws + GL_QD);
  u16* KETg = (u16*)(p.pp->ws + GL_KET);
  u16* ATTg = (u16*)((char*)p.pp->out + GL_ATT_OUT);
  u16* VTg = (u16*)(p.pp->ws + GL_VT);
  float* LASTg = (float*)((char*)p.pp->out + GL_LAST_OUT);
  const int d = tid & 127, tg = tid >> 7;
  for (int item = blockIdx.x; item < 2048; item += gridDim.x) {
    const int h = item & 3, bn = item >> 2;
    const size_t row0 = (size_t)bn * 64;
    float w2c[16];
#pragma unroll
    for (int r = 0; r < 16; ++r) w2c[r] = p.pp->in[33][r * 512 + h * 128 + d];
    const float ab = p.pp->in[34][h * 128 + d];
    for (int i = tid; i < 1024; i += NTHR) AL[i] = bf2f(P[(row0 + (i >> 4)) * 3088 + 3072 + (i & 15)]);
    {
      const int e = tid & 255, th = tid >> 8;
      u16 vv[32];
#pragma unroll
      for (int t = 0; t < 32; ++t) vv[t] = P[(row0 + th * 32 + t) * 3088 + 1024 + h * 256 + e];
      u16* dst = VTg + ((size_t)item * 256 + e) * 64 + th * 32;
#pragma unroll
      for (int q4 = 0; q4 < 4; ++q4) {
        uint4 s0;
        s0.x = vv[q4 * 8 + 0] | ((unsigned)vv[q4 * 8 + 1] << 16); s0.y = vv[q4 * 8 + 2] | ((unsigned)vv[q4 * 8 + 3] << 16);
        s0.z = vv[q4 * 8 + 4] | ((unsigned)vv[q4 * 8 + 5] << 16); s0.w = vv[q4 * 8 + 6] | ((unsigned)vv[q4 * 8 + 7] << 16);
        *(uint4*)(dst + q4 * 8) = s0;
      }
    }
    __syncthreads();
    float cum[16];
    {
      float run = 0.f;
#pragma unroll
      for (int t = 0; t < 16; ++t) {
        const float4* al = (const float4*)(AL + (tg * 16 + t) * 16);
        const float4 x0 = al[0], x1 = al[1], x2 = al[2], x3 = al[3];
        float z = ab + x0.x * w2c[0] + x0.y * w2c[1] + x0.z * w2c[2] + x0.w * w2c[3] + x1.x * w2c[4] + x1.y * w2c[5] + x1.z * w2c[6] + x1.w * w2c[7]
                + x2.x * w2c[8] + x2.y * w2c[9] + x2.z * w2c[10] + x2.w * w2c[11] + x3.x * w2c[12] + x3.y * w2c[13] + x3.z * w2c[14] + x3.w * w2c[15];
        run += -((-z > 20.f) ? -z : __logf(1.f + __expf(-z))) * (1.f / 16.f);
        cum[t] = run;
      }
      TOT[tg * 128 + d] = run;
    }
    __syncthreads();
    {
      float off = 0.f, last = 0.f;
#pragma unroll
      for (int g = 0; g < 4; ++g) { const float tv = TOT[g * 128 + d]; if (g < tg) off += tv; last += tv; }
      if (tg == 0) LASTg[(size_t)item * 128 + d] = last;
      const float elast = __expf(last);
      u16 ke[16];
#pragma unroll
      for (int t = 0; t < 16; ++t) {
        const float c = cum[t] + off;
        const int tok = tg * 16 + t;
        const float q = bf2f(P[(row0 + tok) * 3088 + h * 128 + d]);
        const float k = bf2f(P[(row0 + tok) * 3088 + 512 + h * 128 + d]);
        const float ec = __expf(c), einv = __builtin_amdgcn_rcpf(ec);
        const u16 qd = f2bf(q * 0.08838834764831845f * ec);
        QD[tok * 136 + d] = qd;
        QDg[(row0 + tok) * 512 + h * 128 + d] = qd;
        KI[tok * 136 + d] = f2bf(k * einv);
        ke[t] = f2bf(k * elast * einv);
      }
      uint4 s0, s1;
      s0.x = ke[0] | ((unsigned)ke[1] << 16); s0.y = ke[2] | ((unsigned)ke[3] << 16); s0.z = ke[4] | ((unsigned)ke[5] << 16); s0.w = ke[6] | ((unsigned)ke[7] << 16);
      s1.x = ke[8] | ((unsigned)ke[9] << 16); s1.y = ke[10] | ((unsigned)ke[11] << 16); s1.z = ke[12] | ((unsigned)ke[13] << 16); s1.w = ke[14] | ((unsigned)ke[15] << 16);
      u16* kd = KETg + ((size_t)item * 128 + d) * 64 + tg * 16;
      *(uint4*)kd = s0;
      *(uint4*)(kd + 8) = s1;
    }
    __syncthreads();
    {
      const int ti = wave >> 1;
#pragma unroll
      for (int x = 0; x < 2; ++x) {
        const int tj = (wave & 1) * 2 + x;
        f32x4 a = (f32x4){0.f, 0.f, 0.f, 0.f};
        if (tj <= ti) a = wave_mma(QD + ti * 16 * 136, 136, KI + tj * 16 * 136, 136, 128, a, fr, fq);
#pragma unroll
        for (int r = 0; r < 4; ++r) {
          const int i = ti * 16 + fq * 4 + r, j = tj * 16 + fr;
          ATTg[(size_t)item * 4096 + i * 64 + j] = f2bf((j <= i) ? a[r] : 0.f);
        }
      }
    }
    __syncthreads();
  }
}

__device__ __forceinline__ void gla_phase(const PAcc& p, char* lds) {
  const int tid = tid_(), lane = tid & 63, wave = tid >> 6, fr = lane & 15, fq = lane >> 4;
  float* LAST = (float*)lds;
  u16* QD = (u16*)(LAST + 128);
  u16* KET = QD + 64 * 136;
  u16* VT = KET + 128 * 72;
  u16* ATT = VT + 64 * 72;
  u16* ST = ATT + 64 * 72;
  const u16* QDg = (const u16*)(p.pp->ws + GL_QD);
  const u16* KETg = (const u16*)(p.pp->ws + GL_KET);
  const u16* ATTg = (const u16*)((const char*)p.pp->out + GL_ATT_OUT);
  const u16* VTg = (const u16*)(p.pp->ws + GL_VT);
  const float* LASTg = (const float*)((const char*)p.pp->out + GL_LAST_OUT);
  u16* O = (u16*)(p.pp->ws + GL_O);
  for (int item = blockIdx.x; item < 256; item += gridDim.x) {
    const int b = item >> 4, h = (item >> 2) & 3, es = item & 3;
    f32x4 sacc[4];
#pragma unroll
    for (int i = 0; i < 4; ++i) sacc[i] = (f32x4){0.f, 0.f, 0.f, 0.f};
    for (int i = tid; i < 64 * 136 / 2; i += NTHR) ((unsigned*)ST)[i] = 0u;
    uint4 rA, rQ0, rQ1, rK0, rK1, rV; float rL = 0.f;
#define GLA_LOAD(n_)                                                                                            \
    {                                                                                                           \
      const size_t it_ = ((size_t)(b * 32 + (n_))) * 4 + h;                                                     \
      rA = *(const uint4*)(ATTg + it_ * 4096 + tid * 8);                                                        \
      { const int c0_ = tid, c1_ = tid + NTHR;                                                                  \
        rQ0 = *(const uint4*)(QDg + ((size_t)(b * 32 + (n_)) * 64 + (c0_ >> 4)) * 512 + h * 128 + (c0_ & 15) * 8); \
        rQ1 = *(const uint4*)(QDg + ((size_t)(b * 32 + (n_)) * 64 + (c1_ >> 4)) * 512 + h * 128 + (c1_ & 15) * 8); \
        rK0 = *(const uint4*)(KETg + it_ * 8192 + c0_ * 8);                                                     \
        rK1 = *(const uint4*)(KETg + it_ * 8192 + c1_ * 8); }                                                   \
      rV = *(const uint4*)(VTg + (it_ * 256 + es * 64) * 64 + tid * 8);                                         \
      if (tid < 128) rL = LASTg[it_ * 128 + tid];                                                               \
    }
    GLA_LOAD(0);
    for (int n = 0; n < 32; ++n) {
      const size_t row0 = (size_t)b * 2048 + n * 64;
      *(uint4*)(ATT + (tid >> 3) * 72 + (tid & 7) * 8) = rA;
      *(uint4*)(QD + (tid >> 4) * 136 + (tid & 15) * 8) = rQ0;
      *(uint4*)(QD + ((tid + NTHR) >> 4) * 136 + (tid & 15) * 8) = rQ1;
      *(uint4*)(KET + (tid >> 3) * 72 + (tid & 7) * 8) = rK0;
      *(uint4*)(KET + ((tid + NTHR) >> 3) * 72 + (tid & 7) * 8) = rK1;
      *(uint4*)(VT + (tid >> 3) * 72 + (tid & 7) * 8) = rV;
      if (tid < 128) LAST[tid] = rL;
      __syncthreads();
      if (n + 1 < 32) GLA_LOAD(n + 1);
      {
        const int ti = wave >> 1;
#pragma unroll
        for (int x = 0; x < 2; ++x) {
          const int te = (wave & 1) * 2 + x;
          f32x4 a = (f32x4){0.f, 0.f, 0.f, 0.f};
          a = wave_mma(ATT + ti * 16 * 72, 72, VT + te * 16 * 72, 72, 64, a, fr, fq);
          a = wave_mma(QD + ti * 16 * 136, 136, ST + te * 16 * 136, 136, 128, a, fr, fq);
#pragma unroll
          for (int r = 0; r < 4; ++r)
            O[(row0 + ti * 16 + fq * 4 + r) * 1024 + h * 256 + es * 64 + te * 16 + fr] = f2bf(a[r]);
        }
        const int et = wave >> 1;
#pragma unroll
        for (int x = 0; x < 4; ++x) {
          const int dt = (wave & 1) * 4 + x;
          const float dec = __expf(LAST[dt * 16 + fr]);
          f32x4 a = sacc[x];
          a[0] *= dec; a[1] *= dec; a[2] *= dec; a[3] *= dec;
          sacc[x] = wave_mma(VT + et * 16 * 72, 72, KET + dt * 16 * 72, 72, 64, a, fr, fq);
        }
      }
      __syncthreads();
      {
        const int et = wave >> 1;
#pragma unroll
        for (int x = 0; x < 4; ++x) {
          const int dt = (wave & 1) * 4 + x;
#pragma unroll
          for (int r = 0; r < 4; ++r) ST[(et * 16 + fq * 4 + r) * 136 + dt * 16 + fr] = f2bf(sacc[x][r]);
        }
      }
      __syncthreads();
    }
  }
}
#undef GLA_LOAD
__device__ __forceinline__ void gla_norm_phase(const PAcc& p) {
  const int lane = tid_() & 63;
  const int gw = blockIdx.x * (NTHR / 64) + (tid_() >> 6);
  const int nw = gridDim.x * (NTHR / 64);
  const u16* O = (const u16*)(p.pp->ws + GL_O);
  const u16* P = (const u16*)(p.pp->ws + GL_P);
  u16* OG = (u16*)(p.pp->ws + WS_H);
  const float4 gn = *(const float4*)(p.pp->in[35] + lane * 4);
  for (int row = gw; row < T_; row += nw) {
#pragma unroll
    for (int h = 0; h < 4; ++h) {
      const uint2 ov = *(const uint2*)(O + (size_t)row * 1024 + h * 256 + lane * 4);
      float4 v; v.x = bflo(ov.x); v.y = bfhi(ov.x); v.z = bflo(ov.y); v.w = bfhi(ov.y);
      float ss = v.x * v.x + v.y * v.y + v.z * v.z + v.w * v.w;
#pragma unroll
      for (int m = 32; m >= 1; m >>= 1) ss += __shfl_xor(ss, m);
      const float rstd = rsqrtf(ss * (1.f / 256.f) + 1e-6f);
      const uint2 g = *(const uint2*)(P + (size_t)row * 3088 + 2048 + h * 256 + lane * 4);
      uint2 o;
      o.x = pack2(v.x * rstd * gn.x * silu_(bflo(g.x)), v.y * rstd * gn.y * silu_(bfhi(g.x)));
      o.y = pack2(v.z * rstd * gn.z * silu_(bflo(g.y)), v.w * rstd * gn.w * silu_(bfhi(g.y)));
      *(uint2*)(OG + (size_t)row * 1024 + h * 256 + lane * 4) = o;
    }
  }
}


#define XB_TMO      128
#define XB_XCNT(j)  (256  + 64 * (j))
#define XB_XSUB(j)  (1280 + 64 * (j))
#define XB_XGEN(j)  (2304 + 64 * (j))
#define XB_TOP      3328
#define XB_TOPGEN   3392
#define XCD_BAR_WORDS 3456
#define XB_SPIN_CAP (1u << 18)
#define XLAS __attribute__((address_space(3)))
__device__ __forceinline__ unsigned xb_ld(unsigned* p)              { return __hip_atomic_load(p, __ATOMIC_RELAXED, __HIP_MEMORY_SCOPE_AGENT); }
__device__ __forceinline__ unsigned xb_add(unsigned* p, unsigned v) { return __hip_atomic_fetch_add(p, v, __ATOMIC_RELAXED, __HIP_MEMORY_SCOPE_AGENT); }
__device__ __forceinline__ unsigned xb_xcc_id() { return (unsigned)__builtin_amdgcn_s_getreg((3 << 11) | 20) & 0xFu; }
#define XB_SPIN(cond, bar) do { unsigned _sp = 0; while (cond) { __builtin_amdgcn_s_sleep(1); \
    if ((++_sp & 255u) == 0u) { if (xb_ld(&(bar)[XB_TMO])) break; if (_sp > XB_SPIN_CAP) { atomicAdd(&(bar)[XB_TMO], 1u); break; } } } } while (0)
struct XcdBarrier { unsigned* bar; unsigned x; volatile XLAS unsigned* st; };
__device__ __forceinline__ XcdBarrier xcd_barrier_post(unsigned* bar, volatile XLAS unsigned* st) {
  XcdBarrier b; b.bar = bar; b.x = xb_xcc_id(); b.st = st;
  if (tid_() == 0) (void)xb_add(&bar[XB_XCNT(b.x)], 1u);
  return b;
}
__device__ __forceinline__ void xcd_barrier_complete(unsigned* bar, unsigned x, unsigned& nloc, unsigned& nx) {
  const unsigned G = gridDim.x * gridDim.y * gridDim.z;
  unsigned sum, cnt, mine, sp = 0u;
  for (;;) {
    sum = 0u; cnt = 0u; mine = 0u;
#pragma unroll
    for (unsigned j = 0; j < 16; ++j) { const unsigned c = xb_ld(&bar[XB_XCNT(j)]); sum += c; cnt += (c > 0u) ? 1u : 0u; mine = (j == x) ? c : mine; }
    if (sum == G) break;
    __builtin_amdgcn_s_sleep(1);
    if ((++sp & 255u) == 0u) { if (xb_ld(&bar[XB_TMO])) break; if (sp > XB_SPIN_CAP) { atomicAdd(&bar[XB_TMO], 1u); break; } }
  }
  nloc = mine > 0u ? mine : 1u; nx = cnt > 0u ? cnt : 1u;
}
__device__ __forceinline__ void xcd_barrier(const XcdBarrier& b) {
  asm volatile("s_waitcnt vmcnt(0)" ::: "memory");
  __syncthreads();
  if (tid_() == 0) {
    unsigned* bar = b.bar;
    __builtin_amdgcn_s_waitcnt(0);
    unsigned nloc = b.st[0], nx = b.st[1];
    if (nloc == 0u) { xcd_barrier_complete(bar, b.x, nloc, nx); b.st[0] = nloc; b.st[1] = nx; }
    const unsigned old = xb_add(&bar[XB_XSUB(b.x)], 1u);
    const unsigned gen = old / nloc;
    if (old + 1u == (gen + 1u) * nloc) {
      __builtin_amdgcn_fence(__ATOMIC_RELEASE, "agent");
      asm volatile("s_waitcnt vmcnt(0)" ::: "memory");
      const unsigned og = xb_add(&bar[XB_TOP], 1u);
      const unsigned tg = og / nx;
      if (og + 1u == (tg + 1u) * nx) xb_add(&bar[XB_TOPGEN], 1u);
      else XB_SPIN(xb_ld(&bar[XB_TOPGEN]) == tg, bar);
      __builtin_amdgcn_fence(__ATOMIC_ACQUIRE, "agent");
      xb_add(&bar[XB_XGEN(b.x)], 1u);
      asm volatile("s_waitcnt vmcnt(0)" ::: "memory");
    } else {
      XB_SPIN(xb_ld(&bar[XB_XGEN(b.x)]) == gen, bar);
      __builtin_amdgcn_fence(__ATOMIC_ACQUIRE, "agent");
      asm volatile("s_waitcnt vmcnt(0)" ::: "memory");
    }
  }
  __syncthreads();
}

__global__ void __launch_bounds__(NTHR) fwd_megakernel(Params pk) {
  extern __shared__ __attribute__((aligned(16))) char lds[];
  cg::grid_group grid = cg::this_grid();
  PAcc p;
  p.pp = (CParamsPtr)__builtin_amdgcn_kernarg_segment_ptr();
  asm volatile("" : "+s"(p.pp));
  unsigned* xbar = (unsigned*)(p.pp->ws + WS_XBAR);
  volatile XLAS unsigned* xst = (volatile XLAS unsigned*)(lds + 128 * 1024);
  if (tid_() < 2) xst[tid_()] = 0u;
  if (blockIdx.x == 0) for (int i = tid_(); i < XCD_BAR_WORDS; i += NTHR) xbar[i] = 0u;
  const u16* WT = (const u16*)(p.pp->ws + WS_WT);
  u16* H = (u16*)(p.pp->ws + WS_H);
  u16* H2 = (u16*)(p.pp->ws + WS_H2);
  const float* MOD = (const float*)(p.pp->ws + WS_MOD);
  const float* xcur = p.pp->in[0];

#if DUP == 11
  for (int r_ = 0; r_ < 20; ++r_) grid.sync();
#endif
#if DUP == 5
  prep_phase(p, lds);
  grid.sync();
#endif
  prep_phase(p, lds);
  grid.sync();
  const XcdBarrier xb = xcd_barrier_post(xbar, xst);

  if (LAYER_MASK & 1) {
    for (int r_ = 0; r_ < ((DUP == 10) ? 2 : 1); ++r_) norm_phase<false, true, false>(p, p.pp->in[0], 0, H, nullptr);
    xcd_barrier(xb);
    for (int r_ = 0; r_ < ((DUP == 9) ? 2 : 1); ++r_) {
      pg8::EpiDsaMain e{(u16*)(p.pp->ws + DSA_QKVG), p.pp->in[6], p.pp->in[7], (const float2*)(p.pp->ws + WS_ROPE64), (u16*)(p.pp->ws + DSA_VT)};
      pg8::run<pg8::EpiDsaMain, true>(lds, H, H, H, WT + W_DSA_MAIN, WT + W_DSA_MAIN, WT + W_DSA_MAIN, 1024, 1024, 4, 1, 2560, e);
      pg8::EpiDsaIdx e2{(u16*)(p.pp->ws + DSA_QIHI), (u16*)(p.pp->ws + DSA_QILO), (u16*)(p.pp->ws + DSA_KIHI), (u16*)(p.pp->ws + DSA_KILO), (float*)(p.pp->ws + DSA_WI),
                        (const float2*)(p.pp->ws + WS_ROPE128)};
      pg8::run<pg8::EpiDsaIdx, true>(lds, H, H, H, WT + W_DSA_IDX_HI, WT + W_DSA_IDX_HI, WT + W_DSA_IDX_HI, 1024, 1024, 4, 1, 1280, e2);
    }
    xcd_barrier(xb);
#if DUP == 1
    dsa_unit_phase(p, lds, p.pp->ws == nullptr);
    xcd_barrier(xb);
#endif
    dsa_unit_phase(p, lds, true);
    xcd_barrier(xb);
    for (int r_ = 0; r_ < ((DUP == 9) ? 2 : 1); ++r_) {
      pg8::EpiResid<false, true> e{p.pp->ws + XR1, p.pp->in[0], MOD + 0 * 16 * 3072};
      const u16* A = (const u16*)(p.pp->ws + DSA_QKVG);
      pg8::run(lds, A, A, A, WT + W_DSA_OUT, WT + W_DSA_OUT, WT + W_DSA_OUT, 2560, 1024, 4, 1, 1024, e);
    }
    xcd_barrier(xb);
    xcur = p.pp->out;
  }
  if (LAYER_MASK & 2) {
    for (int r_ = 0; r_ < ((DUP == 10) ? 2 : 1); ++r_) norm_phase<false, false, true>(p, p.pp->ws + XR1, 1, H, nullptr);
    xcd_barrier(xb);
    for (int r_ = 0; r_ < ((DUP == 9) ? 2 : 1); ++r_) {
      pg8::EpiPlain e{(u16*)(p.pp->ws + LRU_UG), 2048, 2048};
      pg8::run(lds, H, H, H, WT + W_LRU_IN, WT + W_LRU_IN, WT + W_LRU_IN, 1024, 1024, 4, 1, 2048, e);
    }
    xcd_barrier(xb);
#if DUP == 4
    lru_fused_phase(p, lds);
    xcd_barrier(xb);
#endif
    lru_fused_phase(p, lds);
    xcd_barrier(xb);
    {
      pg8::EpiResid<true, true> e{p.pp->out, p.pp->ws + XR1, MOD + 1 * 16 * 3072};
      pg8::run(lds, H, H, H, WT + W_LRU_OUT, WT + W_LRU_OUT, WT + W_LRU_OUT, 1024, 1024, 4, 1, 1024, e);
    }
    xcd_barrier(xb);
    xcur = p.pp->out;
  }
  if (LAYER_MASK & 4) {
    for (int r_ = 0; r_ < ((DUP == 10) ? 2 : 1); ++r_) norm_phase<true, false, true>(p, p.pp->out, 2, H, nullptr);
    xcd_barrier(xb);
    for (int r_ = 0; r_ < ((DUP == 9) ? 2 : 1); ++r_) {
      pg8::EpiPlain e{(u16*)(p.pp->ws + RW_RKVG), 4096, 4096};
      pg8::run(lds, H, H, H, WT + W_RWKV_IN, WT + W_RWKV_IN, WT + W_RWKV_IN, 2048, 2048, 5, 1, 4096, e);
      EpiP e2{}; e2.o16 = (u16*)(p.pp->ws + RW_L1);
      gemm_phase<EPI_RWKV_L1>(p, H, H, H, WT + W_RWKV_L1, WT + W_RWKV_L1, WT + W_RWKV_L1, 2048, 2048, 2048, 1, 0, 1, e2, lds);
    }
    xcd_barrier(xb);
    for (int r_ = 0; r_ < ((DUP == 9) ? 2 : 1); ++r_) {
      const u16* L1 = (const u16*)(p.pp->ws + RW_L1);
      EpiP e{}; e.of = (float*)(p.pp->ws + RW_EW); e.f0 = p.pp->in[20];
      gemm_phase<EPI_RWKV_W>(p, L1, L1, L1, WT + W_RWKV_W2, WT + W_RWKV_W2, WT + W_RWKV_W2, 128, 64, 64, 1, 0, 8, e, lds);
      EpiP e2{}; e2.o16 = (u16*)(p.pp->ws + RW_A); e2.f0 = p.pp->in[23];
      gemm_phase<EPI_RWKV_A>(p, L1 + 64, L1 + 64, L1 + 64, WT + W_RWKV_A2, WT + W_RWKV_A2, WT + W_RWKV_A2, 128, 64, 64, 1, 0, 8, e2, lds);
    }
    xcd_barrier(xb);
#if DUP == 2
    rwkv_rec_phase(p, lds, p.pp->ws == nullptr);
    xcd_barrier(xb);
#endif
    rwkv_rec_phase(p, lds, true);
    xcd_barrier(xb);
    {
      pg8::EpiResid<true, true> e{p.pp->ws + XR3, p.pp->out, MOD + 2 * 16 * 3072};
      const u16* A = (const u16*)(p.pp->ws + RW_RKVG);
      pg8::run(lds, A, A, A, WT + W_RWKV_OUT, WT + W_RWKV_OUT, WT + W_RWKV_OUT, 4096, 1024, 4, 1, 1024, e);
    }
    xcd_barrier(xb);
    xcur = p.pp->out;
  }
  if (LAYER_MASK & 8) {
    for (int r_ = 0; r_ < ((DUP == 10) ? 2 : 1); ++r_) norm_phase<false, false, true>(p, p.pp->ws + XR3, 3, H, nullptr);
    xcd_barrier(xb);
    for (int r_ = 0; r_ < ((DUP == 9) ? 2 : 1); ++r_) {
      pg8::EpiPlain e{(u16*)(p.pp->ws + GL_P), 3088, 3088};
      pg8::run(lds, H, H, H, WT + W_GLA_IN, WT + W_GLA_IN, WT + W_GLA_IN, 1024, 1024, 4, 1, 3328, e);
    }
    xcd_barrier(xb);
    gla_pre_phase(p, lds);
    xcd_barrier(xb);
#if DUP == 3
    gla_phase(p, lds);
    xcd_barrier(xb);
#endif
    gla_phase(p, lds);
    xcd_barrier(xb);
    for (int r_ = 0; r_ < ((DUP == 10) ? 2 : 1); ++r_) gla_norm_phase(p);
    xcd_barrier(xb);
    {
      pg8::EpiResid<true, false> e{p.pp->out, p.pp->ws + XR3, MOD + 3 * 16 * 3072};
      pg8::run(lds, H, H, H, WT + W_GLA_OUT, WT + W_GLA_OUT, WT + W_GLA_OUT, 1024, 1024, 4, 1, 1024, e);
    }
    xcur = p.pp->out;
  }
  if (xcur != p.pp->out) {
    for (size_t i = (size_t)blockIdx.x * NTHR + tid_(); i < (size_t)T_ * 1024 / 4; i += (size_t)gridDim.x * NTHR)
      ((float4*)p.pp->out)[i] = ((const float4*)p.pp->in[0])[i];
  }
}

extern "C" void kernel_launch(void* const* d_in, const int* in_sizes, int n_in, void* d_out, int out_size, void* d_ws, size_t ws_size,
                              hipStream_t stream) {
  static int grid_blocks = 0;
  if (!grid_blocks) {
    int dev = 0, cus = 0, per_cu = 0;
    hipGetDevice(&dev);
    hipDeviceGetAttribute(&cus, hipDeviceAttributeMultiprocessorCount, dev);
    hipFuncSetAttribute((const void*)fwd_megakernel, hipFuncAttributeMaxDynamicSharedMemorySize, LDS_BYTES);
    hipOccupancyMaxActiveBlocksPerMultiprocessor(&per_cu, (const void*)fwd_megakernel, NTHR, LDS_BYTES);
    if (per_cu < 1) { fprintf(stderr, "occupancy query says %d blocks/CU\n", per_cu); per_cu = 1; }
    grid_blocks = cus;
  }
  Params p{};
  for (int i = 0; i < 37; ++i) p.in[i] = (const float*)d_in[i];
  p.out = (float*)d_out;
  p.ws = (unsigned char*)d_ws;
  for (int i = 0; i < 64; ++i) p.invf128[i] = (float)pow(10000.0, -(double)i / 64.0);
  for (int i = 0; i < 32; ++i) p.invf64[i] = (float)pow(10000.0, -(double)i / 32.0);
  void* args[] = {&p};
  hipError_t e = hipLaunchCooperativeKernel((const void*)fwd_megakernel, dim3(grid_blocks), dim3(NTHR), args, LDS_BYTES, stream);
  if (e != hipSuccess) fprintf(stderr, "cooperative launch failed: %s (grid %d)\n", hipGetErrorString(e), grid_blocks);
}
```

```cpp
#include <hip/hip_runtime.h>
#include <hip/hip_cooperative_groups.h>
#include <cstdio>
#include <cmath>
namespace cg = cooperative_groups;

#ifndef DUP
#define DUP 0
#endif
#ifndef LAYER_MASK
#define LAYER_MASK 15
#endif

typedef unsigned short u16;
using bf16x8 = __attribute__((ext_vector_type(8))) short;
using f32x4 = __attribute__((ext_vector_type(4))) float;

#define NTHR 512
constexpr int T_ = 32768;
constexpr size_t MiB = 1ull << 20;
constexpr int LDS_BYTES = 128 * 1024 + 64;
constexpr size_t WS_XBAR = 896 * 1024;

constexpr size_t WS_MOD = 0;
constexpr size_t WS_ROPE128 = 1 * MiB;
constexpr size_t WS_ROPE64 = 2 * MiB;
constexpr size_t WS_WT = 4 * MiB;
constexpr size_t WS_H = 52 * MiB;
constexpr size_t WS_H2 = 116 * MiB;
constexpr size_t WS_P = 180 * MiB;

constexpr size_t W_DSA_MAIN = 0;
constexpr size_t W_DSA_IDX_HI = W_DSA_MAIN + 2560ull * 1024;
constexpr size_t W_DSA_IDX_LO = W_DSA_IDX_HI + 1280ull * 1024;
constexpr size_t W_DSA_OUT = W_DSA_IDX_LO + 1280ull * 1024;
constexpr size_t W_LRU_IN = W_DSA_OUT + 1024ull * 1024;
constexpr size_t W_LRU_GATE = W_LRU_IN + 2048ull * 1024;
constexpr size_t W_LRU_OUT = W_LRU_GATE + 16ull * 128 * 64;
constexpr size_t W_RWKV_IN = W_LRU_OUT + 1024ull * 1024;
constexpr size_t W_RWKV_L1 = W_RWKV_IN + 4096ull * 2048;
constexpr size_t W_RWKV_W2 = W_RWKV_L1 + 128ull * 2048;
constexpr size_t W_RWKV_A2 = W_RWKV_W2 + 1024ull * 64;
constexpr size_t W_RWKV_OUT = W_RWKV_A2 + 1024ull * 64;
constexpr size_t W_GLA_IN = W_RWKV_OUT + 1024ull * 1024;
constexpr size_t W_GLA_OUT = W_GLA_IN + 3328ull * 1024;
constexpr size_t W_END = W_GLA_OUT + 1024ull * 1024;
static_assert(W_END * 2 <= 48 * MiB, "weights region");

constexpr size_t DSA_QKVG = WS_P;
constexpr size_t DSA_QIHI = WS_P + 160 * MiB;
constexpr size_t DSA_QILO = WS_P + 224 * MiB;
constexpr size_t DSA_KIHI = WS_P + 288 * MiB;
constexpr size_t DSA_KILO = WS_P + 296 * MiB;
constexpr size_t DSA_WI = WS_P + 304 * MiB;
constexpr size_t DSA_VT = WS_P + 306 * MiB;
constexpr size_t DSA_SCR = WS_H;
constexpr size_t LRU_UG = WS_H2;
constexpr size_t LRU_A = WS_H2 + 128 * MiB;
constexpr size_t LRU_B = WS_H2 + 256 * MiB;
constexpr size_t RW_RKVG = WS_P;
constexpr size_t RW_L1 = WS_P + 256 * MiB;
constexpr size_t RW_EW = WS_H;
constexpr size_t RW_A = WS_P + 264 * MiB;
constexpr size_t GL_P = WS_H2;
constexpr size_t GL_O = WS_H2 + 194 * MiB;
constexpr size_t GL_QD = WS_H2 + 258 * MiB;
constexpr size_t GL_KET = WS_H2 + 290 * MiB;
constexpr size_t GL_ATT_OUT = 0;
constexpr size_t GL_LAST_OUT = 16 * MiB;
constexpr size_t XR1 = 448 * MiB;
constexpr size_t XR3 = 438 * MiB;
constexpr size_t GL_VT = WS_H;

struct Params {
  const float* in[37];
  float* out;
  unsigned char* ws;
  float invf128[64];
  float invf64[32];
};

typedef const Params __attribute__((address_space(4))) * CParamsPtr;
struct PAcc { CParamsPtr pp; };

__device__ __forceinline__ int tid_() { int t = __builtin_amdgcn_workitem_id_x(); asm volatile("" : "+v"(t)); return t; }
__device__ __forceinline__ u16 f2bf(float f) {
  unsigned u = __float_as_uint(f);
  u += 0x7fffu + ((u >> 16) & 1u);
  return (u16)(u >> 16);
}
__device__ __forceinline__ float bf2f(u16 h) { return __uint_as_float(((unsigned)h) << 16); }
__device__ __forceinline__ float bflo(unsigned w) { return __uint_as_float(w << 16); }
__device__ __forceinline__ float bfhi(unsigned w) { return __uint_as_float(w & 0xffff0000u); }
__device__ __forceinline__ unsigned pack2(float a, float b) { return (unsigned)f2bf(a) | ((unsigned)f2bf(b) << 16); }
__device__ __forceinline__ float sigmoid_(float x) { return __builtin_amdgcn_rcpf(1.f + __expf(-x)); }
__device__ __forceinline__ float silu_(float x) { return x * __builtin_amdgcn_rcpf(1.f + __expf(-x)); }
__device__ __forceinline__ float softplus_(float x) { return x > 20.f ? x : log1pf(__expf(x)); }
template <int CTRL> __device__ __forceinline__ float dpp(float x) {
  return __builtin_bit_cast(float, __builtin_amdgcn_mov_dpp(__builtin_bit_cast(int, x), CTRL, 0xf, 0xf, true));
}
__device__ __forceinline__ float red8(float x) {
  x += dpp<0xB1>(x); x += dpp<0x4E>(x); x += dpp<0x141>(x); return x;
}
typedef _Float16 f16x8_t __attribute__((ext_vector_type(8)));
typedef _Float16 f16x2_t __attribute__((ext_vector_type(2)));
__device__ __forceinline__ f32x4 mfma16h(bf16x8 a, bf16x8 b, f32x4 c) {
  return __builtin_amdgcn_mfma_f32_16x16x32_f16(__builtin_bit_cast(f16x8_t, a), __builtin_bit_cast(f16x8_t, b), c, 0, 0, 0);
}
__device__ __forceinline__ unsigned packh2(float a, float b) {
  f16x2_t v; v.x = (_Float16)a; v.y = (_Float16)b; return __builtin_bit_cast(unsigned, v);
}
__device__ __forceinline__ float hlo(unsigned w) { return (float)__builtin_bit_cast(f16x2_t, w).x; }
__device__ __forceinline__ float hhi(unsigned w) { return (float)__builtin_bit_cast(f16x2_t, w).y; }
__device__ __forceinline__ u16 f2h(float a) { return __builtin_bit_cast(u16, (_Float16)a); }
__device__ __forceinline__ float red32(float x) {
  x += dpp<0xB1>(x); x += dpp<0x4E>(x); x += dpp<0x141>(x); x += dpp<0x140>(x);
  const auto s_ = __builtin_amdgcn_permlane16_swap(__float_as_uint(x), __float_as_uint(x), false, false);
  return __uint_as_float(s_[0]) + __uint_as_float(s_[1]);
}
__device__ __forceinline__ f32x4 mfma16(bf16x8 a, bf16x8 b, f32x4 c) {
  return __builtin_amdgcn_mfma_f32_16x16x32_bf16(a, b, c, 0, 0, 0);
}
__device__ __forceinline__ void sincos_d(double x, float& c, float& s) {
  double k = rint(x * 0.63661977236758134308);
  double r = fma(-k, 1.57079632679489655800, x);
  r = fma(-k, 6.12323399573676603587e-17, r);
  int q = ((int)k) & 3;
  double r2 = r * r;
  double sp = r * (1.0 + r2 * (-1.0 / 6 + r2 * (1.0 / 120 + r2 * (-1.0 / 5040 + r2 * (1.0 / 362880 + r2 * (-1.0 / 39916800 + r2 * (1.0 / 6227020800.0)))))));
  double cp = 1.0 + r2 * (-0.5 + r2 * (1.0 / 24 + r2 * (-1.0 / 720 + r2 * (1.0 / 40320 + r2 * (-1.0 / 3628800 + r2 * (1.0 / 479001600.0 + r2 * (-1.0 / 87178291200.0)))))));
  double ss = (q == 0) ? sp : (q == 1) ? cp : (q == 2) ? -sp : -cp;
  double cc = (q == 0) ? cp : (q == 1) ? -sp : (q == 2) ? -cp : sp;
  c = (float)cc; s = (float)ss;
}

__device__ __forceinline__ int idx_perm(int p) {
  int wc = p >> 6, jn = (p >> 4) & 3, fr = p & 15;
  return wc * 32 + (jn & 1) * 16 + fr + 64 * (jn >> 1);
}
__device__ __forceinline__ void tconv_job(const float* __restrict__ src, int ld_src, int K, int nrows, int colmode, int col_off, int nvalid,
                          u16* __restrict__ dst, u16* __restrict__ dst_lo, int ldd, int dst_col0,
                          const float* __restrict__ mu, int smode, float* tl, int fmt = 0) {
  const int tid = tid_();
  const int tk = K >> 6, tn = nrows >> 6;
  for (int tile = blockIdx.x; tile < tk * tn; tile += gridDim.x) {
    const int k0 = (tile % tk) << 6, j0 = (tile / tk) << 6;
    {
      const int jn = tid & 63;
      const int j = j0 + jn;
      int col;
      if (colmode == 0) col = (j < nvalid) ? col_off + j : -1;
      else if (colmode == 2) {
        if (j < 1280) { const int P = j & 255; col = (j & ~255) + ((P >> 5) & 3) * 64 + 32 * (P >> 7) + (P & 31); }
        else col = j;
      } else {
        const int P = j & 255, bj = P >> 7, wcc = (P >> 5) & 3, r5 = P & 31;
        if (j < 1024) col = 2560 + ((j >> 8) * 2 + (wcc >> 1)) * 128 + 32 * (wcc & 1) + r5 + 64 * bj;
        else if (wcc < 2) col = 3592 + 32 * (wcc & 1) + r5 + 64 * bj;
        else if (wcc == 2 && bj == 0 && r5 < 8) col = 3584 + r5;
        else col = -1;
      }
#pragma unroll
      for (int i = 0; i < 8; ++i) {
        const int kr = i * 8 + (tid >> 6);
        float v = 0.f;
        if (col >= 0) v = src[(size_t)(k0 + kr) * ld_src + col];
        if (smode == 1) v *= (1.f - mu[k0 + kr]);
        else if (smode == 2) v *= mu[k0 + kr];
        tl[kr * 65 + jn] = v;
      }
    }
    __syncthreads();
    {
      const int kr = tid & 63;
#pragma unroll
      for (int i = 0; i < 8; ++i) {
        const int jn = i * 8 + (tid >> 6);
        float v = tl[kr * 65 + jn];
        u16 hi = fmt ? f2h(v) : f2bf(v);
        size_t o = (size_t)(j0 + jn) * ldd + dst_col0 + k0 + kr;
        dst[o] = hi;
        if (dst_lo) dst_lo[o] = f2bf(v - bf2f(hi));
      }
    }
    __syncthreads();
  }
}

__device__ __forceinline__ void prep_phase(const PAcc& p, char* lds) {
  const int tid = tid_();
  u16* WT = (u16*)(p.pp->ws + WS_WT);
  float* fl = (float*)lds;
  if (blockIdx.x < 192) {
    float* cact = fl;
    float* red = fl + 16384;
    const float* c = p.pp->in[1];
    for (int i = tid; i < 16384; i += NTHR) { int b = i >> 10, k = i & 1023; cact[k * 16 + b] = silu_(c[i]); }
    __syncthreads();
    for (int item = blockIdx.x; item < 192; item += gridDim.x) {
      const int l = item / 48, n0 = (item % 48) * 64;
      const int col = tid & 63, kq = tid >> 6;
      float acc[16];
#pragma unroll
      for (int b = 0; b < 16; ++b) acc[b] = 0.f;
      const float* w = p.pp->in[3] + (size_t)l * 1024 * 3072 + n0 + col;
#pragma unroll 16
      for (int k = kq * 128; k < kq * 128 + 128; ++k) {
        float wv = w[(size_t)k * 3072];
        const float4* cp = (const float4*)(cact + k * 16);
        float4 c0 = cp[0], c1 = cp[1], c2 = cp[2], c3 = cp[3];
        acc[0] += c0.x * wv; acc[1] += c0.y * wv; acc[2] += c0.z * wv; acc[3] += c0.w * wv;
        acc[4] += c1.x * wv; acc[5] += c1.y * wv; acc[6] += c1.z * wv; acc[7] += c1.w * wv;
        acc[8] += c2.x * wv; acc[9] += c2.y * wv; acc[10] += c2.z * wv; acc[11] += c2.w * wv;
        acc[12] += c3.x * wv; acc[13] += c3.y * wv; acc[14] += c3.z * wv; acc[15] += c3.w * wv;
      }
#pragma unroll
      for (int b = 0; b < 16; ++b) red[(kq * 16 + b) * 64 + col] = acc[b];
      __syncthreads();
      for (int o = tid; o < 1024; o += NTHR) {
        int b = o >> 6, cc = o & 63;
        float s = 0.f;
#pragma unroll
        for (int q = 0; q < 8; ++q) s += red[(q * 16 + b) * 64 + cc];
        ((float*)(p.pp->ws + WS_MOD))[((size_t)l * 16 + b) * 3072 + n0 + cc] = s + p.pp->in[4][l * 3072 + n0 + cc];
      }
      __syncthreads();
    }
  }
  __syncthreads();
  {
    const float f128 = p.pp->invf128[tid & 63], f64 = p.pp->invf64[tid & 31];
    float2* r128 = (float2*)(p.pp->ws + WS_ROPE128);
    float2* r64 = (float2*)(p.pp->ws + WS_ROPE64);
    for (int idx = blockIdx.x * NTHR + tid; idx < 2048 * 64; idx += gridDim.x * NTHR) {
      int pos = idx >> 6;
      float ang = (float)pos * f128;
      float c_, s_; sincos_d((double)ang, c_, s_);
      r128[idx] = make_float2(c_, s_);
    }
    for (int idx = blockIdx.x * NTHR + tid; idx < 2048 * 32; idx += gridDim.x * NTHR) {
      int pos = idx >> 5;
      float ang = (float)pos * f64;
      float c_, s_; sincos_d((double)ang, c_, s_);
      r64[idx] = make_float2(c_, s_);
    }
  }
  float* tl = fl;
  tconv_job(p.pp->in[5], 3720, 1024, 2560, 2, 0, 2560, WT + W_DSA_MAIN, nullptr, 1024, 0, nullptr, 0, tl, 1);
  tconv_job(p.pp->in[5], 3720, 1024, 1280, 3, 0, 0, WT + W_DSA_IDX_HI, nullptr, 1024, 0, nullptr, 0, tl, 1);
  tconv_job(p.pp->in[8], 1024, 1024, 1024, 0, 0, 1024, WT + W_DSA_OUT, nullptr, 1024, 0, nullptr, 0, tl);
  tconv_job(p.pp->in[9], 2048, 1024, 2048, 0, 0, 2048, WT + W_LRU_IN, nullptr, 1024, 0, nullptr, 0, tl);
  tconv_job(p.pp->in[17], 1024, 1024, 1024, 0, 0, 1024, WT + W_LRU_OUT, nullptr, 1024, 0, nullptr, 0, tl);
  for (int n = 0; n < 4; ++n) {
    tconv_job(p.pp->in[19] + (size_t)n * 1024 * 1024, 1024, 1024, 1024, 0, 0, 1024, WT + W_RWKV_IN + (size_t)n * 1024 * 2048, nullptr, 2048, 0, p.pp->in[18] + n * 1024, 1, tl);
    tconv_job(p.pp->in[19] + (size_t)n * 1024 * 1024, 1024, 1024, 1024, 0, 0, 1024, WT + W_RWKV_IN + (size_t)n * 1024 * 2048, nullptr, 2048, 1024, p.pp->in[18] + n * 1024, 2, tl);
  }
  tconv_job(p.pp->in[21], 64, 1024, 64, 0, 0, 64, WT + W_RWKV_L1, nullptr, 2048, 0, p.pp->in[18] + 4 * 1024, 1, tl);
  tconv_job(p.pp->in[21], 64, 1024, 64, 0, 0, 64, WT + W_RWKV_L1, nullptr, 2048, 1024, p.pp->in[18] + 4 * 1024, 2, tl);
  tconv_job(p.pp->in[24], 64, 1024, 64, 0, 0, 64, WT + W_RWKV_L1 + 64 * 2048, nullptr, 2048, 0, p.pp->in[18] + 5 * 1024, 1, tl);
  tconv_job(p.pp->in[24], 64, 1024, 64, 0, 0, 64, WT + W_RWKV_L1 + 64 * 2048, nullptr, 2048, 1024, p.pp->in[18] + 5 * 1024, 2, tl);
  tconv_job(p.pp->in[22], 1024, 64, 1024, 0, 0, 1024, WT + W_RWKV_W2, nullptr, 64, 0, nullptr, 0, tl);
  tconv_job(p.pp->in[25], 1024, 64, 1024, 0, 0, 1024, WT + W_RWKV_A2, nullptr, 64, 0, nullptr, 0, tl);
  tconv_job(p.pp->in[31], 1024, 1024, 1024, 0, 0, 1024, WT + W_RWKV_OUT, nullptr, 1024, 0, nullptr, 0, tl);
  tconv_job(p.pp->in[32], 3088, 1024, 3328, 0, 0, 3088, WT + W_GLA_IN, nullptr, 1024, 0, nullptr, 0, tl);
  tconv_job(p.pp->in[36], 1024, 1024, 1024, 0, 0, 1024, WT + W_GLA_OUT, nullptr, 1024, 0, nullptr, 0, tl);
  for (int idx = blockIdx.x * NTHR + tid; idx < 16 * 128 * 64; idx += gridDim.x * NTHR) {
    int n = idx >> 13, pp = (idx >> 6) & 127, k = idx & 63;
    int wc = pp >> 6, jn = (pp >> 4) & 3, fr = pp & 15;
    int type = jn & 1, d = wc * 32 + (jn >> 1) * 16 + fr;
    const float* src = type ? p.pp->in[14] : p.pp->in[12];
    WT[W_LRU_GATE + idx] = f2bf(src[n * 4096 + k * 64 + d]);
  }
}

template <bool SHIFT, bool F16 = false, bool IN16 = false>
__device__ __forceinline__ void norm_phase(const PAcc& p, const void* __restrict__ xin, int layer, u16* __restrict__ Hhi, u16* __restrict__ Hlo) {
  const int lane = tid_() & 63;
  const int gw = blockIdx.x * (NTHR / 64) + (tid_() >> 6);
  const int nw = gridDim.x * (NTHR / 64);
  const float* gain = p.pp->in[2] + layer * 1024;
  const float* mod = (const float*)(p.pp->ws + WS_MOD) + (size_t)layer * 16 * 3072;
  for (int row = gw; row < T_; row += nw) {
    float4 v[4];
    float ss = 0.f;
    if (IN16) {
      const uint2* xr = (const uint2*)((const u16*)xin + (size_t)row * 1024);
#pragma unroll
      for (int i = 0; i < 4; ++i) { const uint2 t = xr[i * 64 + lane]; v[i] = make_float4(bflo(t.x), bfhi(t.x), bflo(t.y), bfhi(t.y)); }
    } else {
      const float4* xr = (const float4*)((const float*)xin + (size_t)row * 1024);
#pragma unroll
      for (int i = 0; i < 4; ++i) v[i] = xr[i * 64 + lane];
    }
#pragma unroll
    for (int i = 0; i < 4; ++i) ss += v[i].x * v[i].x + v[i].y * v[i].y + v[i].z * v[i].z + v[i].w * v[i].w;
#pragma unroll
    for (int m = 32; m >= 1; m >>= 1) ss += __shfl_xor(ss, m);
    const float rstd = rsqrtf(ss * (1.f / 1024.f) + 1e-6f);
    const float* mb = mod + (size_t)(row >> 11) * 3072;
#pragma unroll
    for (int i = 0; i < 4; ++i) {
      const int c = i * 256 + lane * 4;
      float4 g = *(const float4*)(gain + c);
      float4 sh = *(const float4*)(mb + c);
      float4 sc = *(const float4*)(mb + 1024 + c);
      float y0 = v[i].x * rstd * g.x * (1.f + sc.x) + sh.x;
      float y1 = v[i].y * rstd * g.y * (1.f + sc.y) + sh.y;
      float y2 = v[i].z * rstd * g.z * (1.f + sc.z) + sh.z;
      float y3 = v[i].w * rstd * g.w * (1.f + sc.w) + sh.w;
      uint2 o;
      if (F16) { o.x = packh2(y0, y1); o.y = packh2(y2, y3); }
      else { o.x = pack2(y0, y1); o.y = pack2(y2, y3); }
      if (SHIFT) {
        *(uint2*)(Hhi + (size_t)row * 2048 + c) = o;
        if (((row + 1) & 2047) != 0) *(uint2*)(Hhi + (size_t)(row + 1) * 2048 + 1024 + c) = o;
        if ((row & 2047) == 0) *(uint2*)(Hhi + (size_t)row * 2048 + 1024 + c) = make_uint2(0u, 0u);
      } else {
        *(uint2*)(Hhi + (size_t)row * 1024 + c) = o;
      }
      if (!SHIFT && Hlo) {
        uint2 l;
        l.x = packh2(y0 - hlo(o.x), y1 - hhi(o.x));
        l.y = packh2(y2 - hlo(o.y), y3 - hhi(o.y));
        *(uint2*)(Hlo + (size_t)row * 1024 + c) = l;
      }
    }
  }
}

enum { EPI_PLAIN = 0, EPI_DSA_MAIN, EPI_DSA_IDX, EPI_RESID, EPI_RWKV_L1, EPI_RWKV_W, EPI_RWKV_A };
struct EpiP {
  u16* o16; u16* o16b; u16* o16c; u16* o16d; float* of; const float* f0; const float* f1; const float* f2; const float* f3;
  int ldc; int nvalid;
};
constexpr int LROW = 40;

template <int EPI>
__device__ __forceinline__ void gemm_epilogue(const EpiP& e, const PAcc& p, f32x4 (&acc)[4][4], int rowbase, int colbase, int nt, int wc, int fr, int fq) {
  if (EPI == EPI_PLAIN) {
#pragma unroll
    for (int i = 0; i < 4; ++i)
#pragma unroll
      for (int j = 0; j < 4; ++j) {
        const int col = colbase + j * 16 + fr;
        if (col < e.nvalid) {
#pragma unroll
          for (int r = 0; r < 4; ++r) e.o16[(size_t)(rowbase + i * 16 + fq * 4 + r) * e.ldc + col] = f2bf(acc[i][j][r]);
        }
      }
  } else if (EPI == EPI_DSA_MAIN) {
    if (nt < 10) {
      const float* gain = (nt < 8) ? e.f0 : e.f1;
      const float g0 = gain[fr], g1 = gain[16 + fr], g2 = gain[32 + fr], g3 = gain[48 + fr];
      const float2* rope = (const float2*)(p.pp->ws + WS_ROPE64);
#pragma unroll
      for (int i = 0; i < 4; ++i)
#pragma unroll
        for (int r = 0; r < 4; ++r) {
          float v0 = acc[i][0][r], v1 = acc[i][1][r], v2 = acc[i][2][r], v3 = acc[i][3][r];
          float ss = v0 * v0 + v1 * v1 + v2 * v2 + v3 * v3;
          ss += __shfl_xor(ss, 1); ss += __shfl_xor(ss, 2); ss += __shfl_xor(ss, 4); ss += __shfl_xor(ss, 8);
          const float rstd = rsqrtf(ss * (1.f / 64.f) + 1e-6f);
          v0 *= rstd * g0; v1 *= rstd * g1; v2 *= rstd * g2; v3 *= rstd * g3;
          const int row = rowbase + i * 16 + fq * 4 + r;
          const int pos = row & 2047;
          const float2 ca = rope[pos * 32 + fr], cb = rope[pos * 32 + 16 + fr];
          const float o0 = v0 * ca.x - v2 * ca.y, o2 = v2 * ca.x + v0 * ca.y;
          const float o1 = v1 * cb.x - v3 * cb.y, o3 = v3 * cb.x + v1 * cb.y;
          u16* d = e.o16 + (size_t)row * 2560 + colbase + fr;
          d[0] = f2bf(o0); d[16] = f2bf(o1); d[32] = f2bf(o2); d[48] = f2bf(o3);
        }
    } else {
#pragma unroll
      for (int i = 0; i < 4; ++i)
#pragma unroll
        for (int j = 0; j < 4; ++j)
#pragma unroll
          for (int r = 0; r < 4; ++r) e.o16[(size_t)(rowbase + i * 16 + fq * 4 + r) * 2560 + colbase + j * 16 + fr] = f2bf(acc[i][j][r]);
    }
  } else if (EPI == EPI_DSA_IDX) {
    if (nt < 9) {
      const float2* rope = (const float2*)(p.pp->ws + WS_ROPE128);
#pragma unroll
      for (int i = 0; i < 4; ++i)
#pragma unroll
        for (int r = 0; r < 4; ++r) {
          const int row = rowbase + i * 16 + fq * 4 + r;
          const int pos = row & 2047;
#pragma unroll
          for (int jj = 0; jj < 2; ++jj) {
            const int ii = wc * 32 + jj * 16 + fr;
            const float2 cs = rope[pos * 64 + ii];
            const float x1 = acc[i][jj][r], x2 = acc[i][jj + 2][r];
            const float o1 = x1 * cs.x - x2 * cs.y, o2 = x2 * cs.x + x1 * cs.y;
            const u16 h1 = f2bf(o1), h2 = f2bf(o2);
            const u16 l1 = f2bf(o1 - bf2f(h1)), l2 = f2bf(o2 - bf2f(h2));
            if (nt < 8) {
              size_t o = (size_t)row * 1024 + nt * 128 + ii;
              e.o16[o] = h1; e.o16[o + 64] = h2; e.o16b[o] = l1; e.o16b[o + 64] = l2;
            } else {
              size_t o = (size_t)row * 128 + ii;
              e.o16c[o] = h1; e.o16c[o + 64] = h2; e.o16d[o] = l1; e.o16d[o + 64] = l2;
            }
          }
        }
    } else {
      if (wc == 0 && fr < 8) {
#pragma unroll
        for (int i = 0; i < 4; ++i)
#pragma unroll
          for (int r = 0; r < 4; ++r) e.of[(size_t)(rowbase + i * 16 + fq * 4 + r) * 8 + fr] = acc[i][0][r] * 0.03125f;
      }
    }
  } else if (EPI == EPI_RESID) {
#pragma unroll
    for (int i = 0; i < 4; ++i)
#pragma unroll
      for (int j = 0; j < 4; ++j) {
        const int col = colbase + j * 16 + fr;
#pragma unroll
        for (int r = 0; r < 4; ++r) {
          const int row = rowbase + i * 16 + fq * 4 + r;
          const float gate = e.f1[(size_t)(row >> 11) * 3072 + 2048 + col];
          const size_t o = (size_t)row * 1024 + col;
          e.of[o] = e.f0[o] + gate * acc[i][j][r];
        }
      }
  } else if (EPI == EPI_RWKV_L1) {
#pragma unroll
    for (int i = 0; i < 4; ++i)
#pragma unroll
      for (int j = 0; j < 4; ++j) {
        const int col = colbase + j * 16 + fr;
#pragma unroll
        for (int r = 0; r < 4; ++r) {
          float v = acc[i][j][r];
          if (col < 64) v = 1.f - 2.f * __builtin_amdgcn_rcpf(1.f + __expf(2.f * v));
          e.o16[(size_t)(rowbase + i * 16 + fq * 4 + r) * 128 + col] = f2bf(v);
        }
      }
  } else if (EPI == EPI_RWKV_W) {
#pragma unroll
    for (int i = 0; i < 4; ++i)
#pragma unroll
      for (int j = 0; j < 4; ++j) {
        const int col = colbase + j * 16 + fr;
        const float w0 = e.f0[col];
#pragma unroll
        for (int r = 0; r < 4; ++r) {
          const float w = w0 + acc[i][j][r];
          e.of[(size_t)(rowbase + i * 16 + fq * 4 + r) * 1024 + col] = sigmoid_(w) * 0.60653065971f;
        }
      }
  } else if (EPI == EPI_RWKV_A) {
#pragma unroll
    for (int i = 0; i < 4; ++i)
#pragma unroll
      for (int j = 0; j < 4; ++j) {
        const int col = colbase + j * 16 + fr;
        const float a0 = e.f0[col];
#pragma unroll
        for (int r = 0; r < 4; ++r)
          e.o16[(size_t)(rowbase + i * 16 + fq * 4 + r) * 1024 + col] = f2bf(sigmoid_(a0 + acc[i][j][r]));
      }
  }
}

template <int EPI>
__device__ __forceinline__ void gemm_phase(const PAcc& p, const u16* A0, const u16* A1, const u16* A2, const u16* B0, const u16* B1, const u16* B2,
                           int lda, int ldb, int kseg, int nseg, int shiftmask, int ntn, const EpiP& e, char* ldsc) {
  const int tid = tid_(), lane = tid & 63, wave = tid >> 6;
  const int wr = wave >> 1, wc = wave & 1, fr = lane & 15, fq = lane >> 4;
  u16* As = (u16*)ldsc;
  u16* Bs = As + 2 * 256 * LROW;
  const int kps = kseg >> 5;
  const int nk = nseg * kps;
  const int ntiles = 128 * ntn;
  const int lrow = tid >> 2, lkc = (tid & 3) * 8;
  for (int tile = blockIdx.x; tile < ntiles; tile += gridDim.x) {
    const int mt = tile / ntn, nt = tile - mt * ntn;
    const int m0 = mt * 256, n0 = nt * 128;
    f32x4 acc[4][4];
#pragma unroll
    for (int i = 0; i < 4; ++i)
#pragma unroll
      for (int j = 0; j < 4; ++j) acc[i][j] = (f32x4){0.f, 0.f, 0.f, 0.f};
    uint4 ra0, ra1, rb;
#define GLOAD(ks_)                                                                           \
  {                                                                                          \
    const int s_ = (ks_) / kps;                                                              \
    const int kk_ = ((ks_) - s_ * kps) << 5;                                                 \
    const u16* Ap_ = s_ == 0 ? A0 : (s_ == 1 ? A1 : A2);                                     \
    const u16* Bp_ = s_ == 0 ? B0 : (s_ == 1 ? B1 : B2);                                     \
    const int sh_ = (shiftmask >> s_) & 1;                                                   \
    const int g0_ = m0 + lrow, g1_ = m0 + 128 + lrow;                                        \
    ra0 = (sh_ && (g0_ & 2047) == 0) ? make_uint4(0, 0, 0, 0) : *(const uint4*)(Ap_ + (size_t)(g0_ - sh_) * lda + kk_ + lkc); \
    ra1 = (sh_ && (g1_ & 2047) == 0) ? make_uint4(0, 0, 0, 0) : *(const uint4*)(Ap_ + (size_t)(g1_ - sh_) * lda + kk_ + lkc); \
    rb = *(const uint4*)(Bp_ + (size_t)(n0 + lrow) * ldb + kk_ + lkc);                       \
  }
#define LSTORE(buf_)                                                                         \
  {                                                                                          \
    *(uint4*)(As + ((buf_) * 256 + lrow) * LROW + lkc) = ra0;                                \
    *(uint4*)(As + ((buf_) * 256 + 128 + lrow) * LROW + lkc) = ra1;                          \
    *(uint4*)(Bs + ((buf_) * 128 + lrow) * LROW + lkc) = rb;                                 \
  }
    GLOAD(0);
    LSTORE(0);
    __syncthreads();
    for (int ks = 0; ks < nk; ++ks) {
      const int buf = ks & 1;
      if (ks + 1 < nk) GLOAD(ks + 1);
      bf16x8 af[4], bfr[4];
#pragma unroll
      for (int i = 0; i < 4; ++i) af[i] = *(const bf16x8*)(As + (buf * 256 + wr * 64 + i * 16 + fr) * LROW + fq * 8);
#pragma unroll
      for (int j = 0; j < 4; ++j) bfr[j] = *(const bf16x8*)(Bs + (buf * 128 + wc * 64 + j * 16 + fr) * LROW + fq * 8);
#pragma unroll
      for (int i = 0; i < 4; ++i)
#pragma unroll
        for (int j = 0; j < 4; ++j) acc[i][j] = mfma16(af[i], bfr[j], acc[i][j]);
      if (ks + 1 < nk) LSTORE(buf ^ 1);
      __syncthreads();
    }
#undef GLOAD
#undef LSTORE
    gemm_epilogue<EPI>(e, p, acc, m0 + wr * 64, n0 + wc * 64, nt, wc, fr, fq);
  }
}


namespace pg8 {
#define PG8_LAS __attribute__((address_space(3)))
typedef unsigned u32x4 __attribute__((ext_vector_type(4)));
constexpr int BM = 256, BK = 64, HALF = 128, HTB = HALF * BK * 2, NXCD = 8, WGM = 8;
__device__ __forceinline__ int lds_byte(int r, int c) { const int st = (r >> 4) * 2 + (c >> 5), rr = r & 15, cc = c & 31, ob = rr * 64 + cc * 2; return st * 1024 + (ob ^ (((ob >> 9) & 1) << 5)); }
__device__ __forceinline__ void stage_rc(int b, int& R, int& C) { const int st = b / 1024, sb = b % 1024, swz = sb ^ (((sb >> 9) & 1) << 5); R = (st >> 1) * 16 + swz / 64; C = (st & 1) * 32 + (swz % 64) / 2; }
__device__ __forceinline__ int perm32(int rho) { const int n = rho >> 4, i = rho & 15; return 8 * (i >> 2) + 4 * n + (i & 3); }
struct Unit { int pm, pn; };
struct GemmD { const u16 *A0, *A1, *A2, *B0, *B1, *B2; int lda, ldb, lgnts, nseg, M, N; };
struct StaticOrder {
  int nM, nN, nwg, G, c;
  __device__ void init(int M, int N, int G_, int c_) { nM = M / BM; nN = N / BM; nwg = nM * nN; G = G_; c = c_; }
  __device__ bool next(int i, Unit& u) const {
    const long L = (long)i * G + c; if (L >= nwg) return false;
    int wgid = (int)L; { const int q = nwg / NXCD, r = nwg % NXCD, xcd = wgid % NXCD, off = wgid / NXCD; wgid = (xcd < r ? xcd * (q + 1) : r * (q + 1) + (xcd - r) * q) + off; }
    const int nig = WGM * nN, gid = wgid / nig, fm = gid * WGM, gsz = (nM - fm) < WGM ? (nM - fm) : WGM;
    u.pm = fm + ((wgid % nig) % gsz); u.pn = (wgid % nig) / gsz; return true;
  }
};
__device__ __forceinline__ unsigned cvt_pk_bf16(float lo, float hi) { unsigned r; asm volatile("v_cvt_pk_bf16_f32 %0, %1, %2" : "=v"(r) : "v"(lo), "v"(hi)); return r; }

struct EpiPlain {
  static constexpr bool PERM = true;
  u16* O; int ldc; int nvalid;
  __device__ __forceinline__ void operator()(const f32x4 (&acc)[2][2][4][2], const Unit& u, int wr, int wc, int fr, int fq) const {
    asm volatile("" : "+v"(fr), "+v"(fq));
    const int row0 = u.pm * BM + wr * 64 + fr, col0 = u.pn * BM + wc * 32 + 8 * fq;
#pragma unroll
    for (int ai = 0; ai < 2; ++ai)
#pragma unroll
      for (int m = 0; m < 4; ++m) {
        u16* rowp = O + (size_t)(row0 + ai * HALF + m * 16) * ldc;
#pragma unroll
        for (int bj = 0; bj < 2; ++bj) {
          const int col = col0 + bj * HALF;
          if (col < nvalid) {
            const f32x4 v0 = acc[ai][bj][m][0], v1 = acc[ai][bj][m][1];
            u32x4 w; w.x = cvt_pk_bf16(v0[0], v0[1]); w.y = cvt_pk_bf16(v0[2], v0[3]); w.z = cvt_pk_bf16(v1[0], v1[1]); w.w = cvt_pk_bf16(v1[2], v1[3]);
            *(u32x4*)(rowp + col) = w;
          }
        }
      }
  }
};
template <bool IN16, bool OUT16>
struct EpiResid {
  static constexpr bool PERM = true;
  void* out; const void* xin; const float* mod;
  __device__ __forceinline__ void operator()(const f32x4 (&acc)[2][2][4][2], const Unit& u, int wr, int wc, int fr, int fq) const {
    asm volatile("" : "+v"(fr), "+v"(fq));
    const int row0 = u.pm * BM + wr * 64 + fr, col0 = u.pn * BM + wc * 32 + 8 * fq;
#pragma unroll
    for (int ai = 0; ai < 2; ++ai)
#pragma unroll
      for (int m = 0; m < 4; ++m) {
        const int row = row0 + ai * HALF + m * 16;
        const float* gp = mod + (size_t)(row >> 11) * 3072 + 2048;
#pragma unroll
        for (int bj = 0; bj < 2; ++bj) {
          const int col = col0 + bj * HALF;
          const size_t o = (size_t)row * 1024 + col;
          const f32x4 g0 = *(const f32x4*)(gp + col), g1 = *(const f32x4*)(gp + col + 4);
          f32x4 x0, x1;
          if (IN16) {
            const u32x4 xv = *(const u32x4*)((const u16*)xin + o);
            x0 = (f32x4){bflo(xv.x), bfhi(xv.x), bflo(xv.y), bfhi(xv.y)};
            x1 = (f32x4){bflo(xv.z), bfhi(xv.z), bflo(xv.w), bfhi(xv.w)};
          } else {
            x0 = *(const f32x4*)((const float*)xin + o); x1 = *(const f32x4*)((const float*)xin + o + 4);
          }
          const f32x4 y0 = x0 + g0 * acc[ai][bj][m][0], y1 = x1 + g1 * acc[ai][bj][m][1];
          if (OUT16) {
            u32x4 w; w.x = cvt_pk_bf16(y0[0], y0[1]); w.y = cvt_pk_bf16(y0[2], y0[3]); w.z = cvt_pk_bf16(y1[0], y1[1]); w.w = cvt_pk_bf16(y1[2], y1[3]);
            *(u32x4*)((u16*)out + o) = w;
          } else {
            *(f32x4*)((float*)out + o) = y0; *(f32x4*)((float*)out + o + 4) = y1;
          }
        }
      }
  }
};
struct EpiDsaMain {
  static constexpr bool PERM = true;
  u16* O; const float* qg; const float* kg; const float2* rope; u16* VT;
  __device__ __forceinline__ void operator()(const f32x4 (&acc)[2][2][4][2], const Unit& u, int wr, int wc, int fr, int fq) const {
    asm volatile("" : "+v"(fr), "+v"(fq));
    const int row0 = u.pm * BM + wr * 64 + fr;
    if (u.pn <= 4) {
      const float* gain = (u.pn < 4) ? qg : kg;
      const int cb = u.pn * 256 + wc * 64 + 8 * fq;
#pragma unroll
      for (int ai = 0; ai < 2; ++ai)
#pragma unroll
        for (int m = 0; m < 4; ++m) {
          const int row = row0 + ai * HALF + m * 16;
          float ss = 0.f;
#pragma unroll
          for (int n = 0; n < 2; ++n)
#pragma unroll
            for (int j = 0; j < 4; ++j) { const float x = acc[ai][0][m][n][j], y = acc[ai][1][m][n][j]; ss += x * x + y * y; }
          ss += __shfl_xor(ss, 16); ss += __shfl_xor(ss, 32);
          const float rstd = rsqrtf(ss * (1.f / 64.f) + 1e-6f);
          const float2* rp = rope + (row & 2047) * 32 + 8 * fq;
          u16* d = O + (size_t)row * 2560 + cb;
#pragma unroll
          for (int n = 0; n < 2; ++n) {
            float ol[4], oh[4];
#pragma unroll
            for (int j = 0; j < 4; ++j) {
              const int e = 4 * n + j;
              const float2 cs = rp[e];
              const float xn = acc[ai][0][m][n][j] * rstd * gain[8 * fq + e], yn = acc[ai][1][m][n][j] * rstd * gain[32 + 8 * fq + e];
              ol[j] = xn * cs.x - yn * cs.y; oh[j] = yn * cs.x + xn * cs.y;
            }
            uint2 w; w.x = cvt_pk_bf16(ol[0], ol[1]); w.y = cvt_pk_bf16(ol[2], ol[3]);
            *(uint2*)(d + 4 * n) = w;
            w.x = cvt_pk_bf16(oh[0], oh[1]); w.y = cvt_pk_bf16(oh[2], oh[3]);
            *(uint2*)(d + 32 + 4 * n) = w;
          }
        }
    } else if (u.pn == 5) {
#pragma unroll
      for (int ai = 0; ai < 2; ++ai)
#pragma unroll
        for (int m = 0; m < 4; ++m) {
          const int row = row0 + ai * HALF + m * 16;
          u16* vb = VT + (size_t)(row >> 11) * 256 * 2048 + (row & 2047);
#pragma unroll
          for (int bj = 0; bj < 2; ++bj)
#pragma unroll
            for (int n = 0; n < 2; ++n)
#pragma unroll
              for (int j = 0; j < 4; ++j) vb[(size_t)(128 * bj + 32 * wc + 8 * fq + 4 * n + j) * 2048] = f2bf(acc[ai][bj][m][n][j]);
        }
    } else {
      const int col0 = u.pn * BM + wc * 32 + 8 * fq;
#pragma unroll
      for (int ai = 0; ai < 2; ++ai)
#pragma unroll
        for (int m = 0; m < 4; ++m) {
          u16* rowp = O + (size_t)(row0 + ai * HALF + m * 16) * 2560 + col0;
#pragma unroll
          for (int bj = 0; bj < 2; ++bj) {
            const f32x4 v0 = acc[ai][bj][m][0], v1 = acc[ai][bj][m][1];
            u32x4 w; w.x = cvt_pk_bf16(v0[0], v0[1]); w.y = cvt_pk_bf16(v0[2], v0[3]); w.z = cvt_pk_bf16(v1[0], v1[1]); w.w = cvt_pk_bf16(v1[2], v1[3]);
            *(u32x4*)(rowp + bj * HALF) = w;
          }
        }
    }
  }
};
struct EpiDsaIdx {
  static constexpr bool PERM = true;
  u16 *qh, *ql, *kh, *kl; float* wi; const float2* rope;
  __device__ __forceinline__ void operator()(const f32x4 (&acc)[2][2][4][2], const Unit& u, int wr, int wc, int fr, int fq) const {
    asm volatile("" : "+v"(fr), "+v"(fq));
    const int row0 = u.pm * BM + wr * 64 + fr;
    if (u.pn < 4 || wc < 2) {
      const int dl = 32 * (wc & 1) + 8 * fq;
      u16* dh; size_t ld; int cb;
      if (u.pn < 4) { dh = qh; ld = 1024; cb = (u.pn * 2 + (wc >> 1)) * 128 + dl; }
      else { dh = kh; ld = 128; cb = dl; }
#pragma unroll
      for (int ai = 0; ai < 2; ++ai)
#pragma unroll
        for (int m = 0; m < 4; ++m) {
          const int row = row0 + ai * HALF + m * 16;
          const float2* rp = rope + (row & 2047) * 64 + dl;
          const size_t o = (size_t)row * ld + cb;
#pragma unroll
          for (int n = 0; n < 2; ++n) {
            float o1[4], o2[4];
#pragma unroll
            for (int j = 0; j < 4; ++j) {
              const float2 cs = rp[4 * n + j];
              const float x = acc[ai][0][m][n][j], y = acc[ai][1][m][n][j];
              o1[j] = x * cs.x - y * cs.y; o2[j] = y * cs.x + x * cs.y;
            }
            uint2 h1, h2;
            h1.x = packh2(o1[0], o1[1]); h1.y = packh2(o1[2], o1[3]);
            h2.x = packh2(o2[0], o2[1]); h2.y = packh2(o2[2], o2[3]);
            *(uint2*)(dh + o + 4 * n) = h1; *(uint2*)(dh + o + 64 + 4 * n) = h2;
          }
        }
    } else if (wc == 2 && fq == 0) {
#pragma unroll
      for (int ai = 0; ai < 2; ++ai)
#pragma unroll
        for (int m = 0; m < 4; ++m) {
          const int row = row0 + ai * HALF + m * 16;
          *(f32x4*)(wi + (size_t)row * 8) = acc[ai][0][m][0] * 0.03125f;
          *(f32x4*)(wi + (size_t)row * 8 + 4) = acc[ai][0][m][1] * 0.03125f;
        }
    }
  }
};

template <class Epi, bool F16>
__device__ __forceinline__ void gemm_phase(PG8_LAS unsigned char* lds, const GemmD g, const StaticOrder& S, const Epi& E) {
  const int tid = tid_(), wid = __builtin_amdgcn_readfirstlane(tid >> 6), lane = tid & 63, wr = wid >> 2, wc = wid & 3, fr = lane & 15, fq = lane >> 4;
  const int lg = g.lgnts, nts = 1 << lg, nt = nts * g.nseg;
  unsigned voffA[2], voffB[2];
#pragma unroll
  for (int i = 0; i < 2; ++i) { int R, C; stage_rc(tid * 16 + i * 8192, R, C); const int Rb = Epi::PERM ? ((R & ~31) + perm32(R & 31)) : R;
    voffA[i] = (unsigned)(R * g.lda + C) * 2u; voffB[i] = (unsigned)(Rb * g.ldb + C) * 2u; }
  const size_t kstep = (size_t)(BK * 2);
  const size_t hstepA = (size_t)HALF * g.lda * 2, hstepB = (size_t)HALF * g.ldb * 2;
  const size_t tstepA = 2 * hstepA, tstepB = 2 * hstepB;
  const unsigned ldsw = (unsigned)wid * 1024u;
  const int aoff = lds_byte(wr * 64 + fr, fq * 8), boff = lds_byte(wc * 32 + fr, fq * 8);
#define PG8_APTR(pm_, t_) ((const char*)((((t_) >> lg) == 0) ? g.A0 : ((((t_) >> lg) == 1) ? g.A1 : g.A2)) + (size_t)(pm_) * tstepA + (size_t)((t_) & (nts - 1)) * kstep)
#define PG8_BPTR(pn_, t_) ((const char*)((((t_) >> lg) == 0) ? g.B0 : ((((t_) >> lg) == 1) ? g.B1 : g.B2)) + (size_t)(pn_) * tstepB + (size_t)((t_) & (nts - 1)) * kstep)
#define PG8_SA(b, h) (((b) * 2 + (h)) * HTB)
#define PG8_SB(b, h) ((4 + (b) * 2 + (h)) * HTB)
#define PG8_STAGE(bufoff, gbase, voff) do { _Pragma("unroll") for (int _i = 0; _i < 2; ++_i) \
    __builtin_amdgcn_global_load_lds((const unsigned*)((const char*)(gbase) + (voff)[_i]), (PG8_LAS unsigned*)(lds + (bufoff) + ldsw + _i * 8192), 16, 0, 0); } while (0)
#define PG8_LDA(dst, b, h) do { _Pragma("unroll") for (int m = 0; m < 4; ++m) _Pragma("unroll") for (int k = 0; k < 2; ++k) dst[m][k] = *(const PG8_LAS bf16x8*)(lds + PG8_SA(b, h) + aoff + m * 2048 + k * 1024); } while (0)
#define PG8_LDB(dst, b, h) do { _Pragma("unroll") for (int n = 0; n < 2; ++n) _Pragma("unroll") for (int k = 0; k < 2; ++k) dst[n][k] = *(const PG8_LAS bf16x8*)(lds + PG8_SB(b, h) + boff + n * 2048 + k * 1024); } while (0)
#define PG8_MMA(ai, bj, At, Bt) do { __builtin_amdgcn_s_setprio(1); _Pragma("unroll") for (int m = 0; m < 4; ++m) _Pragma("unroll") for (int n = 0; n < 2; ++n) _Pragma("unroll") for (int k = 0; k < 2; ++k) \
    acc[ai][bj][m][n] = F16 ? mfma16h(Bt[n][k], At[m][k], acc[ai][bj][m][n]) : __builtin_amdgcn_mfma_f32_16x16x32_bf16(Bt[n][k], At[m][k], acc[ai][bj][m][n], 0, 0, 0); __builtin_amdgcn_s_setprio(0); } while (0)
#define PG8_WAIT_V(n) asm volatile("s_waitcnt vmcnt(" #n ")" ::: "memory")
#define PG8_WAIT_L(n) asm volatile("s_waitcnt lgkmcnt(" #n ")" ::: "memory")
#define PG8_BAR __builtin_amdgcn_s_barrier()
#define PG8_SCHED __builtin_amdgcn_sched_barrier(0)
  Unit cur, nxt; int ui = 0;
  if (!S.next(0, cur)) return;
  f32x4 acc[2][2][4][2];
#pragma unroll
  for (int a = 0; a < 2; ++a)
#pragma unroll
    for (int b = 0; b < 2; ++b)
#pragma unroll
      for (int m = 0; m < 4; ++m)
#pragma unroll
        for (int n = 0; n < 2; ++n) acc[a][b][m][n] = (f32x4){0.f, 0.f, 0.f, 0.f};
  bf16x8 At[4][2], B0[2][2], B1[2][2];
  {
    const char* cA = PG8_APTR(cur.pm, 0); const char* cB = PG8_BPTR(cur.pn, 0);
    PG8_STAGE(PG8_SB(0, 0), cB, voffB); PG8_STAGE(PG8_SA(0, 0), cA, voffA); PG8_STAGE(PG8_SB(0, 1), cB + hstepB, voffB); PG8_STAGE(PG8_SA(0, 1), cA + hstepA, voffA);
    if (wr == 1) PG8_BAR;
    PG8_WAIT_V(4); PG8_BAR;
    PG8_STAGE(PG8_SB(1, 0), cB + kstep, voffB); PG8_STAGE(PG8_SA(1, 0), cA + kstep, voffA); PG8_STAGE(PG8_SB(1, 1), cB + hstepB + kstep, voffB);
    PG8_WAIT_V(6); PG8_BAR;
  }
  for (;;) {
    const bool has_next = S.next(ui + 1, nxt);
    const int npm = has_next ? nxt.pm : cur.pm, npn = has_next ? nxt.pn : cur.pn;
    for (int t = 0; t < nt; t += 2) {
      const bool last = (t == nt - 2);
      const char* a1 = PG8_APTR(cur.pm, t + 1);
      const char* a2 = last ? PG8_APTR(npm, 0) : PG8_APTR(cur.pm, t + 2);
      const char* b2 = last ? PG8_BPTR(npn, 0) : PG8_BPTR(cur.pn, t + 2);
      const char* a3 = a2 + kstep; const char* b3 = b2 + kstep;
      PG8_LDB(B0, 0, 0); PG8_SCHED; PG8_LDA(At, 0, 0); PG8_STAGE(PG8_SA(1, 1), a1 + hstepA, voffA);
      PG8_WAIT_L(8); PG8_BAR; PG8_WAIT_L(0); PG8_MMA(0, 0, At, B0); PG8_BAR; PG8_SCHED;
      PG8_LDB(B1, 0, 1); PG8_STAGE(PG8_SB(0, 0), b2, voffB);
      PG8_BAR; PG8_WAIT_L(0); PG8_MMA(0, 1, At, B1); PG8_BAR;
      PG8_LDA(At, 0, 1); PG8_STAGE(PG8_SA(0, 0), a2, voffA);
      PG8_BAR; PG8_WAIT_L(0); PG8_MMA(1, 0, At, B0); PG8_BAR; PG8_SCHED;
      PG8_STAGE(PG8_SB(0, 1), b2 + hstepB, voffB);
      PG8_WAIT_V(6); PG8_BAR; PG8_MMA(1, 1, At, B1); PG8_BAR;
      PG8_LDB(B0, 1, 0); PG8_SCHED; PG8_LDA(At, 1, 0); PG8_STAGE(PG8_SA(0, 1), a2 + hstepA, voffA);
      PG8_WAIT_L(8); PG8_BAR; PG8_WAIT_L(0); PG8_MMA(0, 0, At, B0); PG8_BAR; PG8_SCHED;
      PG8_LDB(B1, 1, 1); PG8_STAGE(PG8_SB(1, 0), b3, voffB);
      PG8_BAR; PG8_WAIT_L(0); PG8_MMA(0, 1, At, B1); PG8_BAR;
      PG8_LDA(At, 1, 1); PG8_STAGE(PG8_SA(1, 0), a3, voffA);
      PG8_BAR; PG8_WAIT_L(0); PG8_MMA(1, 0, At, B0); PG8_BAR; PG8_SCHED;
      PG8_STAGE(PG8_SB(1, 1), b3 + hstepB, voffB);
      PG8_WAIT_V(6); PG8_BAR; PG8_MMA(1, 1, At, B1); PG8_BAR;
    }
    E(acc, cur, wr, wc, fr, fq);
    if (!has_next) break;
#pragma unroll
    for (int a = 0; a < 2; ++a)
#pragma unroll
      for (int b = 0; b < 2; ++b)
#pragma unroll
        for (int m = 0; m < 4; ++m)
#pragma unroll
          for (int n = 0; n < 2; ++n) acc[a][b][m][n] = (f32x4){0.f, 0.f, 0.f, 0.f};
    cur = nxt; ++ui;
  }
  PG8_WAIT_V(0);
  if (wr == 0) PG8_BAR;
  PG8_BAR;
#undef PG8_APTR
#undef PG8_BPTR
#undef PG8_SA
#undef PG8_SB
#undef PG8_STAGE
#undef PG8_LDA
#undef PG8_LDB
#undef PG8_MMA
#undef PG8_WAIT_V
#undef PG8_WAIT_L
#undef PG8_BAR
#undef PG8_SCHED
}
template <class Epi, bool F16 = false>
__device__ __forceinline__ void run(char* lds, const u16* A0, const u16* A1, const u16* A2, const u16* B0, const u16* B1, const u16* B2,
                                    int lda, int ldb, int lgnts, int nseg, int N, const Epi& E) {
  GemmD g; g.A0 = A0; g.A1 = A1; g.A2 = A2; g.B0 = B0; g.B1 = B1; g.B2 = B2; g.lda = lda; g.ldb = ldb; g.lgnts = lgnts; g.nseg = nseg; g.M = T_; g.N = N;
  StaticOrder S; S.init(T_, N, (int)gridDim.x, (int)blockIdx.x);
  gemm_phase<Epi, F16>((PG8_LAS unsigned char*)lds, g, S, E);
}
}


template <int NE>
__device__ __forceinline__ void topk_row(const float* __restrict__ srow, int qpos, int lane, unsigned* __restrict__ mrow) {
  unsigned uk[NE];
#pragma unroll
  for (int e = 0; e < NE; ++e) {
    const int key = e * 64 + lane;
    const float v = srow[key];
    unsigned uu = __float_as_uint(v);
    uu = (uu & 0x80000000u) ? ~uu : (uu | 0x80000000u);
    uk[e] = (key <= qpos) ? uu : 0u;
  }
  unsigned prefix = 0u;
  for (int bit = 31; bit >= 0; --bit) {
    const unsigned cand = prefix | (1u << bit);
    int cnt = 0;
#pragma unroll
    for (int e = 0; e < NE; ++e) cnt += __popcll(__ballot(uk[e] >= cand));
    if (cnt >= 256) { prefix = cand; if (cnt == 256) break; }
  }
  int cgt = 0;
#pragma unroll
  for (int e = 0; e < NE; ++e) cgt += __popcll(__ballot(uk[e] > prefix));
  const int need = 256 - cgt;
  int eqused = 0;
  const unsigned long long lt = (1ull << lane) - 1ull;
#pragma unroll
  for (int e = 0; e < NE; ++e) {
    const bool gt = uk[e] > prefix, eq = uk[e] == prefix;
    const unsigned long long meq = __ballot(eq);
    const bool take = gt || (eq && (eqused + __popcll(meq & lt)) < need);
    const unsigned long long ms = __ballot(take);
    if (lane == 0) { mrow[2 * e] = (unsigned)ms; mrow[2 * e + 1] = (unsigned)(ms >> 32); }
    eqused += __popcll(meq);
  }
}

__device__ __forceinline__ void dsa_unit_phase(const PAcc& p, char* lds, bool st) {
  u16* qihi = (u16*)lds;
  unsigned* MASK = (unsigned*)lds;
  const u16* VT = (const u16*)(p.pp->ws + DSA_VT);
  float* wis = (float*)(lds + 73728);
  u16* QKVG = (u16*)(p.pp->ws + DSA_QKVG);
  const u16* QIH = (const u16*)(p.pp->ws + DSA_QIHI);
  const u16* KIH = (const u16*)(p.pp->ws + DSA_KIHI);
  const float* WI = (const float*)(p.pp->ws + DSA_WI);
  float* scr = (float*)(p.pp->ws + DSA_SCR) + (size_t)blockIdx.x * 16 * 2048;

  const bool xmap = (gridDim.x == 256);
  for (int u = blockIdx.x; u < 2048; u += gridDim.x) {
    const int tid = tid_(), lane = tid & 63, wave = tid >> 6, fr = lane & 15, fq = lane >> 4;
    int qt, b;
    if (xmap) { const int v = (blockIdx.x >> 3) + 32 * (u >> 8); b = 2 * (blockIdx.x & 7) + (v & 1); qt = 127 - (v >> 1); }
    else { qt = 127 - (u >> 4); b = u & 15; }
    const int q0 = qt * 16;
    const size_t tok0 = (size_t)b * 2048 + q0;
    const bool full = (q0 < 256);
    if (!full) {
#pragma unroll
      for (int i = 0; i < 4; ++i) {
        const int c = tid + i * NTHR;
        const int row = c >> 7, ch = c & 127;
        *(uint4*)(qihi + row * 1032 + ch * 8) = *(const uint4*)(QIH + (tok0 + row) * 1024 + ch * 8);
      }
      if (tid < 128) wis[tid] = WI[tok0 * 8 + tid];
      __syncthreads();
      const int nkeys = q0 + 16;
      const int nch = (nkeys + 31) >> 5;
      for (int rep_ = 0; rep_ < ((DUP == 6) ? 2 : 1); ++rep_)
      for (int c = wave; c < nch; c += 8) {
        const int kbase = c * 32;
        bf16x8 khi[2][4];
#pragma unroll
        for (int mt = 0; mt < 2; ++mt)
#pragma unroll
          for (int ks = 0; ks < 4; ++ks) {
            const size_t o = ((size_t)b * 2048 + kbase + mt * 16 + fr) * 128 + ks * 32 + fq * 8;
            khi[mt][ks] = *(const bf16x8*)(KIH + o);
          }
        f32x4 sc[2];
        sc[0] = (f32x4){0.f, 0.f, 0.f, 0.f}; sc[1] = sc[0];
#pragma unroll 1
        for (int h = 0; h < 8; ++h) {
          const float wv = wis[fr * 8 + h];
          f32x4 lg[2];
          lg[0] = (f32x4){0.f, 0.f, 0.f, 0.f}; lg[1] = lg[0];
#pragma unroll
          for (int ks = 0; ks < 4; ++ks) {
            const bf16x8 bh = *(const bf16x8*)(qihi + fr * 1032 + h * 128 + ks * 32 + fq * 8);
#pragma unroll
            for (int mt = 0; mt < 2; ++mt) {
              lg[mt] = mfma16h(khi[mt][ks], bh, lg[mt]);
            }
          }
#pragma unroll
          for (int mt = 0; mt < 2; ++mt)
#pragma unroll
            for (int r = 0; r < 4; ++r) sc[mt][r] += wv * fmaxf(lg[mt][r], 0.f);
        }
#pragma unroll
        for (int mt = 0; mt < 2; ++mt) *(f32x4*)(scr + fr * 2048 + kbase + mt * 16 + fq * 4) = sc[mt];
      }
    }
    __syncthreads();
    u16* QF = (u16*)(lds + 81920);
#pragma unroll
    for (int i = 0; i < 4; ++i) {
      const int c = tid + i * NTHR;
      const int row = c >> 7, ch = c & 127;
      *(uint4*)(QF + row * 1032 + ch * 8) = *(const uint4*)(QKVG + (tok0 + row) * 2560 + ch * 8);
    }
#pragma unroll 1
    for (int qi2 = 0; qi2 < ((DUP == 7) ? 4 : 2); ++qi2) {
      const int qq = wave * 2 + (qi2 & 1);
      const int qpos = q0 + qq;
      if (!full) {
        const int ng = ((q0 + 15) >> 8) + 1;
        const float* sr = scr + qq * 2048; unsigned* mr = MASK + qq * 64;
        switch (ng) {
          case 2: topk_row<8>(sr, qpos, lane, mr); break;
          case 3: topk_row<12>(sr, qpos, lane, mr); break;
          case 4: topk_row<16>(sr, qpos, lane, mr); break;
          case 5: topk_row<20>(sr, qpos, lane, mr); break;
          case 6: topk_row<24>(sr, qpos, lane, mr); break;
          case 7: topk_row<28>(sr, qpos, lane, mr); break;
          default: topk_row<32>(sr, qpos, lane, mr); break;
        }
      } else {
#pragma unroll
        for (int e = 0; e < 32; ++e) {
          const unsigned long long ms = __ballot((e * 64 + lane) <= qpos);
          if (lane == 0) { MASK[qq * 64 + 2 * e] = (unsigned)ms; MASK[qq * 64 + 2 * e + 1] = (unsigned)(ms >> 32); }
        }
      }
    }
    __syncthreads();
    {
      int fr_a = fr, fq_a = fq, lane_a = lane;
      asm volatile("" : "+v"(fr_a), "+v"(fq_a), "+v"(lane_a));
#define fr fr_a
#define fq fq_a
#define lane lane_a
      const int g = wave >> 1, half = wave & 1;
      float mq = fabsf(p.pp->in[6][lane]), mk = fabsf(p.pp->in[7][lane]);
#pragma unroll
      for (int mm = 32; mm >= 1; mm >>= 1) { mq = fmaxf(mq, __shfl_xor(mq, mm)); mk = fmaxf(mk, __shfl_xor(mk, mm)); }
      const float shift = 8.f * mq * mk; const float nshift2 = -shift * 1.44269504089f;
      const u16* qfp = QF + fr * 1032 + g * 256 + fq * 8;
      f32x4 o[4][4];
#pragma unroll
      for (int rr = 0; rr < 4; ++rr)
#pragma unroll
        for (int mt = 0; mt < 4; ++mt) o[rr][mt] = (f32x4){0.f, 0.f, 0.f, 0.f};
      float lsum[4] = {0.f, 0.f, 0.f, 0.f};
      const u16* Kb = QKVG + (size_t)b * 2048 * 2560 + 1024 + g * 64 + fq * 8 + (size_t)(8 * (fr >> 2) + (fr & 3)) * 2560;
      const u16* Vb = VT + (size_t)(b * 256 + g * 64 + fr) * 2048 + 8 * fq;
      const int nb = (q0 + 16 + 31) >> 5;
      bf16x8 kf[2][2], vf[4];
      {
        const int k0 = (half < nb ? half : 0) * 32;
#pragma unroll
        for (int s2 = 0; s2 < 2; ++s2)
#pragma unroll
          for (int ks = 0; ks < 2; ++ks) kf[s2][ks] = *(const bf16x8*)(Kb + (size_t)(k0 + 4 * s2) * 2560 + ks * 32);
#pragma unroll
        for (int mt = 0; mt < 4; ++mt) vf[mt] = *(const bf16x8*)(Vb + (size_t)mt * 16 * 2048 + k0);
      }
#pragma unroll 1
      for (int blk = half; blk < nb; blk += 2) {
        bf16x8 kn[2][2], vn[4];
        const int nx = (blk + 2 < nb) ? (blk + 2) * 32 : blk * 32;
#pragma unroll
        for (int s2 = 0; s2 < 2; ++s2)
#pragma unroll
          for (int ks = 0; ks < 2; ++ks) kn[s2][ks] = *(const bf16x8*)(Kb + (size_t)(nx + 4 * s2) * 2560 + ks * 32);
#pragma unroll
        for (int mt = 0; mt < 4; ++mt) vn[mt] = *(const bf16x8*)(Vb + (size_t)mt * 16 * 2048 + nx);
        const unsigned mw = MASK[fr * 64 + blk] >> (8 * fq);
        f32x4 mf[2];
#pragma unroll
        for (int s2 = 0; s2 < 2; ++s2)
#pragma unroll
          for (int r = 0; r < 4; ++r) mf[s2][r] = (float)((mw >> (4 * s2 + r)) & 1u);
#pragma unroll
        for (int rr = 0; rr < 4; ++rr) {
          float pv[8];
          f32x4 pq[2];
#pragma unroll
          for (int s2 = 0; s2 < 2; ++s2) {
            f32x4 stv = (f32x4){0.f, 0.f, 0.f, 0.f};
            stv = mfma16(kf[s2][0], *(const bf16x8*)(qfp + rr * 64), stv);
            stv = mfma16(kf[s2][1], *(const bf16x8*)(qfp + rr * 64 + 32), stv);
            stv = stv * (0.125f * 1.44269504089f) + nshift2;
#pragma unroll
            for (int r = 0; r < 4; ++r) stv[r] = __builtin_amdgcn_exp2f(stv[r]);
            pq[s2] = stv * mf[s2];
          }
          {
            const f32x4 sm_ = pq[0] + pq[1];
            lsum[rr] += (sm_[0] + sm_[1]) + (sm_[2] + sm_[3]);
          }
#pragma unroll
          for (int r = 0; r < 4; ++r) { pv[r] = pq[0][r]; pv[4 + r] = pq[1][r]; }
          union { bf16x8 v; unsigned w[4]; } pk;
          pk.w[0] = pg8::cvt_pk_bf16(pv[0], pv[1]); pk.w[1] = pg8::cvt_pk_bf16(pv[2], pv[3]);
          pk.w[2] = pg8::cvt_pk_bf16(pv[4], pv[5]); pk.w[3] = pg8::cvt_pk_bf16(pv[6], pv[7]);
#pragma unroll
          for (int mt = 0; mt < 4; ++mt) o[rr][mt] = mfma16(vf[mt], pk.v, o[rr][mt]);
        }
#pragma unroll
        for (int s2 = 0; s2 < 2; ++s2)
#pragma unroll
          for (int ks = 0; ks < 2; ++ks) kf[s2][ks] = kn[s2][ks];
#pragma unroll
        for (int mt = 0; mt < 4; ++mt) vf[mt] = vn[mt];
      }
      float* CB = (float*)(lds + 8192) + (size_t)g * 68 * 64 + lane;
      if (half == 1) {
#pragma unroll
        for (int rr = 0; rr < 4; ++rr) {
#pragma unroll
          for (int mt = 0; mt < 4; ++mt)
#pragma unroll
            for (int r = 0; r < 4; ++r) CB[((rr * 4 + mt) * 4 + r) * 64] = o[rr][mt][r];
          CB[(64 + rr) * 64] = lsum[rr];
        }
      }
      __syncthreads();
      if (half == 0) {
#pragma unroll
        for (int rr = 0; rr < 4; ++rr) {
          float l = lsum[rr] + CB[(64 + rr) * 64];
          l += __shfl_xor(l, 16); l += __shfl_xor(l, 32);
          const float inv = 1.f / l;
          const int h = g * 4 + rr;
#pragma unroll
          for (int mt = 0; mt < 4; ++mt) {
            u16* op = QKVG + (tok0 + fr) * 2560 + h * 64 + mt * 16 + fq * 4;
            const uint2 gg = *(const uint2*)(op + 1536);
            const float v0 = o[rr][mt][0] + CB[((rr * 4 + mt) * 4 + 0) * 64], v1 = o[rr][mt][1] + CB[((rr * 4 + mt) * 4 + 1) * 64];
            const float v2 = o[rr][mt][2] + CB[((rr * 4 + mt) * 4 + 2) * 64], v3 = o[rr][mt][3] + CB[((rr * 4 + mt) * 4 + 3) * 64];
            uint2 w;
            w.x = pg8::cvt_pk_bf16(v0 * inv * silu_(bflo(gg.x)), v1 * inv * silu_(bfhi(gg.x)));
            w.y = pg8::cvt_pk_bf16(v2 * inv * silu_(bflo(gg.y)), v3 * inv * silu_(bfhi(gg.y)));
            if (st) *(uint2*)op = w;
          }
        }
      }
#undef fr
#undef fq
#undef lane
    }
    __syncthreads();
  }
}

__device__ __forceinline__ void lru_gate_phase(const PAcc& p, char* lds) {
  const int tid = tid_(), lane = tid & 63, wave = tid >> 6;
  const int wr = wave >> 1, wc = wave & 1, fr = lane & 15, fq = lane >> 4;
  float* UC = (float*)lds;
  u16* Al = (u16*)(lds + 256 * 65 * 4);
  u16* Bl = Al + 256 * 72;
  const u16* UG = (const u16*)(p.pp->ws + LRU_UG);
  const u16* WG = (const u16*)(p.pp->ws + WS_WT) + W_LRU_GATE;
  float* LA = (float*)(p.pp->ws + LRU_A);
  float* LB = (float*)(p.pp->ws + LRU_B);
  for (int unit = blockIdx.x; unit < 2048; unit += gridDim.x) {
    const int n = unit & 15, mt = unit >> 4;
    const int m0 = mt * 256;
    {
      const int c = tid & 63, rg = tid >> 6;
      const int ch = n * 64 + c;
      const float w0 = p.pp->in[10][ch], w1 = p.pp->in[10][1024 + ch], w2 = p.pp->in[10][2048 + ch], w3 = p.pp->in[10][3072 + ch];
      const float cb = p.pp->in[11][ch];
      const int r0 = rg * 32;
      const int g0 = m0 + r0;
      float u3 = ((g0 & 2047) >= 3) ? bf2f(UG[(size_t)(g0 - 3) * 2048 + ch]) : 0.f;
      float u2 = ((g0 & 2047) >= 2) ? bf2f(UG[(size_t)(g0 - 2) * 2048 + ch]) : 0.f;
      float u1 = ((g0 & 2047) >= 1) ? bf2f(UG[(size_t)(g0 - 1) * 2048 + ch]) : 0.f;
#pragma unroll 8
      for (int r = 0; r < 32; ++r) {
        const float u0 = bf2f(UG[(size_t)(g0 + r) * 2048 + ch]);
        const float v = w0 * u3 + w1 * u2 + w2 * u1 + w3 * u0 + cb;
        UC[(r0 + r) * 65 + c] = v;
        Al[(r0 + r) * 72 + c] = f2bf(v);
        u3 = u2; u2 = u1; u1 = u0;
      }
#pragma unroll
      for (int i = 0; i < 2; ++i) {
        const int cidx = tid + i * NTHR;
        const int row = cidx >> 3, kc = (cidx & 7) * 8;
        *(uint4*)(Bl + row * 72 + kc) = *(const uint4*)(WG + (size_t)n * 8192 + row * 64 + kc);
      }
    }
    __syncthreads();
    f32x4 acc[4][4];
#pragma unroll
    for (int i = 0; i < 4; ++i)
#pragma unroll
      for (int j = 0; j < 4; ++j) acc[i][j] = (f32x4){0.f, 0.f, 0.f, 0.f};
#pragma unroll
    for (int ks = 0; ks < 2; ++ks) {
      bf16x8 af[4], bfr[4];
#pragma unroll
      for (int i = 0; i < 4; ++i) af[i] = *(const bf16x8*)(Al + (wr * 64 + i * 16 + fr) * 72 + ks * 32 + fq * 8);
#pragma unroll
      for (int j = 0; j < 4; ++j) bfr[j] = *(const bf16x8*)(Bl + (wc * 64 + j * 16 + fr) * 72 + ks * 32 + fq * 8);
#pragma unroll
      for (int i = 0; i < 4; ++i)
#pragma unroll
        for (int j = 0; j < 4; ++j) acc[i][j] = mfma16(af[i], bfr[j], acc[i][j]);
    }
#pragma unroll
    for (int jj = 0; jj < 2; ++jj) {
      const int d = wc * 32 + jj * 16 + fr;
      const int ch = n * 64 + d;
      const float ba = p.pp->in[13][ch], bx = p.pp->in[15][ch];
      const float spl = softplus_(-p.pp->in[16][ch]);
#pragma unroll
      for (int i = 0; i < 4; ++i)
#pragma unroll
        for (int r = 0; r < 4; ++r) {
          const int row = wr * 64 + i * 16 + fq * 4 + r;
          const float rr = sigmoid_(acc[i][jj * 2][r] + ba);
          const float ig = sigmoid_(acc[i][jj * 2 + 1][r] + bx);
          const float log_a = -8.f * rr * spl;
          const float a = __expf(log_a);
          const float bb = sqrtf(fmaxf(-expm1f(2.f * log_a), 0.f)) * (ig * UC[row * 65 + d]);
          const size_t o = (size_t)(m0 + row) * 1024 + ch;
          LA[o] = a; LB[o] = bb;
        }
    }
    __syncthreads();
  }
}


__device__ __forceinline__ void lru_fused_phase(const PAcc& p, char* lds) {
  const int tid = tid_(), lane = tid & 63, wave = tid >> 6;
  const int wr = wave >> 1, wc = wave & 1, fr = lane & 15, fq = lane >> 4;
  float* UB = (float*)lds;
  float* AA = UB + 128 * 65;
  u16* Al = (u16*)(AA + 128 * 65);
  u16* Bl = Al + 128 * 72;
  float* sA = (float*)(Bl + 128 * 72);
  float* sB = sA + 512;
  float* Hc = sB + 512;
  const u16* UG = (const u16*)(p.pp->ws + LRU_UG);
  const u16* WG = (const u16*)(p.pp->ws + WS_WT) + W_LRU_GATE;
  u16* OG = (u16*)(p.pp->ws + WS_H);
  const int c = tid & 63, rg = tid >> 6;
  for (int unit = blockIdx.x; unit < 256; unit += gridDim.x) {
    const int b = unit >> 4, n = unit & 15;
    const int ch = n * 64 + c;
    const float w0 = p.pp->in[10][ch], w1 = p.pp->in[10][1024 + ch], w2 = p.pp->in[10][2048 + ch], w3 = p.pp->in[10][3072 + ch];
    const float cb = p.pp->in[11][ch];
#pragma unroll
    for (int i = 0; i < 2; ++i) {
      const int cidx = tid + i * NTHR;
      const int row = cidx >> 3, kc = (cidx & 7) * 8;
      *(uint4*)(Bl + row * 72 + kc) = *(const uint4*)(WG + (size_t)n * 8192 + row * 64 + kc);
    }
    if (tid < 64) Hc[tid] = 0.f;
    float ba[2], bx[2], spl[2];
#pragma unroll
    for (int jj = 0; jj < 2; ++jj) {
      const int dch = n * 64 + wc * 32 + jj * 16 + fr;
      ba[jj] = p.pp->in[13][dch]; bx[jj] = p.pp->in[15][dch]; spl[jj] = softplus_(-p.pp->in[16][dch]);
    }
    u16 un[19], gn[16];
#define LRU_LOAD(mt_)                                                                      \
    { const size_t g0_ = (size_t)b * 2048 + (mt_) * 128 + rg * 16;                         \
      const int pos0_ = (mt_) * 128 + rg * 16;                                             \
      _Pragma("unroll") for (int r = 0; r < 3; ++r) un[r] = (pos0_ >= 3 - r) ? UG[(g0_ - 3 + r) * 2048 + ch] : (u16)0; \
      _Pragma("unroll") for (int r = 0; r < 16; ++r) { un[3 + r] = UG[(g0_ + r) * 2048 + ch]; gn[r] = UG[(g0_ + r) * 2048 + 1024 + ch]; } }
    LRU_LOAD(0);
#pragma unroll 1
    for (int mt = 0; mt < 16; ++mt) {
      const size_t m0 = (size_t)b * 2048 + mt * 128;
      const size_t g0 = m0 + rg * 16;
      u16 gg[16];
#pragma unroll
      for (int r = 0; r < 16; ++r) gg[r] = gn[r];
      {
        float u3 = bf2f(un[0]), u2 = bf2f(un[1]), u1 = bf2f(un[2]);
#pragma unroll
        for (int r = 0; r < 16; ++r) {
          const float u0 = bf2f(un[3 + r]);
          const float v = w0 * u3 + w1 * u2 + w2 * u1 + w3 * u0 + cb;
          UB[(rg * 16 + r) * 65 + c] = v;
          Al[(rg * 16 + r) * 72 + c] = f2bf(v);
          u3 = u2; u2 = u1; u1 = u0;
        }
      }
      if (mt + 1 < 16) LRU_LOAD(mt + 1);
      __syncthreads();
      f32x4 acc[2][4];
#pragma unroll
      for (int i = 0; i < 2; ++i)
#pragma unroll
        for (int j = 0; j < 4; ++j) acc[i][j] = (f32x4){0.f, 0.f, 0.f, 0.f};
#pragma unroll
      for (int ks = 0; ks < 2; ++ks) {
        bf16x8 af[2], bfr[4];
#pragma unroll
        for (int i = 0; i < 2; ++i) af[i] = *(const bf16x8*)(Al + (wr * 32 + i * 16 + fr) * 72 + ks * 32 + fq * 8);
#pragma unroll
        for (int j = 0; j < 4; ++j) bfr[j] = *(const bf16x8*)(Bl + (wc * 64 + j * 16 + fr) * 72 + ks * 32 + fq * 8);
#pragma unroll
        for (int i = 0; i < 2; ++i)
#pragma unroll
          for (int j = 0; j < 4; ++j) acc[i][j] = mfma16(af[i], bfr[j], acc[i][j]);
      }
#pragma unroll
      for (int jj = 0; jj < 2; ++jj) {
        const int d = wc * 32 + jj * 16 + fr;
#pragma unroll
        for (int i = 0; i < 2; ++i)
#pragma unroll
          for (int r = 0; r < 4; ++r) {
            const int row = wr * 32 + i * 16 + fq * 4 + r;
            const float rr = sigmoid_(acc[i][jj * 2][r] + ba[jj]);
            const float ig = sigmoid_(acc[i][jj * 2 + 1][r] + bx[jj]);
            const float log_a = -8.f * rr * spl[jj];
            const float av = __expf(log_a);
            AA[row * 65 + d] = av;
            UB[row * 65 + d] = __builtin_amdgcn_sqrtf(fmaxf((1.f - av) * (1.f + av), 0.f)) * (ig * UB[row * 65 + d]);
          }
      }
      __syncthreads();
      {
        float Aa = 1.f, Bb = 0.f;
#pragma unroll
        for (int r = 0; r < 16; ++r) {
          const float a = AA[(rg * 16 + r) * 65 + c], bb = UB[(rg * 16 + r) * 65 + c];
          Bb = a * Bb + bb; Aa *= a;
        }
        sA[rg * 64 + c] = Aa; sB[rg * 64 + c] = Bb;
        __syncthreads();
        float h = Hc[c];
        for (int v = 0; v < rg; ++v) h = sA[v * 64 + c] * h + sB[v * 64 + c];
#pragma unroll
        for (int r = 0; r < 16; ++r) {
          const float a = AA[(rg * 16 + r) * 65 + c], bb = UB[(rg * 16 + r) * 65 + c];
          h = a * h + bb;
          OG[(g0 + r) * 1024 + ch] = f2bf(h * silu_(bf2f(gg[r])));
        }
        __syncthreads();
        if (rg == 7) Hc[c] = h;
      }
    }
    __syncthreads();
  }
}

#undef LRU_LOAD
__device__ __forceinline__ void lru_scan_phase(const PAcc& p, char* lds) {
  const int tid = tid_(), c = tid & 63, tc = tid >> 6;
  float* sA = (float*)lds;
  float* sB = sA + 512;
  const float* LA = (const float*)(p.pp->ws + LRU_A);
  const float* LB = (const float*)(p.pp->ws + LRU_B);
  const u16* UG = (const u16*)(p.pp->ws + LRU_UG);
  u16* OG = (u16*)(p.pp->ws + WS_H);
  for (int item = blockIdx.x; item < 256; item += gridDim.x) {
    const int b = item >> 4, ch = (item & 15) * 64 + c;
    const size_t row0 = (size_t)b * 2048 + tc * 256;
    float Aa = 1.f, Bb = 0.f;
#pragma unroll 8
    for (int t = 0; t < 256; ++t) {
      const float a = LA[(row0 + t) * 1024 + ch], bb = LB[(row0 + t) * 1024 + ch];
      Bb = a * Bb + bb; Aa *= a;
    }
    sA[tc * 64 + c] = Aa; sB[tc * 64 + c] = Bb;
    __syncthreads();
    float h = 0.f;
    for (int v = 0; v < tc; ++v) h = sA[v * 64 + c] * h + sB[v * 64 + c];
#pragma unroll 8
    for (int t = 0; t < 256; ++t) {
      const float a = LA[(row0 + t) * 1024 + ch], bb = LB[(row0 + t) * 1024 + ch];
      h = a * h + bb;
      const float g = bf2f(UG[(row0 + t) * 2048 + 1024 + ch]);
      OG[(row0 + t) * 1024 + ch] = f2bf(h * silu_(g));
    }
    __syncthreads();
  }
}

__device__ __forceinline__ void rwkv_rec_phase(const PAcc& p, char* lds, bool st) {
  const int tid = tid_(), lane = tid & 63, wave = tid >> 6;
  float* Wd = (float*)lds;
  float* NKK = Wd + 1024;
  float* KKA = NKK + 1024;
  float* KM = KKA + 1024;
  float* Rr = KM + 1024;
  float* Vv = Rr + 1024;
  float* RKs = Vv + 1024;
  float* Yy = RKs + 64;
  u16* RKVG = (u16*)(p.pp->ws + RW_RKVG);
  const float* EW = (const float*)(p.pp->ws + RW_EW);
  const u16* AB = (const u16*)(p.pp->ws + RW_A);
  const int tl = tid >> 5, jp = tid & 31;
  const int il = lane >> 3, js = lane & 7;
  for (int item = blockIdx.x; item < 256; item += gridDim.x) {
    const int b = item >> 4, h = item & 15;
    const int hc = h * 64 + 2 * jp;
    const float kk0 = p.pp->in[26][hc], kk1 = p.pp->in[26][hc + 1];
    const float ka0 = p.pp->in[27][hc], ka1 = p.pp->in[27][hc + 1];
    const float rk0 = p.pp->in[28][hc], rk1 = p.pp->in[28][hc + 1];
    const float lw0 = p.pp->in[29][hc], lw1 = p.pp->in[29][hc + 1];
    const float lb0 = p.pp->in[30][hc], lb1 = p.pp->in[30][hc + 1];
    f32x4 SA = (f32x4){0.f, 0.f, 0.f, 0.f}, SB = SA;
    const int irow = wave * 8 + il;
    unsigned r2, k2, v2, a2, g2n, g2; float2 e2;
    {
      const size_t row = (size_t)b * 2048 + tl;
      r2 = *(const unsigned*)(RKVG + row * 4096 + hc);
      k2 = *(const unsigned*)(RKVG + row * 4096 + 1024 + hc);
      v2 = *(const unsigned*)(RKVG + row * 4096 + 2048 + hc);
      g2n = *(const unsigned*)(RKVG + row * 4096 + 3072 + hc);
      a2 = *(const unsigned*)(AB + row * 1024 + hc);
      e2 = *(const float2*)(EW + row * 1024 + hc);
    }
    for (int t0 = 0; t0 < 2048; t0 += 16) {
      g2 = g2n;
      {
        const float r0 = bflo(r2), r1 = bfhi(r2), k0 = bflo(k2), k1 = bfhi(k2), v0 = bflo(v2), v1 = bfhi(v2);
        const float a0 = bflo(a2), a1 = bfhi(a2);
        float q0 = k0 * kk0, q1 = k1 * kk1;
        float ss = q0 * q0 + q1 * q1;
        ss = red32(ss);
        const float inv = rsqrtf(fmaxf(ss, 1e-24f));
        q0 *= inv; q1 *= inv;
        const float km0 = k0 * (1.f + (a0 - 1.f) * ka0), km1 = k1 * (1.f + (a1 - 1.f) * ka1);
        float bon = r0 * km0 * rk0 + r1 * km1 * rk1;
        bon = red32(bon);
        const int o = tl * 64 + 2 * jp;
        *(float2*)(Wd + o) = make_float2(__expf(-e2.x), __expf(-e2.y));
        *(float2*)(NKK + o) = make_float2(-q0, -q1);
        *(float2*)(KKA + o) = make_float2(q0 * a0, q1 * a1);
        *(float2*)(KM + o) = make_float2(km0, km1);
        *(float2*)(Rr + o) = make_float2(r0, r1);
        *(float2*)(Vv + o) = make_float2(v0, v1);
        if (jp == 0) RKs[tl] = bon;
      }
      __syncthreads();
      if (t0 + 16 < 2048) {
        const size_t row = (size_t)b * 2048 + t0 + 16 + tl;
        r2 = *(const unsigned*)(RKVG + row * 4096 + hc);
        k2 = *(const unsigned*)(RKVG + row * 4096 + 1024 + hc);
        v2 = *(const unsigned*)(RKVG + row * 4096 + 2048 + hc);
        g2n = *(const unsigned*)(RKVG + row * 4096 + 3072 + hc);
        a2 = *(const unsigned*)(AB + row * 1024 + hc);
        e2 = *(const float2*)(EW + row * 1024 + hc);
      }
#define RW_RD(W, N, C, M, R, V, t_)                                                        \
      { const int o_ = (t_) * 64 + js * 8;                                                   \
        W[0] = *(const f32x4*)(Wd + o_); W[1] = *(const f32x4*)(Wd + o_ + 4);                \
        N[0] = *(const f32x4*)(NKK + o_); N[1] = *(const f32x4*)(NKK + o_ + 4);              \
        C[0] = *(const f32x4*)(KKA + o_); C[1] = *(const f32x4*)(KKA + o_ + 4);              \
        M[0] = *(const f32x4*)(KM + o_); M[1] = *(const f32x4*)(KM + o_ + 4);                \
        R[0] = *(const f32x4*)(Rr + o_); R[1] = *(const f32x4*)(Rr + o_ + 4);                \
        V = Vv[(t_) * 64 + irow]; }
#define RW_CP(W, N, C, M, R, V, yout)                                                      \
      { f32x4 q_ = SA * N[0]; q_ = SB * N[1] + q_;          \
        float sa_ = (q_[0] + q_[1]) + (q_[2] + q_[3]);                                       \
        sa_ = red8(sa_);                                                                     \
        SA = SA * W[0] + (C[0] * sa_ + M[0] * V);                                            \
        SB = SB * W[1] + (C[1] * sa_ + M[1] * V);                                            \
        f32x4 yq_ = SA * R[0]; yq_ = SB * R[1] + yq_;                                        \
        float y_ = (yq_[0] + yq_[1]) + (yq_[2] + yq_[3]);                                    \
        yout = y_; }
      {
        f32x4 aW[2], aN[2], aC[2], aM[2], aR[2], bW[2], bN[2], bC[2], bM[2], bR[2];
        float aV, bV;
        RW_RD(aW, aN, aC, aM, aR, aV, 0);
        RW_RD(bW, bN, bC, bM, bR, bV, 1);
#pragma unroll
        for (int t = 0; t < 16; t += 2) {
          float ya, yb;
          RW_CP(aW, aN, aC, aM, aR, aV, ya);
          if (t + 2 < 16) RW_RD(aW, aN, aC, aM, aR, aV, t + 2);
          RW_CP(bW, bN, bC, bM, bR, bV, yb);
          if (t + 3 < 16) RW_RD(bW, bN, bC, bM, bR, bV, t + 3);
          Yy[(t * 64 + irow) * 8 + js] = ya; Yy[((t + 1) * 64 + irow) * 8 + js] = yb;
        }
      }
#undef RW_RD
#undef RW_CP
      __syncthreads();
      {
        const int o = tl * 64 + 2 * jp;
        float2 y;
        {
          const f32x4* yp = (const f32x4*)(Yy + (size_t)o * 8);
          const f32x4 a0 = yp[0] + yp[1], a1 = yp[2] + yp[3];
          y.x = (a0[0] + a0[1]) + (a0[2] + a0[3]); y.y = (a1[0] + a1[1]) + (a1[2] + a1[3]);
        }
        float sm = y.x + y.y;
        sm = red32(sm);
        const float mean = sm * (1.f / 64.f);
        const float d0 = y.x - mean, d1 = y.y - mean;
        float vs = d0 * d0 + d1 * d1;
        vs = red32(vs);
        const float rstd = rsqrtf(vs * (1.f / 64.f) + 64e-5f);
        const float2 vv = *(const float2*)(Vv + o);
        const float bon = RKs[tl];
        const size_t row = (size_t)b * 2048 + t0 + tl;
        const float o0 = (d0 * rstd * lw0 + lb0 + bon * vv.x) * silu_(bflo(g2));
        const float o1 = (d1 * rstd * lw1 + lb1 + bon * vv.y) * silu_(bfhi(g2));
        if (st) *(unsigned*)(RKVG + row * 4096 + hc) = pack2(o0, o1);
      }
      __syncthreads();
    }
  }
}

__device__ __forceinline__ f32x4 wave_mma(const u16* A, int lda, const u16* B, int ldb, int K, f32x4 acc, int fr, int fq) {
  for (int k = 0; k < K; k += 32) {
    const bf16x8 a = *(const bf16x8*)(A + fr * lda + k + fq * 8);
    const bf16x8 b = *(const bf16x8*)(B + fr * ldb + k + fq * 8);
    acc = mfma16(a, b, acc);
  }
  return acc;
}

__device__ __forceinline__ void gla_pre_phase(const PAcc& p, char* lds) {
  const int tid = tid_(), lane = tid & 63, wave = tid >> 6, fr = lane & 15, fq = lane >> 4;
  float* AL = (float*)lds;
  float* TOT = AL + 1024;
  u16* QD = (u16*)(TOT + 512);
  u16* KI = QD + 64 * 136;
  const u16* P = (const u16*)(p.pp->ws + GL_P);
  u16* QDg = (u16*)(p.pp->ws + GL_QD);
  u16* KETg = (u16*)(p.pp->ws + GL_KET);
  u16* ATTg = (u16*)((char*)p.pp->out + GL_ATT_OUT);
  u16* VTg = (u16*)(p.pp->ws + GL_VT);
  float* LASTg = (float*)((char*)p.pp->out + GL_LAST_OUT);
  const int d = tid & 127, tg = tid >> 7;
  for (int item = blockIdx.x; item < 2048; item += gridDim.x) {
    const int h = item & 3, bn = item >> 2;
    const size_t row0 = (size_t)bn * 64;
    float w2c[16];
#pragma unroll
    for (int r = 0; r < 16; ++r) w2c[r] = p.pp->in[33][r * 512 + h * 128 + d];
    const float ab = p.pp->in[34][h * 128 + d];
    for (int i = tid; i < 1024; i += NTHR) AL[i] = bf2f(P[(row0 + (i >> 4)) * 3088 + 3072 + (i & 15)]);
    {
      const int e = tid & 255, th = tid >> 8;
      u16 vv[32];
#pragma unroll
      for (int t = 0; t < 32; ++t) vv[t] = P[(row0 + th * 32 + t) * 3088 + 1024 + h * 256 + e];
      u16* dst = VTg + ((size_t)item * 256 + e) * 64 + th * 32;
#pragma unroll
      for (int q4 = 0; q4 < 4; ++q4) {
        uint4 s0;
        s0.x = vv[q4 * 8 + 0] | ((unsigned)vv[q4 * 8 + 1] << 16); s0.y = vv[q4 * 8 + 2] | ((unsigned)vv[q4 * 8 + 3] << 16);
        s0.z = vv[q4 * 8 + 4] | ((unsigned)vv[q4 * 8 + 5] << 16); s0.w = vv[q4 * 8 + 6] | ((unsigned)vv[q4 * 8 + 7] << 16);
        *(uint4*)(dst + q4 * 8) = s0;
      }
    }
    __syncthreads();
    float cum[16];
    {
      float run = 0.f;
#pragma unroll
      for (int t = 0; t < 16; ++t) {
        const float4* al = (const float4*)(AL + (tg * 16 + t) * 16);
        const float4 x0 = al[0], x1 = al[1], x2 = al[2], x3 = al[3];
        float z = ab + x0.x * w2c[0] + x0.y * w2c[1] + x0.z * w2c[2] + x0.w * w2c[3] + x1.x * w2c[4] + x1.y * w2c[5] + x1.z * w2c[6] + x1.w * w2c[7]
                + x2.x * w2c[8] + x2.y * w2c[9] + x2.z * w2c[10] + x2.w * w2c[11] + x3.x * w2c[12] + x3.y * w2c[13] + x3.z * w2c[14] + x3.w * w2c[15];
        run += -((-z > 20.f) ? -z : __logf(1.f + __expf(-z))) * (1.f / 16.f);
        cum[t] = run;
      }
      TOT[tg * 128 + d] = run;
    }
    __syncthreads();
    {
      float off = 0.f, last = 0.f;
#pragma unroll
      for (int g = 0; g < 4; ++g) { const float tv = TOT[g * 128 + d]; if (g < tg) off += tv; last += tv; }
      if (tg == 0) LASTg[(size_t)item * 128 + d] = last;
      const float elast = __expf(last);
      u16 ke[16];
#pragma unroll
      for (int t = 0; t < 16; ++t) {
        const float c = cum[t] + off;
        const int tok = tg * 16 + t;
        const float q = bf2f(P[(row0 + tok) * 3088 + h * 128 + d]);
        const float k = bf2f(P[(row0 + tok) * 3088 + 512 + h * 128 + d]);
        const float ec = __expf(c), einv = __builtin_amdgcn_rcpf(ec);
        const u16 qd = f2bf(q * 0.08838834764831845f * ec);
        QD[tok * 136 + d] = qd;
        QDg[(row0 + tok) * 512 + h * 128 + d] = qd;
        KI[tok * 136 + d] = f2bf(k * einv);
        ke[t] = f2bf(k * elast * einv);
      }
      uint4 s0, s1;
      s0.x = ke[0] | ((unsigned)ke[1] << 16); s0.y = ke[2] | ((unsigned)ke[3] << 16); s0.z = ke[4] | ((unsigned)ke[5] << 16); s0.w = ke[6] | ((unsigned)ke[7] << 16);
      s1.x = ke[8] | ((unsigned)ke[9] << 16); s1.y = ke[10] | ((unsigned)ke[11] << 16); s1.z = ke[12] | ((unsigned)ke[13] << 16); s1.w = ke[14] | ((unsigned)ke[15] << 16);
      u16* kd = KETg + ((size_t)item * 128 + d) * 64 + tg * 16;
      *(uint4*)kd = s0;
      *(uint4*)(kd + 8) = s1;
    }
    __syncthreads();
    {
      const int ti = wave >> 1;
#pragma unroll
      for (int x = 0; x < 2; ++x) {
        const int tj = (wave & 1) * 2 + x;
        f32x4 a = (f32x4){0.f, 0.f, 0.f, 0.f};
        if (tj <= ti) a = wave_mma(QD + ti * 16 * 136, 136, KI + tj * 16 * 136, 136, 128, a, fr, fq);
#pragma unroll
        for (int r = 0; r < 4; ++r) {
          const int i = ti * 16 + fq * 4 + r, j = tj * 16 + fr;
          ATTg[(size_t)item * 4096 + i * 64 + j] = f2bf((j <= i) ? a[r] : 0.f);
        }
      }
    }
    __syncthreads();
  }
}

__device__ __forceinline__ void gla_phase(const PAcc& p, char* lds) {
  const int tid = tid_(), lane = tid & 63, wave = tid >> 6, fr = lane & 15, fq = lane >> 4;
  float* LAST = (float*)lds;
  u16* QD = (u16*)(LAST + 128);
  u16* KET = QD + 64 * 136;
  u16* VT = KET + 128 * 72;
  u16* ATT = VT + 64 * 72;
  u16* ST = ATT + 64 * 72;
  const u16* QDg = (const u16*)(p.pp->ws + GL_QD);
  const u16* KETg = (const u16*)(p.pp->ws + GL_KET);
  const u16* ATTg = (const u16*)((const char*)p.pp->out + GL_ATT_OUT);
  const u16* VTg = (const u16*)(p.pp->ws + GL_VT);
  const float* LASTg = (const float*)((const char*)p.pp->out + GL_LAST_OUT);
  u16* O = (u16*)(p.pp->ws + GL_O);
  for (int item = blockIdx.x; item < 256; item += gridDim.x) {
    const int b = item >> 4, h = (item >> 2) & 3, es = item & 3;
    f32x4 sacc[4];
#pragma unroll
    for (int i = 0; i < 4; ++i) sacc[i] = (f32x4){0.f, 0.f, 0.f, 0.f};
    for (int i = tid; i < 64 * 136 / 2; i += NTHR) ((unsigned*)ST)[i] = 0u;
    uint4 rA, rQ0, rQ1, rK0, rK1, rV; float rL = 0.f;
#define GLA_LOAD(n_)                                                                                            \
    {                                                                                                           \
      const size_t it_ = ((size_t)(b * 32 + (n_))) * 4 + h;                                                     \
      rA = *(const uint4*)(ATTg + it_ * 4096 + tid * 8);                                                        \
      { const int c0_ = tid, c1_ = tid + NTHR;                                                                  \
        rQ0 = *(const uint4*)(QDg + ((size_t)(b * 32 + (n_)) * 64 + (c0_ >> 4)) * 512 + h * 128 + (c0_ & 15) * 8); \
        rQ1 = *(const uint4*)(QDg + ((size_t)(b * 32 + (n_)) * 64 + (c1_ >> 4)) * 512 + h * 128 + (c1_ & 15) * 8); \
        rK0 = *(const uint4*)(KETg + it_ * 8192 + c0_ * 8);                                                     \
        rK1 = *(const uint4*)(KETg + it_ * 8192 + c1_ * 8); }                                                   \
      rV = *(const uint4*)(VTg + (it_ * 256 + es * 64) * 64 + tid * 8);                                         \
      if (tid < 128) rL = LASTg[it_ * 128 + tid];                                                               \
    }
    GLA_LOAD(0);
    for (int n = 0; n < 32; ++n) {
      const size_t row0 = (size_t)b * 2048 + n * 64;
      *(uint4*)(ATT + (tid >> 3) * 72 + (tid & 7) * 8) = rA;
      *(uint4*)(QD + (tid >> 4) * 136 + (tid & 15) * 8) = rQ0;
      *(uint4*)(QD + ((tid + NTHR) >> 4) * 136 + (tid & 15) * 8) = rQ1;
      *(uint4*)(KET + (tid >> 3) * 72 + (tid & 7) * 8) = rK0;
      *(uint4*)(KET + ((tid + NTHR) >> 3) * 72 + (tid & 7) * 8) = rK1;
      *(uint4*)(VT + (tid >> 3) * 72 + (tid & 7) * 8) = rV;
      if (tid < 128) LAST[tid] = rL;
      __syncthreads();
      if (n + 1 < 32) GLA_LOAD(n + 1);
      {
        const int ti = wave >> 1;
#pragma unroll
        for (int x = 0; x < 2; ++x) {
          const int te = (wave & 1) * 2 + x;
          f32x4 a = (f32x4){0.f, 0.f, 0.f, 0.f};
          a = wave_mma(ATT + ti * 16 * 72, 72, VT + te * 16 * 72, 72, 64, a, fr, fq);
          a = wave_mma(QD + ti * 16 * 136, 136, ST + te * 16 * 136, 136, 128, a, fr, fq);
#pragma unroll
          for (int r = 0; r < 4; ++r)
            O[(row0 + ti * 16 + fq * 4 + r) * 1024 + h * 256 + es * 64 + te * 16 + fr] = f2bf(a[r]);
        }
        const int et = wave >> 1;
#pragma unroll
        for (int x = 0; x < 4; ++x) {
          const int dt = (wave & 1) * 4 + x;
          const float dec = __expf(LAST[dt * 16 + fr]);
          f32x4 a = sacc[x];
          a[0] *= dec; a[1] *= dec; a[2] *= dec; a[3] *= dec;
          sacc[x] = wave_mma(VT + et * 16 * 72, 72, KET + dt * 16 * 72, 72, 64, a, fr, fq);
        }
      }
      __syncthreads();
      {
        const int et = wave >> 1;
#pragma unroll
        for (int x = 0; x < 4; ++x) {
          const int dt = (wave & 1) * 4 + x;
#pragma unroll
          for (int r = 0; r < 4; ++r) ST[(et * 16 + fq * 4 + r) * 136 + dt * 16 + fr] = f2bf(sacc[x][r]);
        }
      }
      __syncthreads();
    }
  }
}
#undef GLA_LOAD
__device__ __forceinline__ void gla_norm_phase(const PAcc& p) {
  const int lane = tid_() & 63;
  const int gw = blockIdx.x * (NTHR / 64) + (tid_() >> 6);
  const int nw = gridDim.x * (NTHR / 64);
  const u16* O = (const u16*)(p.pp->ws + GL_O);
  const u16* P = (const u16*)(p.pp->ws + GL_P);
  u16* OG = (u16*)(p.pp->ws + WS_H);
  const float4 gn = *(const float4*)(p.pp->in[35] + lane * 4);
  for (int row = gw; row < T_; row += nw) {
#pragma unroll
    for (int h = 0; h < 4; ++h) {
      const uint2 ov = *(const uint2*)(O + (size_t)row * 1024 + h * 256 + lane * 4);
      float4 v; v.x = bflo(ov.x); v.y = bfhi(ov.x); v.z = bflo(ov.y); v.w = bfhi(ov.y);
      float ss = v.x * v.x + v.y * v.y + v.z * v.z + v.w * v.w;
#pragma unroll
      for (int m = 32; m >= 1; m >>= 1) ss += __shfl_xor(ss, m);
      const float rstd = rsqrtf(ss * (1.f / 256.f) + 1e-6f);
      const uint2 g = *(const uint2*)(P + (size_t)row * 3088 + 2048 + h * 256 + lane * 4);
      uint2 o;
      o.x = pack2(v.x * rstd * gn.x * silu_(bflo(g.x)), v.y * rstd * gn.y * silu_(bfhi(g.x)));
      o.y = pack2(v.z * rstd * gn.z * silu_(bflo(g.y)), v.w * rstd * gn.w * silu_(bfhi(g.y)));
      *(uint2*)(OG + (size_t)row * 1024 + h * 256 + lane * 4) = o;
    }
  }
}


#define XB_TMO      128
#define XB_XCNT(j)  (256  + 64 * (j))
#define XB_XSUB(j)  (1280 + 64 * (j))
#define XB_XGEN(j)  (2304 + 64 * (j))
#define XB_TOP      3328
#define XB_TOPGEN   3392
#define XCD_BAR_WORDS 3456
#define XB_SPIN_CAP (1u << 18)
#define XLAS __attribute__((address_space(3)))
__device__ __forceinline__ unsigned xb_ld(unsigned* p)              { return __hip_atomic_load(p, __ATOMIC_RELAXED, __HIP_MEMORY_SCOPE_AGENT); }
__device__ __forceinline__ unsigned xb_add(unsigned* p, unsigned v) { return __hip_atomic_fetch_add(p, v, __ATOMIC_RELAXED, __HIP_MEMORY_SCOPE_AGENT); }
__device__ __forceinline__ unsigned xb_xcc_id() { return (unsigned)__builtin_amdgcn_s_getreg((3 << 11) | 20) & 0xFu; }
#define XB_SPIN(cond, bar) do { unsigned _sp = 0; while (cond) { __builtin_amdgcn_s_sleep(1); \
    if ((++_sp & 255u) == 0u) { if (xb_ld(&(bar)[XB_TMO])) break; if (_sp > XB_SPIN_CAP) { atomicAdd(&(bar)[XB_TMO], 1u); break; } } } } while (0)
struct XcdBarrier { unsigned* bar; unsigned x; volatile XLAS unsigned* st; };
__device__ __forceinline__ XcdBarrier xcd_barrier_post(unsigned* bar, volatile XLAS unsigned* st) {
  XcdBarrier b; b.bar = bar; b.x = xb_xcc_id(); b.st = st;
  if (tid_() == 0) (void)xb_add(&bar[XB_XCNT(b.x)], 1u);
  return b;
}
__device__ __forceinline__ void xcd_barrier_complete(unsigned* bar, unsigned x, unsigned& nloc, unsigned& nx) {
  const unsigned G = gridDim.x * gridDim.y * gridDim.z;
  unsigned sum, cnt, mine, sp = 0u;
  for (;;) {
    sum = 0u; cnt = 0u; mine = 0u;
#pragma unroll
    for (unsigned j = 0; j < 16; ++j) { const unsigned c = xb_ld(&bar[XB_XCNT(j)]); sum += c; cnt += (c > 0u) ? 1u : 0u; mine = (j == x) ? c : mine; }
    if (sum == G) break;
    __builtin_amdgcn_s_sleep(1);
    if ((++sp & 255u) == 0u) { if (xb_ld(&bar[XB_TMO])) break; if (sp > XB_SPIN_CAP) { atomicAdd(&bar[XB_TMO], 1u); break; } }
  }
  nloc = mine > 0u ? mine : 1u; nx = cnt > 0u ? cnt : 1u;
}
__device__ __forceinline__ void xcd_barrier(const XcdBarrier& b) {
  asm volatile("s_waitcnt vmcnt(0)" ::: "memory");
  __syncthreads();
  if (tid_() == 0) {
    unsigned* bar = b.bar;
    __builtin_amdgcn_s_waitcnt(0);
    unsigned nloc = b.st[0], nx = b.st[1];
    if (nloc == 0u) { xcd_barrier_complete(bar, b.x, nloc, nx); b.st[0] = nloc; b.st[1] = nx; }
    const unsigned old = xb_add(&bar[XB_XSUB(b.x)], 1u);
    const unsigned gen = old / nloc;
    if (old + 1u == (gen + 1u) * nloc) {
      __builtin_amdgcn_fence(__ATOMIC_RELEASE, "agent");
      asm volatile("s_waitcnt vmcnt(0)" ::: "memory");
      const unsigned og = xb_add(&bar[XB_TOP], 1u);
      const unsigned tg = og / nx;
      if (og + 1u == (tg + 1u) * nx) xb_add(&bar[XB_TOPGEN], 1u);
      else XB_SPIN(xb_ld(&bar[XB_TOPGEN]) == tg, bar);
      __builtin_amdgcn_fence(__ATOMIC_ACQUIRE, "agent");
      xb_add(&bar[XB_XGEN(b.x)], 1u);
      asm volatile("s_waitcnt vmcnt(0)" ::: "memory");
    } else {
      XB_SPIN(xb_ld(&bar[XB_XGEN(b.x)]) == gen, bar);
      __builtin_amdgcn_fence(__ATOMIC_ACQUIRE, "agent");
      asm volatile("s_waitcnt vmcnt(0)" ::: "memory");
    }
  }
  __syncthreads();
}

__global__ void __launch_bounds__(NTHR) fwd_megakernel(Params pk) {
  extern __shared__ __attribute__((aligned(16))) char lds[];
  cg::grid_group grid = cg::this_grid();
  PAcc p;
  p.pp = (CParamsPtr)__builtin_amdgcn_kernarg_segment_ptr();
  asm volatile("" : "+s"(p.pp));
  unsigned* xbar = (unsigned*)(p.pp->ws + WS_XBAR);
  volatile XLAS unsigned* xst = (volatile XLAS unsigned*)(lds + 128 * 1024);
  if (tid_() < 2) xst[tid_()] = 0u;
  if (blockIdx.x == 0) for (int i = tid_(); i < XCD_BAR_WORDS; i += NTHR) xbar[i] = 0u;
  const u16* WT = (const u16*)(p.pp->ws + WS_WT);
  u16* H = (u16*)(p.pp->ws + WS_H);
  u16* H2 = (u16*)(p.pp->ws + WS_H2);
  const float* MOD = (const float*)(p.pp->ws + WS_MOD);
  const float* xcur = p.pp->in[0];

#if DUP == 11
  for (int r_ = 0; r_ < 20; ++r_) grid.sync();
#endif
#if DUP == 5
  prep_phase(p, lds);
  grid.sync();
#endif
  prep_phase(p, lds);
  grid.sync();
  const XcdBarrier xb = xcd_barrier_post(xbar, xst);

  if (LAYER_MASK & 1) {
    for (int r_ = 0; r_ < ((DUP == 10) ? 2 : 1); ++r_) norm_phase<false, true, false>(p, p.pp->in[0], 0, H, nullptr);
    xcd_barrier(xb);
    for (int r_ = 0; r_ < ((DUP == 9) ? 2 : 1); ++r_) {
      pg8::EpiDsaMain e{(u16*)(p.pp->ws + DSA_QKVG), p.pp->in[6], p.pp->in[7], (const float2*)(p.pp->ws + WS_ROPE64), (u16*)(p.pp->ws + DSA_VT)};
      pg8::run<pg8::EpiDsaMain, true>(lds, H, H, H, WT + W_DSA_MAIN, WT + W_DSA_MAIN, WT + W_DSA_MAIN, 1024, 1024, 4, 1, 2560, e);
      pg8::EpiDsaIdx e2{(u16*)(p.pp->ws + DSA_QIHI), (u16*)(p.pp->ws + DSA_QILO), (u16*)(p.pp->ws + DSA_KIHI), (u16*)(p.pp->ws + DSA_KILO), (float*)(p.pp->ws + DSA_WI),
                        (const float2*)(p.pp->ws + WS_ROPE128)};
      pg8::run<pg8::EpiDsaIdx, true>(lds, H, H, H, WT + W_DSA_IDX_HI, WT + W_DSA_IDX_HI, WT + W_DSA_IDX_HI, 1024, 1024, 4, 1, 1280, e2);
    }
    xcd_barrier(xb);
#if DUP == 1
    dsa_unit_phase(p, lds, p.pp->ws == nullptr);
    xcd_barrier(xb);
#endif
    dsa_unit_phase(p, lds, true);
    xcd_barrier(xb);
    for (int r_ = 0; r_ < ((DUP == 9) ? 2 : 1); ++r_) {
      pg8::EpiResid<false, true> e{p.pp->ws + XR1, p.pp->in[0], MOD + 0 * 16 * 3072};
      const u16* A = (const u16*)(p.pp->ws + DSA_QKVG);
      pg8::run(lds, A, A, A, WT + W_DSA_OUT, WT + W_DSA_OUT, WT + W_DSA_OUT, 2560, 1024, 4, 1, 1024, e);
    }
    xcd_barrier(xb);
    xcur = p.pp->out;
  }
  if (LAYER_MASK & 2) {
    for (int r_ = 0; r_ < ((DUP == 10) ? 2 : 1); ++r_) norm_phase<false, false, true>(p, p.pp->ws + XR1, 1, H, nullptr);
    xcd_barrier(xb);
    for (int r_ = 0; r_ < ((DUP == 9) ? 2 : 1); ++r_) {
      pg8::EpiPlain e{(u16*)(p.pp->ws + LRU_UG), 2048, 2048};
      pg8::run(lds, H, H, H, WT + W_LRU_IN, WT + W_LRU_IN, WT + W_LRU_IN, 1024, 1024, 4, 1, 2048, e);
    }
    xcd_barrier(xb);
#if DUP == 4
    lru_fused_phase(p, lds);
    xcd_barrier(xb);
#endif
    lru_fused_phase(p, lds);
    xcd_barrier(xb);
    {
      pg8::EpiResid<true, true> e{p.pp->out, p.pp->ws + XR1, MOD + 1 * 16 * 3072};
      pg8::run(lds, H, H, H, WT + W_LRU_OUT, WT + W_LRU_OUT, WT + W_LRU_OUT, 1024, 1024, 4, 1, 1024, e);
    }
    xcd_barrier(xb);
    xcur = p.pp->out;
  }
  if (LAYER_MASK & 4) {
    for (int r_ = 0; r_ < ((DUP == 10) ? 2 : 1); ++r_) norm_phase<true, false, true>(p, p.pp->out, 2, H, nullptr);
    xcd_barrier(xb);
    for (int r_ = 0; r_ < ((DUP == 9) ? 2 : 1); ++r_) {
      pg8::EpiPlain e{(u16*)(p.pp->ws + RW_RKVG), 4096, 4096};
      pg8::run(lds, H, H, H, WT + W_RWKV_IN, WT + W_RWKV_IN, WT + W_RWKV_IN, 2048, 2048, 5, 1, 4096, e);
      EpiP e2{}; e2.o16 = (u16*)(p.pp->ws + RW_L1);
      gemm_phase<EPI_RWKV_L1>(p, H, H, H, WT + W_RWKV_L1, WT + W_RWKV_L1, WT + W_RWKV_L1, 2048, 2048, 2048, 1, 0, 1, e2, lds);
    }
    xcd_barrier(xb);
    for (int r_ = 0; r_ < ((DUP == 9) ? 2 : 1); ++r_) {
      const u16* L1 = (const u16*)(p.pp->ws + RW_L1);
      EpiP e{}; e.of = (float*)(p.pp->ws + RW_EW); e.f0 = p.pp->in[20];
      gemm_phase<EPI_RWKV_W>(p, L1, L1, L1, WT + W_RWKV_W2, WT + W_RWKV_W2, WT + W_RWKV_W2, 128, 64, 64, 1, 0, 8, e, lds);
      EpiP e2{}; e2.o16 = (u16*)(p.pp->ws + RW_A); e2.f0 = p.pp->in[23];
      gemm_phase<EPI_RWKV_A>(p, L1 + 64, L1 + 64, L1 + 64, WT + W_RWKV_A2, WT + W_RWKV_A2, WT + W_RWKV_A2, 128, 64, 64, 1, 0, 8, e2, lds);
    }
    xcd_barrier(xb);
#if DUP == 2
    rwkv_rec_phase(p, lds, p.pp->ws == nullptr);
    xcd_barrier(xb);
#endif
    rwkv_rec_phase(p, lds, true);
    xcd_barrier(xb);
    {
      pg8::EpiResid<true, true> e{p.pp->ws + XR3, p.pp->out, MOD + 2 * 16 * 3072};
      const u16* A = (const u16*)(p.pp->ws + RW_RKVG);
      pg8::run(lds, A, A, A, WT + W_RWKV_OUT, WT + W_RWKV_OUT, WT + W_RWKV_OUT, 4096, 1024, 4, 1, 1024, e);
    }
    xcd_barrier(xb);
    xcur = p.pp->out;
  }
  if (LAYER_MASK & 8) {
    for (int r_ = 0; r_ < ((DUP == 10) ? 2 : 1); ++r_) norm_phase<false, false, true>(p, p.pp->ws + XR3, 3, H, nullptr);
    xcd_barrier(xb);
    for (int r_ = 0; r_ < ((DUP == 9) ? 2 : 1); ++r_) {
      pg8::EpiPlain e{(u16*)(p.pp->ws + GL_P), 3088, 3088};
      pg8::run(lds, H, H, H, WT + W_GLA_IN, WT + W_GLA_IN, WT + W_GLA_IN, 1024, 1024, 4, 1, 3328, e);
    }
    xcd_barrier(xb);
    gla_pre_phase(p, lds);
    xcd_barrier(xb);
#if DUP == 3
    gla_phase(p, lds);
    xcd_barrier(xb);
#endif
    gla_phase(p, lds);
    xcd_barrier(xb);
    for (int r_ = 0; r_ < ((DUP == 10) ? 2 : 1); ++r_) gla_norm_phase(p);
    xcd_barrier(xb);
    {
      pg8::EpiResid<true, false> e{p.pp->out, p.pp->ws + XR3, MOD + 3 * 16 * 3072};
      pg8::run(lds, H, H, H, WT + W_GLA_OUT, WT + W_GLA_OUT, WT + W_GLA_OUT, 1024, 1024, 4, 1, 1024, e);
    }
    xcur = p.pp->out;
  }
  if (xcur != p.pp->out) {
    for (size_t i = (size_t)blockIdx.x * NTHR + tid_(); i < (size_t)T_ * 1024 / 4; i += (size_t)gridDim.x * NTHR)
      ((float4*)p.pp->out)[i] = ((const float4*)p.pp->in[0])[i];
  }
}

extern "C" void kernel_launch(void* const* d_in, const int* in_sizes, int n_in, void* d_out, int out_size, void* d_ws, size_t ws_size,
                              hipStream_t stream) {
  static int grid_blocks = 0;
  if (!grid_blocks) {
    int dev = 0, cus = 0, per_cu = 0;
    hipGetDevice(&dev);
    hipDeviceGetAttribute(&cus, hipDeviceAttributeMultiprocessorCount, dev);
    hipFuncSetAttribute((const void*)fwd_megakernel, hipFuncAttributeMaxDynamicSharedMemorySize, LDS_BYTES);
    hipOccupancyMaxActiveBlocksPerMultiprocessor(&per_cu, (const void*)fwd_megakernel, NTHR, LDS_BYTES);
    if (per_cu < 1) { fprintf(stderr, "occupancy query says %d blocks/CU\n", per_cu); per_cu = 1; }
    grid_blocks = cus;
  }
  Params p{};
  for (int i = 0; i < 37; ++i) p.in[i] = (const float*)d_in[i];
  p.out = (float*)d_out;
  p.ws = (unsigned char*)d_ws;
  for (int i = 0; i < 64; ++i) p.invf128[i] = (float)pow(10000.0, -(double)i / 64.0);
  for (int i = 0; i < 32; ++i) p.invf64[i] = (float)pow(10000.0, -(double)i / 32.0);
  void* args[] = {&p};
  hipError_t e = hipLaunchCooperativeKernel((const void*)fwd_megakernel, dim3(grid_blocks), dim3(NTHR), args, LDS_BYTES, stream);
  if (e != hipSuccess) fprintf(stderr, "cooperative launch failed: %s (grid %d)\n", hipGetErrorString(e), grid_blocks);
}
```
